# Optimizing an MI355X kernel written in HIP

```python
import jax, jax.numpy as jnp
from jax import lax
import numpy as np

D_MODEL = 2048
BATCH = 8
SEQ = 4096
DEPTH = 1

CHUNK = 64
Q_BLOCK = 128
FOX_HEADS = 8
FOX_HEAD_DIM = 128
FOX_WIDTH = FOX_HEADS * FOX_HEAD_DIM
CONV_WIDTH = 1024
CONV_K = 3
N_BRANCHES = 2
PLE_DIM = 256
N_GROUPS = 4
EXPERTS_PER_GROUP = 8
N_EXPERTS = N_GROUPS * EXPERTS_PER_GROUP
TOP_K_IN_GROUP = 2
EXPERT_FF = 512
NORM_EPS = 1e-6
IN_COLS = 3 * FOX_WIDTH + FOX_HEADS + 3 * CONV_WIDTH + N_BRANCHES * D_MODEL

kernel_name = "hybrid_fox_shortconv_hiermoe_block"


def rmsnorm(x, g):
    xf = x.astype(jnp.float32)
    y = xf * lax.rsqrt(jnp.mean(xf * xf, axis=-1, keepdims=True) + NORM_EPS)
    return (y * g.astype(jnp.float32)).astype(x.dtype)


def split_points():
    sizes = [FOX_WIDTH, FOX_WIDTH, FOX_WIDTH, FOX_HEADS, CONV_WIDTH, CONV_WIDTH, CONV_WIDTH]
    return tuple(int(v) for v in np.cumsum(sizes))


def fox_attention(q, k, v, log_f):
    b, s, h, dh = q.shape
    nb = s // Q_BLOCK
    c = jnp.cumsum(log_f, axis=1).transpose(0, 2, 1)
    scale = dh ** -0.5
    kpos = jnp.arange(s)
    q_blocks = q.reshape(b, nb, Q_BLOCK, h, dh).transpose(1, 0, 2, 3, 4)
    c_blocks = c.reshape(b, h, nb, Q_BLOCK).transpose(2, 0, 1, 3)
    starts = jnp.arange(nb) * Q_BLOCK

    def block(args):
        qb, cb, start = args
        logits = jnp.einsum('bqhd,bkhd->bhqk', qb, k).astype(jnp.float32) * scale
        logits = logits + cb[..., :, None] - c[:, :, None, :]
        qpos = start + jnp.arange(Q_BLOCK)
        mask = kpos[None, :] <= qpos[:, None]
        logits = jnp.where(mask, logits, -jnp.inf)
        probs = jax.nn.softmax(logits, axis=-1).astype(v.dtype)
        return jnp.einsum('bhqk,bkhd->bqhd', probs, v)

    out = lax.map(block, (q_blocks, c_blocks, starts))
    return out.transpose(1, 0, 2, 3, 4).reshape(b, s, h * dh)


def causal_short_conv(z, w):
    s = z.shape[1]
    zp = jnp.pad(z, ((0, 0), (CONV_K - 1, 0), (0, 0)))
    return sum(w[j] * zp[:, j:j + s] for j in range(CONV_K))


def hier_moe(hn, w_rg, b_rg, w_re, b_re, w_gu, w_down):
    t = hn.shape[0]
    g_logits = (hn @ w_rg).astype(jnp.float32) + b_rg
    g_probs = jax.nn.softmax(g_logits, axis=-1)
    grp = jnp.argmax(g_logits, axis=-1).astype(jnp.int32)
    p_grp = jnp.take_along_axis(g_probs, grp[:, None], axis=1)
    e_logits = ((hn @ w_re).astype(jnp.float32) + b_re).reshape(t, N_GROUPS, EXPERTS_PER_GROUP)
    e_sel = jnp.take_along_axis(e_logits, grp[:, None, None], axis=1)[:, 0]
    e_probs = jax.nn.softmax(e_sel, axis=-1)
    vals, idx = lax.top_k(e_probs, TOP_K_IN_GROUP)
    wts = p_grp * vals / jnp.sum(vals, axis=-1, keepdims=True)
    eid = grp[:, None] * EXPERTS_PER_GROUP + idx.astype(jnp.int32)

    flat_e = eid.reshape(-1)
    order = jnp.argsort(flat_e)
    tok = order // TOP_K_IN_GROUP
    group_sizes = jnp.bincount(flat_e, length=N_EXPERTS).astype(jnp.int32)
    xs = hn[tok]
    gu = lax.ragged_dot(xs, w_gu, group_sizes)
    gate, up = jnp.split(gu, 2, axis=-1)
    ys = lax.ragged_dot(jax.nn.silu(gate) * up, w_down, group_sizes)
    ys = ys * wts.reshape(-1)[order][:, None].astype(ys.dtype)
    return jax.ops.segment_sum(ys, tok, num_segments=t)


def setup_inputs(seed: int = 0) -> dict:
    key = jax.random.key(seed)
    ks = jax.random.split(key, 20)
    f32 = jnp.float32
    D, L = D_MODEL, DEPTH
    nrm = lambda k, shape, fan_in: jax.random.normal(k, shape, f32) * (fan_in ** -0.5)
    gain = lambda k, shape: 1.0 + 0.01 * jax.random.normal(k, shape, f32)
    return {
        "x": jax.random.normal(ks[0], (BATCH, SEQ, D), f32),
        "p": jax.random.normal(ks[1], (DEPTH, BATCH, SEQ, PLE_DIM), f32),
        "g_mix": gain(ks[2], (L, D)),
        "w_in": nrm(ks[3], (L, D, IN_COLS), D),
        "b_f": jax.random.uniform(ks[4], (L, FOX_HEADS), f32, 1.0, 4.0),
        "conv_w": nrm(ks[5], (L, CONV_K, CONV_WIDTH), CONV_K),
        "w_branch_a": nrm(ks[6], (L, FOX_WIDTH, D), FOX_WIDTH),
        "w_branch_b": nrm(ks[7], (L, CONV_WIDTH, D), CONV_WIDTH),
        "w_out": nrm(ks[8], (L, D, D), D),
        "g_ffn": gain(ks[9], (L, D)),
        "w_router_group": nrm(ks[10], (L, D, N_GROUPS), D),
        "b_router_group": 0.01 * jax.random.normal(ks[11], (L, N_GROUPS), f32),
        "w_router_expert": nrm(ks[12], (L, D, N_EXPERTS), D),
        "b_router_expert": 0.01 * jax.random.normal(ks[13], (L, N_EXPERTS), f32),
        "w_gate_up": nrm(ks[14], (L, N_EXPERTS, D, 2 * EXPERT_FF), D),
        "w_down": nrm(ks[15], (L, N_EXPERTS, EXPERT_FF, D), EXPERT_FF),
        "g_ple": gain(ks[16], (L, D)),
        "w_ple_gate": nrm(ks[17], (L, D, D), D),
        "w_ple_proj": nrm(ks[18], (L, PLE_DIM, D), PLE_DIM),
        "g_final": gain(ks[19], (D,)),
    }


def reference(x, p, g_mix, w_in, b_f, conv_w, w_branch_a, w_branch_b, w_out, g_ffn,
              w_router_group, b_router_group, w_router_expert, b_router_expert,
              w_gate_up, w_down, g_ple, w_ple_gate, w_ple_proj, g_final):
    b, s, d = x.shape
    cuts = split_points()
    for i in range(DEPTH):
        h = rmsnorm(x, g_mix[i])
        proj = h @ w_in[i]
        q, k, v, f_logit, u, bg, cg, gate_logit = jnp.split(proj, cuts, axis=-1)
        log_f = jax.nn.log_sigmoid(f_logit.astype(jnp.float32) + b_f[i])
        shp = (b, s, FOX_HEADS, FOX_HEAD_DIM)
        attn = fox_attention(q.reshape(shp), k.reshape(shp), v.reshape(shp), log_f)
        conv = bg * causal_short_conv(cg * u, conv_w[i])
        ga, gb = jnp.split(jax.nn.sigmoid(gate_logit), N_BRANCHES, axis=-1)
        merged = ga * (attn @ w_branch_a[i]) + gb * (conv @ w_branch_b[i])
        x = x + merged @ w_out[i]
        hn = rmsnorm(x, g_ffn[i]).reshape(b * s, d)
        x = x + hier_moe(hn, w_router_group[i], b_router_group[i], w_router_expert[i],
                         b_router_expert[i], w_gate_up[i], w_down[i]).reshape(b, s, d)
        hp = rmsnorm(x, g_ple[i])
        x = x + jax.nn.sigmoid(hp @ w_ple_gate[i]) * (p[i] @ w_ple_proj[i])
    return rmsnorm(x, g_final)
```

```cpp
#include <hip/hip_runtime.h>
#include <cstdio>
#include <cstdint>
#include <cstring>

constexpr int BATCH = 8, SEQ = 4096, DM = 2048, T = BATCH * SEQ;
constexpr int NH = 8, HD = 128, FW = 1024, CW = 1024, PLE = 256, NGRP = 4, EPG = 8, NE = 32, FF = 512;
constexpr int IN_COLS = 3 * FW + NH + 3 * CW + 2 * DM;
constexpr int C_Q = 0, C_K = 1024, C_V = 2048, C_F = 3072, C_U = 3080, C_BG = 4104, C_CG = 5128, C_GA = 6152;
constexpr float EPS = 1e-6f;
constexpr int NSEG = 64;

constexpr size_t MiB = 1u << 20;
constexpr size_t WS_CTL = 0;
constexpr size_t WS_RSTD1 = 1 * MiB;
constexpr size_t WS_LOGF = 2 * MiB;
constexpr size_t WS_CUM = 3 * MiB;
constexpr size_t WS_SS1 = 4 * MiB, WS_SS2 = 5 * MiB, WS_SS3 = 6 * MiB;
constexpr size_t WS_EID = 7 * MiB;
constexpr size_t WS_WTS = 7 * MiB + 512 * 1024;
constexpr size_t WS_POS = 8 * MiB;
constexpr size_t WS_SEGB = 8 * MiB + 512 * 1024;
constexpr size_t WS_TOKL = 9 * MiB;
constexpr size_t WS_WT_IN = 20 * MiB, WS_WT_A = 60 * MiB, WS_WT_B = 64 * MiB, WS_WT_OUT = 68 * MiB, WS_WT_PG = 76 * MiB, WS_WT_PE = 84 * MiB;
constexpr size_t WS_PB = 86 * MiB;
constexpr size_t WS_WT_GU = 104 * MiB, WS_WT_DN = 232 * MiB;
constexpr size_t WS_XB = 296 * MiB;
constexpr size_t WS_Q = 424 * MiB, WS_K = 488 * MiB, WS_V = 552 * MiB;
constexpr size_t WS_Z = 616 * MiB, WS_BG = 680 * MiB;
constexpr size_t WS_GAB = 744 * MiB;
constexpr size_t WS_MERGED = WS_XB;
constexpr size_t WS_X1B = 424 * MiB;
constexpr size_t WS_HACT = 552 * MiB;
constexpr size_t WS_X2B = 744 * MiB;
constexpr size_t WS_PP = 872 * MiB;
constexpr size_t WS_END = 1000 * MiB;
constexpr int CW_CNT = 1024;

typedef unsigned short bf16;
typedef float f32x4 __attribute__((ext_vector_type(4)));
typedef unsigned u32x4 __attribute__((ext_vector_type(4)));
typedef unsigned u32x2 __attribute__((ext_vector_type(2)));

struct Params {
    const float *x, *p, *g_mix, *w_in, *b_f, *conv_w, *w_a, *w_b, *w_out, *g_ffn, *w_rg, *b_rg, *w_re, *b_re, *w_gu, *w_dn, *g_ple, *w_pg, *w_pe, *g_final;
    float* out; unsigned char* ws;
};

__device__ __forceinline__ unsigned f2bf(float f) { unsigned u = __builtin_bit_cast(unsigned, f); return (u + 0x7fffu + ((u >> 16) & 1u)) >> 16; }
__device__ __forceinline__ unsigned pk2(float lo, float hi) { return f2bf(lo) | (f2bf(hi) << 16); }
__device__ __forceinline__ float bf2f(unsigned short b) { return __builtin_bit_cast(float, (unsigned)b << 16); }
__device__ __forceinline__ float bflo(unsigned w) { return __builtin_bit_cast(float, w << 16); }
__device__ __forceinline__ float bfhi(unsigned w) { return __builtin_bit_cast(float, w & 0xffff0000u); }
__device__ __forceinline__ float wave_sum(float v) {
#pragma unroll
    for (int o = 1; o < 64; o <<= 1) v += __shfl_xor(v, o);
    return v;
}
__device__ __forceinline__ float wave_max(float v) {
#pragma unroll
    for (int o = 1; o < 64; o <<= 1) v = fmaxf(v, __shfl_xor(v, o));
    return v;
}
__device__ __forceinline__ float sigmoidf_(float v) { return 1.0f / (1.0f + __expf(-v)); }
__device__ __forceinline__ float rstd_from_ss(const float* ss8) { float s = 0.f;
#pragma unroll
    for (int i = 0; i < 8; ++i) s += ss8[i];
    return 1.0f / sqrtf(s * (1.0f / DM) + EPS); }

__device__ __forceinline__ void thin_rowstats(const Params& P, int gw, int ngw, int lane) {
    unsigned char* ws = P.ws; float* rstd1 = (float*)(ws + WS_RSTD1); float* logf = (float*)(ws + WS_LOGF); bf16* XB = (bf16*)(ws + WS_XB);
    for (int t = gw; t < T; t += ngw) {
        const f32x4* xr = (const f32x4*)(P.x + (size_t)t * DM) + lane;
        f32x4 v[8]; float ss = 0.f;
#pragma unroll
        for (int j = 0; j < 8; ++j) { v[j] = xr[64 * j]; ss += (v[j].x * v[j].x + v[j].y * v[j].y) + (v[j].z * v[j].z + v[j].w * v[j].w); }
        ss = wave_sum(ss);
        const float rstd = 1.0f / sqrtf(ss * (1.0f / DM) + EPS);
        u32x2* xo = (u32x2*)(XB + (size_t)t * DM) + lane;
#pragma unroll
        for (int j = 0; j < 8; ++j) { u32x2 w; w.x = pk2(v[j].x, v[j].y); w.y = pk2(v[j].z, v[j].w); xo[64 * j] = w; }
        float f[8];
#pragma unroll
        for (int i = 0; i < 8; ++i) f[i] = 0.f;
#pragma unroll
        for (int j = 0; j < 8; ++j) {
            const int k0 = 4 * (lane + 64 * j);
            const f32x4 g = *(const f32x4*)(P.g_mix + k0);
#pragma unroll
            for (int e = 0; e < 4; ++e) {
                const float hv = v[j][e] * g[e];
                const f32x4* w = (const f32x4*)(P.w_in + (size_t)(k0 + e) * IN_COLS + C_F);
                const f32x4 w0 = w[0], w1 = w[1];
                f[0] += hv * w0.x; f[1] += hv * w0.y; f[2] += hv * w0.z; f[3] += hv * w0.w;
                f[4] += hv * w1.x; f[5] += hv * w1.y; f[6] += hv * w1.z; f[7] += hv * w1.w;
            }
        }
#pragma unroll
        for (int i = 0; i < 8; ++i) f[i] = wave_sum(f[i]);
        if (lane == 0) { rstd1[t] = rstd;
#pragma unroll
            for (int i = 0; i < 8; ++i) { const float a = f[i] * rstd + P.b_f[i]; logf[(size_t)t * 8 + i] = fminf(a, 0.f) - log1pf(__expf(-fabsf(a))); } }
    }
}
__device__ __forceinline__ void thin_cumsum(const Params& P, int gw, int ngw, int lane) {
    const float* logf = (const float*)(P.ws + WS_LOGF); float* cum = (float*)(P.ws + WS_CUM);
    for (int bh = gw; bh < BATCH * NH; bh += ngw) {
        const int b = bh / NH, h = bh % NH;
        const float* src = logf + ((size_t)b * SEQ + lane * 64) * 8 + h;
        double s = 0.0;
        for (int i = 0; i < 64; ++i) s += (double)src[(size_t)i * 8];
        double incl = s;
#pragma unroll
        for (int o = 1; o < 64; o <<= 1) { const double up = __shfl_up(incl, o); if (lane >= o) incl += up; }
        double run = incl - s;
        float* dst = cum + (size_t)bh * SEQ + lane * 64;
        for (int i = 0; i < 64; ++i) { run += (double)src[(size_t)i * 8]; dst[i] = (float)run; }
    }
}
__device__ __forceinline__ void thin_conv(const Params& P, long gt, long ngt) {
    const bf16* Z = (const bf16*)(P.ws + WS_Z); bf16* BG = (bf16*)(P.ws + WS_BG);
    for (long i = gt; i < (long)T * (CW / 8); i += ngt) {
        const int t = (int)(i / (CW / 8)), c = (int)(i % (CW / 8)) * 8, s = t % SEQ;
        const u32x4 z2 = *(const u32x4*)(Z + (size_t)t * CW + c);
        u32x4 z1 = (u32x4){0u, 0u, 0u, 0u}, z0 = (u32x4){0u, 0u, 0u, 0u};
        if (s >= 1) z1 = *(const u32x4*)(Z + (size_t)(t - 1) * CW + c);
        if (s >= 2) z0 = *(const u32x4*)(Z + (size_t)(t - 2) * CW + c);
        const u32x4 b = *(const u32x4*)(BG + (size_t)t * CW + c);
        u32x4 o;
#pragma unroll
        for (int q = 0; q < 4; ++q) {
            const int c0 = c + 2 * q;
            const float lo = bflo(b[q]) * (P.conv_w[c0] * bflo(z0[q]) + P.conv_w[CW + c0] * bflo(z1[q]) + P.conv_w[2 * CW + c0] * bflo(z2[q]));
            const float hi = bfhi(b[q]) * (P.conv_w[c0 + 1] * bfhi(z0[q]) + P.conv_w[CW + c0 + 1] * bfhi(z1[q]) + P.conv_w[2 * CW + c0 + 1] * bfhi(z2[q]));
            o[q] = pk2(lo, hi);
        }
        *(u32x4*)(BG + (size_t)t * CW + c) = o;
    }
}
__device__ __forceinline__ void thin_rowcast(const Params& P, bf16* XnB, float* SS, int gw, int ngw, int lane) {
    for (int t = gw; t < T; t += ngw) {
        const f32x4* xr = (const f32x4*)(P.out + (size_t)t * DM) + lane; float ss = 0.f;
        u32x2* xo = (u32x2*)(XnB + (size_t)t * DM) + lane;
#pragma unroll
        for (int j = 0; j < 8; ++j) { const f32x4 v = xr[64 * j]; ss += (v.x * v.x + v.y * v.y) + (v.z * v.z + v.w * v.w);
            if (XnB) { u32x2 w; w.x = pk2(v.x, v.y); w.y = pk2(v.z, v.w); xo[64 * j] = w; } }
        ss = wave_sum(ss);
        if (lane < 8) SS[(size_t)t * 8 + lane] = lane == 0 ? ss : 0.f;
    }
}
__device__ __forceinline__ void thin_router(const Params& P, int gw, int ngw, int lane) {
    unsigned char* ws = P.ws; int* EID = (int*)(ws + WS_EID); float* WTS = (float*)(ws + WS_WTS); int* POS = (int*)(ws + WS_POS); int* TOKL = (int*)(ws + WS_TOKL);
    unsigned* CNT = (unsigned*)(ws + WS_CTL) + CW_CNT;
    for (int t = gw; t < T; t += ngw) {
        const f32x4* xr = (const f32x4*)(P.out + (size_t)t * DM) + lane;
        float gl[4], el[32]; float ss = 0.f;
#pragma unroll
        for (int i = 0; i < 4; ++i) gl[i] = 0.f;
#pragma unroll
        for (int i = 0; i < 32; ++i) el[i] = 0.f;
#pragma unroll 1
        for (int j = 0; j < 8; ++j) {
            const f32x4 v = xr[64 * j]; const int k0 = 4 * (lane + 64 * j);
            ss += (v.x * v.x + v.y * v.y) + (v.z * v.z + v.w * v.w);
            const f32x4 g = *(const f32x4*)(P.g_ffn + k0);
#pragma unroll
            for (int e = 0; e < 4; ++e) {
                const float hv = v[e] * g[e];
                const f32x4 wg = *(const f32x4*)(P.w_rg + (size_t)(k0 + e) * NGRP);
                gl[0] += hv * wg.x; gl[1] += hv * wg.y; gl[2] += hv * wg.z; gl[3] += hv * wg.w;
                const f32x4* we = (const f32x4*)(P.w_re + (size_t)(k0 + e) * NE);
#pragma unroll
                for (int q = 0; q < 8; ++q) { const f32x4 w = we[q]; el[4 * q] += hv * w.x; el[4 * q + 1] += hv * w.y; el[4 * q + 2] += hv * w.z; el[4 * q + 3] += hv * w.w; }
            }
        }
        ss = wave_sum(ss);
        const float rstd = 1.0f / sqrtf(ss * (1.0f / DM) + EPS);
#pragma unroll
        for (int i = 0; i < 4; ++i) gl[i] = wave_sum(gl[i]) * rstd + P.b_rg[i];
#pragma unroll
        for (int i = 0; i < 32; ++i) el[i] = wave_sum(el[i]) * rstd + P.b_re[i];
        int grp = 0; float gm = gl[0];
#pragma unroll
        for (int i = 1; i < 4; ++i) if (gl[i] > gm) { gm = gl[i]; grp = i; }
        float gsum = 0.f;
#pragma unroll
        for (int i = 0; i < 4; ++i) gsum += __expf(gl[i] - gm);
        const float p_grp = 1.0f / gsum;
        float es[8];
#pragma unroll
        for (int i = 0; i < 8; ++i) { es[i] = el[i]; if (grp == 1) es[i] = el[8 + i]; if (grp == 2) es[i] = el[16 + i]; if (grp == 3) es[i] = el[24 + i]; }
        int i1 = 0; float l1 = es[0];
#pragma unroll
        for (int i = 1; i < 8; ++i) if (es[i] > l1) { l1 = es[i]; i1 = i; }
        int i2 = -1; float l2 = -3.0e38f;
#pragma unroll
        for (int i = 0; i < 8; ++i) if (i != i1 && es[i] > l2) { l2 = es[i]; i2 = i; }
        const float w1 = 1.0f / (1.0f + __expf(l2 - l1)), w2 = 1.0f - w1;
        if (lane == 0) {
            const int e1 = grp * EPG + i1, e2 = grp * EPG + i2;
            const int s0 = e1, s1 = NE + e2;
            const unsigned p0 = atomicAdd(&CNT[s0], 1u), p1 = atomicAdd(&CNT[s1], 1u);
            EID[2 * t] = e1; EID[2 * t + 1] = e2; WTS[2 * t] = p_grp * w1; WTS[2 * t + 1] = p_grp * w2; POS[2 * t] = (int)p0; POS[2 * t + 1] = (int)p1;
            TOKL[(size_t)s0 * T + p0] = t; TOKL[(size_t)s1 * T + p1] = t;
        }
    }
}
__device__ __forceinline__ void thin_final(const Params& P, int gw, int ngw, int lane) {
    for (int t = gw; t < T; t += ngw) {
        f32x4* xr = (f32x4*)(P.out + (size_t)t * DM) + lane; f32x4 v[8]; float ss = 0.f;
#pragma unroll
        for (int j = 0; j < 8; ++j) { v[j] = xr[64 * j]; ss += (v[j].x * v[j].x + v[j].y * v[j].y) + (v[j].z * v[j].z + v[j].w * v[j].w); }
        ss = wave_sum(ss);
        const float rstd = 1.0f / sqrtf(ss * (1.0f / DM) + EPS);
#pragma unroll
        for (int j = 0; j < 8; ++j) { const f32x4 g = *((const f32x4*)P.g_final + lane + 64 * j); xr[64 * j] = v[j] * rstd * g; }
    }
}

#define GW_DECL const int lane = threadIdx.x & 63, gw = (blockIdx.x * blockDim.x + threadIdx.x) >> 6, ngw = (gridDim.x * blockDim.x) >> 6
__global__ __launch_bounds__(256) void k_rowstats(Params P) { GW_DECL; thin_rowstats(P, gw, ngw, lane); }
__global__ __launch_bounds__(256) void k_cumsum(Params P) { GW_DECL; thin_cumsum(P, gw, ngw, lane); }
__global__ __launch_bounds__(256) void k_conv(Params P) { thin_conv(P, (long)blockIdx.x * blockDim.x + threadIdx.x, (long)gridDim.x * blockDim.x); }
__global__ __launch_bounds__(256) void k_rowcast(Params P, size_t xnb_off, size_t ss_off) { GW_DECL; thin_rowcast(P, xnb_off ? (bf16*)(P.ws + xnb_off) : nullptr, (float*)(P.ws + ss_off), gw, ngw, lane); }
__global__ __launch_bounds__(256) void k_router(Params P) { GW_DECL; thin_router(P, gw, ngw, lane); }
__global__ __launch_bounds__(256) void k_final(Params P) { GW_DECL; thin_final(P, gw, ngw, lane); }
__global__ void k_segscan(Params P) {
    if (threadIdx.x == 0 && blockIdx.x == 0) { const unsigned* CNT = (const unsigned*)(P.ws + WS_CTL) + CW_CNT; int* SEGB = (int*)(P.ws + WS_SEGB); int b = 0;
        for (int s = 0; s < NSEG; ++s) { SEGB[s] = b; b += ((int)CNT[s] + 255) & ~255; } SEGB[NSEG] = b; }
}

struct NOp { const void* A; const float* B; const float* gain; long lda, ldb; int K, abf16; };
__device__ __forceinline__ void ngemm_pass(const NOp& o, long arow, long bshift, int n0, float (&acc)[4][4], float (*As)[68], float (*Bs)[64]) {
    const int tid = threadIdx.x, tx = tid & 15, ty = tid >> 4, ar = tid >> 2, ak = (tid & 3) * 4, bk = tid >> 4, bn = (tid & 15) * 4;
    const float* Bp = o.B + bshift;
    for (int k0 = 0; k0 < o.K; k0 += 16) {
        float a4[4] = {0.f, 0.f, 0.f, 0.f};
        if (arow >= 0) {
            if (o.abf16) { const unsigned short* p = (const unsigned short*)o.A + arow * o.lda + k0 + ak;
#pragma unroll
                for (int i = 0; i < 4; ++i) a4[i] = bf2f(p[i]); }
            else { const float* p = (const float*)o.A + arow * o.lda + k0 + ak;
#pragma unroll
                for (int i = 0; i < 4; ++i) a4[i] = p[i]; }
            if (o.gain) {
#pragma unroll
                for (int i = 0; i < 4; ++i) a4[i] *= o.gain[k0 + ak + i]; }
        }
#pragma unroll
        for (int i = 0; i < 4; ++i) As[ak + i][ar] = a4[i];
        const f32x4 b4 = *(const f32x4*)(Bp + (size_t)(k0 + bk) * o.ldb + n0 + bn);
        Bs[bk][bn] = b4.x; Bs[bk][bn + 1] = b4.y; Bs[bk][bn + 2] = b4.z; Bs[bk][bn + 3] = b4.w;
        __syncthreads();
#pragma unroll
        for (int kk = 0; kk < 16; ++kk) {
            const f32x4 a = *(const f32x4*)&As[kk][ty * 4], b = *(const f32x4*)&Bs[kk][tx * 4];
#pragma unroll
            for (int i = 0; i < 4; ++i)
#pragma unroll
                for (int j = 0; j < 4; ++j) acc[i][j] += a[i] * b[j];
        }
        __syncthreads();
    }
}
template <int DUAL, class Epi>
__global__ __launch_bounds__(256) void ngemm(NOp o1, NOp o2, Epi epi) {
    __shared__ __attribute__((aligned(16))) float As[16][68]; __shared__ __attribute__((aligned(16))) float Bs[16][64];
    const int tid = threadIdx.x, tx = tid & 15, ty = tid >> 4, ar = tid >> 2;
    const int m0 = blockIdx.y * 64, n0 = blockIdx.x * 64;
    if (!epi.live(m0)) return;
    float acc1[4][4], acc2[4][4];
#pragma unroll
    for (int i = 0; i < 4; ++i)
#pragma unroll
        for (int j = 0; j < 4; ++j) { acc1[i][j] = 0.f; acc2[i][j] = 0.f; }
    ngemm_pass(o1, epi.arow(0, m0 + ar), epi.bshift(0, m0), n0, acc1, As, Bs);
    if (DUAL) ngemm_pass(o2, epi.arow(1, m0 + ar), epi.bshift(1, m0), n0, acc2, As, Bs);
#pragma unroll
    for (int i = 0; i < 4; ++i)
#pragma unroll
        for (int j = 0; j < 4; ++j) epi(m0 + ty * 4 + i, n0 + tx * 4 + j, acc1[i][j], acc2[i][j]);
}
struct EpiDenseBase {
    __device__ bool live(int) const { return true; }
    __device__ long arow(int, int m) const { return m; }
    __device__ long bshift(int, int) const { return 0; }
};
struct EpiQKV : EpiDenseBase { bf16* QKV; const float* rstd;
    __device__ void operator()(int m, int n, float v1, float) const { QKV[(size_t)(n >> 10) * ((size_t)T * FW) + (size_t)m * FW + (n & 1023)] = (bf16)f2bf(v1 * rstd[m]); } };
struct EpiZ : EpiDenseBase { bf16* Z; const float* rstd;
    __device__ void operator()(int m, int n, float v1, float v2) const { const float r = rstd[m]; Z[(size_t)m * CW + n] = (bf16)f2bf((v1 * r) * (v2 * r)); } };
struct EpiBG : EpiDenseBase { bf16* BG; const float* rstd;
    __device__ void operator()(int m, int n, float v1, float) const { BG[(size_t)m * CW + n] = (bf16)f2bf(v1 * rstd[m]); } };
struct EpiGAB : EpiDenseBase { bf16* GAB; const float* rstd;
    __device__ void operator()(int m, int n, float v1, float) const { GAB[(size_t)m * 4096 + n] = (bf16)f2bf(sigmoidf_(v1 * rstd[m])); } };
struct EpiMerged : EpiDenseBase { bf16* MG; const bf16* GAB;
    __device__ void operator()(int m, int n, float v1, float v2) const { const float ga = bf2f(GAB[(size_t)m * 4096 + n]), gb = bf2f(GAB[(size_t)m * 4096 + 2048 + n]); MG[(size_t)m * DM + n] = (bf16)f2bf(ga * v1 + gb * v2); } };
struct EpiX1 : EpiDenseBase { const float* x; float* out;
    __device__ void operator()(int m, int n, float v1, float) const { out[(size_t)m * DM + n] = x[(size_t)m * DM + n] + v1; } };
struct EpiPle : EpiDenseBase { float* out; const float* SS;
    __device__ void operator()(int m, int n, float v1, float v2) const { const float r = rstd_from_ss(SS + (size_t)m * 8); out[(size_t)m * DM + n] += sigmoidf_(v1 * r) * v2; } };
struct EpiSegBase { const int* SEGB; const unsigned* CNT; const int* TOKL; int rank_only;
    __device__ int seg_of(int m) const { int s = 0; while (s < NSEG - 1 && m >= SEGB[s + 1]) ++s; return s; }
    __device__ bool live(int m0) const { if (m0 >= SEGB[NSEG]) return false; const int s = seg_of(m0); if (rank_only >= 0 && (s >> 5) != rank_only) return false; return (m0 - SEGB[s]) < (int)CNT[s]; }
    __device__ int tok_of(int m, int& s) const { s = seg_of(m); const int l = m - SEGB[s]; return l < (int)CNT[s] ? TOKL[(size_t)s * T + l] : -1; }
};
struct EpiGU : EpiSegBase { bf16* HACT; const float* SS1; const float* WTS;
    __device__ long arow(int, int m) const { int s; return tok_of(m, s); }
    __device__ long bshift(int, int m0) const { return (long)(seg_of(m0) & 31) * DM * (2 * FF); }
    __device__ void operator()(int m, int n, float v1, float v2) const { int s; const int tok = tok_of(m, s); if (tok < 0) return;
        const float r = rstd_from_ss(SS1 + (size_t)tok * 8), g = v1 * r, u = v2 * r, wt = WTS[2 * tok + (s >> 5)];
        HACT[(size_t)m * FF + n] = (bf16)f2bf(g * sigmoidf_(g) * u * wt); } };
struct EpiDN : EpiSegBase { float* out;
    __device__ long arow(int, int m) const { int s; return tok_of(m, s) >= 0 ? m : -1; }
    __device__ long bshift(int, int m0) const { return (long)(seg_of(m0) & 31) * FF * DM; }
    __device__ void operator()(int m, int n, float v1, float) const { int s; const int tok = tok_of(m, s); if (tok < 0) return; out[(size_t)tok * DM + n] += v1; } };

__global__ __launch_bounds__(256) void nattn(Params P) {
    __shared__ float sc[4][SEQ];
    const bf16* Q = (const bf16*)(P.ws + WS_Q); const bf16* K = (const bf16*)(P.ws + WS_K); const bf16* V = (const bf16*)(P.ws + WS_V); bf16* O = (bf16*)(P.ws + WS_Q);
    const float* CUM = (const float*)(P.ws + WS_CUM);
    const int lane = threadIdx.x & 63, wid = threadIdx.x >> 6;
    const int r = blockIdx.x * 4 + wid, bh = r / SEQ, t = r % SEQ, b = bh / NH, h = bh % NH;
    const size_t rowq = ((size_t)b * SEQ + t) * FW + h * HD;
    float* s_ = sc[wid];
    const float* cum = CUM + (size_t)bh * SEQ; const float ct = cum[t];
    const float scale = 0.08838834764831845f;
    float mx = -3.0e38f;
    for (int s0 = 0; s0 <= t; s0 += 64) {
        const int s = s0 + lane;
        if (s <= t) {
            const u32x4* kp = (const u32x4*)(K + ((size_t)b * SEQ + s) * FW + h * HD); const u32x4* qp = (const u32x4*)(Q + rowq);
            float d = 0.f;
#pragma unroll 4
            for (int c = 0; c < 16; ++c) { const u32x4 kv = kp[c], qv = qp[c];
#pragma unroll
                for (int e = 0; e < 4; ++e) d += bflo(kv[e]) * bflo(qv[e]) + bfhi(kv[e]) * bfhi(qv[e]); }
            const float lg = d * scale + (ct - cum[s]);
            s_[s] = lg; mx = fmaxf(mx, lg);
        }
    }
    mx = wave_max(mx);
    __syncthreads();
    float l = 0.f;
    for (int s = lane; s <= t; s += 64) { const float p = __expf(s_[s] - mx); s_[s] = p; l += p; }
    l = wave_sum(l);
    __syncthreads();
    float o0 = 0.f, o1 = 0.f;
    const unsigned* vp = (const unsigned*)(V + (size_t)b * SEQ * FW + h * HD) + lane;
    for (int s = 0; s <= t; ++s) { const float p = s_[s]; const unsigned w = vp[(size_t)s * (FW / 2)]; o0 += p * bflo(w); o1 += p * bfhi(w); }
    const float il = 1.0f / l;
    *((unsigned*)(O + rowq) + lane) = pk2(o0 * il, o1 * il);
}

extern "C" void kernel_launch(void* const* d_in, const int* in_sizes, int n_in, void* d_out, int out_size, void* d_ws, size_t ws_size, hipStream_t stream) {
    if (n_in != 20 || in_sizes[0] != T * DM || out_size != T * DM || ws_size < WS_END) {
        fprintf(stderr, "kernel_launch: unexpected shapes (n_in %d, in0 %d, out %d, ws %zu; need ws >= %zu); nothing launched\n", n_in, n_in > 0 ? in_sizes[0] : -1, out_size, ws_size, (size_t)WS_END); return; }
    Params P{};
    const float** pp = (const float**)&P;
    for (int i = 0; i < 20; ++i) pp[i] = (const float*)d_in[i];
    P.out = (float*)d_out; P.ws = (unsigned char*)d_ws;
    unsigned char* ws = P.ws;
    (void)hipMemsetAsync(ws + WS_CTL, 0, 1 * MiB, stream);
    const dim3 blk(256);
    k_rowstats<<<2048, blk, 0, stream>>>(P);
    k_cumsum<<<16, blk, 0, stream>>>(P);
    const float* rstd1 = (const float*)(ws + WS_RSTD1);
    NOp none{};
    { NOp o{ws + WS_XB, P.w_in + C_Q, P.g_mix, DM, IN_COLS, DM, 1}; EpiQKV e; memset(&e, 0, sizeof(e)); e.QKV = (bf16*)(ws + WS_Q); e.rstd = rstd1; ngemm<0, EpiQKV><<<dim3(3072 / 64, T / 64), blk, 0, stream>>>(o, none, e); }
    { NOp o1{ws + WS_XB, P.w_in + C_U, P.g_mix, DM, IN_COLS, DM, 1}, o2{ws + WS_XB, P.w_in + C_CG, P.g_mix, DM, IN_COLS, DM, 1}; EpiZ e; memset(&e, 0, sizeof(e)); e.Z = (bf16*)(ws + WS_Z); e.rstd = rstd1; ngemm<1, EpiZ><<<dim3(CW / 64, T / 64), blk, 0, stream>>>(o1, o2, e); }
    { NOp o{ws + WS_XB, P.w_in + C_BG, P.g_mix, DM, IN_COLS, DM, 1}; EpiBG e; memset(&e, 0, sizeof(e)); e.BG = (bf16*)(ws + WS_BG); e.rstd = rstd1; ngemm<0, EpiBG><<<dim3(CW / 64, T / 64), blk, 0, stream>>>(o, none, e); }
    { NOp o{ws + WS_XB, P.w_in + C_GA, P.g_mix, DM, IN_COLS, DM, 1}; EpiGAB e; memset(&e, 0, sizeof(e)); e.GAB = (bf16*)(ws + WS_GAB); e.rstd = rstd1; ngemm<0, EpiGAB><<<dim3(4096 / 64, T / 64), blk, 0, stream>>>(o, none, e); }
    k_conv<<<4096, blk, 0, stream>>>(P);
    nattn<<<BATCH * NH * SEQ / 4, blk, 0, stream>>>(P);
    { NOp o1{ws + WS_Q, P.w_a, nullptr, FW, DM, FW, 1}, o2{ws + WS_BG, P.w_b, nullptr, CW, DM, CW, 1}; EpiMerged e; memset(&e, 0, sizeof(e)); e.MG = (bf16*)(ws + WS_MERGED); e.GAB = (const bf16*)(ws + WS_GAB);
      ngemm<1, EpiMerged><<<dim3(DM / 64, T / 64), blk, 0, stream>>>(o1, o2, e); }
    { NOp o{ws + WS_MERGED, P.w_out, nullptr, DM, DM, DM, 1}; EpiX1 e; memset(&e, 0, sizeof(e)); e.x = P.x; e.out = P.out; ngemm<0, EpiX1><<<dim3(DM / 64, T / 64), blk, 0, stream>>>(o, none, e); }
    k_rowcast<<<2048, blk, 0, stream>>>(P, WS_X1B, WS_SS1);
    k_router<<<2048, blk, 0, stream>>>(P);
    k_segscan<<<1, 64, 0, stream>>>(P);
    const int* SEGB = (const int*)(ws + WS_SEGB); const unsigned* CNT = (const unsigned*)(ws + WS_CTL) + CW_CNT; const int* TOKL = (const int*)(ws + WS_TOKL);
    { NOp o1{ws + WS_X1B, P.w_gu, P.g_ffn, DM, 2 * FF, DM, 1}, o2{ws + WS_X1B, P.w_gu + FF, P.g_ffn, DM, 2 * FF, DM, 1};
      EpiGU e; memset(&e, 0, sizeof(e)); e.SEGB = SEGB; e.CNT = CNT; e.TOKL = TOKL; e.rank_only = -1; e.HACT = (bf16*)(ws + WS_HACT); e.SS1 = (const float*)(ws + WS_SS1); e.WTS = (const float*)(ws + WS_WTS);
      ngemm<1, EpiGU><<<dim3(FF / 64, 81920 / 64), blk, 0, stream>>>(o1, o2, e); }
    for (int rank = 0; rank < 2; ++rank) { NOp o{ws + WS_HACT, P.w_dn, nullptr, FF, DM, FF, 1};
      EpiDN e; memset(&e, 0, sizeof(e)); e.SEGB = SEGB; e.CNT = CNT; e.TOKL = TOKL; e.rank_only = rank; e.out = P.out;
      ngemm<0, EpiDN><<<dim3(DM / 64, 81920 / 64), blk, 0, stream>>>(o, none, e); }
    k_rowcast<<<2048, blk, 0, stream>>>(P, WS_X2B, WS_SS2);
    { NOp o1{ws + WS_X2B, P.w_pg, P.g_ple, DM, DM, DM, 1}, o2{P.p, P.w_pe, nullptr, PLE, DM, PLE, 0}; EpiPle e; memset(&e, 0, sizeof(e)); e.out = P.out; e.SS = (const float*)(ws + WS_SS2);
      ngemm<1, EpiPle><<<dim3(DM / 64, T / 64), blk, 0, stream>>>(o1, o2, e); }
    k_final<<<2048, blk, 0, stream>>>(P);
}
```

```cpp
#define NAIVE_FROM 12
#define MEGA_ATTN 1
#include <hip/hip_runtime.h>
#include <cstdio>
#include <cstdint>
#include <cstring>

constexpr int BATCH = 8, SEQ = 4096, DM = 2048, T = BATCH * SEQ;
constexpr int NH = 8, HD = 128, FW = 1024, CW = 1024, PLE = 256, NGRP = 4, EPG = 8, NE = 32, FF = 512;
constexpr int IN_COLS = 3 * FW + NH + 3 * CW + 2 * DM;
constexpr int C_Q = 0, C_K = 1024, C_V = 2048, C_F = 3072, C_U = 3080, C_BG = 4104, C_CG = 5128, C_GA = 6152;
constexpr float EPS = 1e-6f;
constexpr int NSEG = 64;

constexpr size_t MiB = 1u << 20;
constexpr size_t WS_CTL = 0;
constexpr size_t WS_RSTD1 = 1 * MiB;
constexpr size_t WS_LOGF = 2 * MiB;
constexpr size_t WS_CUM = 3 * MiB;
constexpr size_t WS_RSTD2 = 4 * MiB, WS_RSTD3 = 5 * MiB;
constexpr size_t WS_EID = 7 * MiB;
constexpr size_t WS_WTS = 7 * MiB + 512 * 1024;
constexpr size_t WS_POS = 8 * MiB;
constexpr size_t WS_SEGB = 8 * MiB + 512 * 1024;
constexpr size_t WS_TOKL = 9 * MiB;
constexpr size_t WS_WT_IN = 20 * MiB, WS_WT_A = 60 * MiB, WS_WT_B = 64 * MiB, WS_WT_OUT = 68 * MiB, WS_WT_PG = 76 * MiB, WS_WT_PE = 84 * MiB;
constexpr size_t WS_PB = 86 * MiB;
constexpr size_t WS_WT_GU = 104 * MiB, WS_WT_DN = 232 * MiB;
constexpr size_t WS_XB = 296 * MiB;
constexpr size_t WS_Q = 424 * MiB, WS_K = 488 * MiB, WS_V = 552 * MiB;
constexpr size_t WS_Z = 616 * MiB, WS_BG = 680 * MiB;
constexpr size_t WS_GAB = 744 * MiB;
constexpr size_t WS_MERGED = WS_XB;
constexpr size_t WS_X1B = 424 * MiB;
constexpr size_t WS_HACT = 552 * MiB;
constexpr size_t WS_X2B = 744 * MiB;
constexpr size_t WS_PP = 872 * MiB;
constexpr size_t WS_END = 1000 * MiB;
constexpr int CW_CNT = 1024;

typedef unsigned short bf16;
typedef float f32x4 __attribute__((ext_vector_type(4)));
typedef unsigned u32x4 __attribute__((ext_vector_type(4)));
typedef unsigned u32x2 __attribute__((ext_vector_type(2)));

struct Params {
    const float *x, *p, *g_mix, *w_in, *b_f, *conv_w, *w_a, *w_b, *w_out, *g_ffn, *w_rg, *b_rg, *w_re, *b_re, *w_gu, *w_dn, *g_ple, *w_pg, *w_pe, *g_final;
    float* out; unsigned char* ws;
};

__device__ __forceinline__ unsigned f2bf(float f) { unsigned u = __builtin_bit_cast(unsigned, f); return (u + 0x7fffu + ((u >> 16) & 1u)) >> 16; }
__device__ __forceinline__ unsigned pk2(float lo, float hi) { return f2bf(lo) | (f2bf(hi) << 16); }
__device__ __forceinline__ float bf2f(unsigned short b) { return __builtin_bit_cast(float, (unsigned)b << 16); }
__device__ __forceinline__ float bflo(unsigned w) { return __builtin_bit_cast(float, w << 16); }
__device__ __forceinline__ float bfhi(unsigned w) { return __builtin_bit_cast(float, w & 0xffff0000u); }
__device__ __forceinline__ float wave_sum(float v) {
#pragma unroll
    for (int o = 1; o < 64; o <<= 1) v += __shfl_xor(v, o);
    return v;
}
__device__ __forceinline__ float wave_max(float v) {
#pragma unroll
    for (int o = 1; o < 64; o <<= 1) v = fmaxf(v, __shfl_xor(v, o));
    return v;
}
__device__ __forceinline__ float sigmoidf_(float v) { return 1.0f / (1.0f + __expf(-v)); }

__device__ __forceinline__ void thin_rowstats(const Params& P, int gw, int ngw, int lane) {
    unsigned char* ws = P.ws; float* rstd1 = (float*)(ws + WS_RSTD1); float* logf = (float*)(ws + WS_LOGF); bf16* XB = (bf16*)(ws + WS_XB);
    for (int t = gw; t < T; t += ngw) {
        const f32x4* xr = (const f32x4*)(P.x + (size_t)t * DM) + lane;
        f32x4 v[8]; float ss = 0.f;
#pragma unroll
        for (int j = 0; j < 8; ++j) { v[j] = xr[64 * j]; ss += (v[j].x * v[j].x + v[j].y * v[j].y) + (v[j].z * v[j].z + v[j].w * v[j].w); }
        ss = wave_sum(ss);
        const float rstd = 1.0f / sqrtf(ss * (1.0f / DM) + EPS);
        u32x2* xo = (u32x2*)(XB + (size_t)t * DM) + lane;
#pragma unroll
        for (int j = 0; j < 8; ++j) { u32x2 w; w.x = pk2(v[j].x * rstd, v[j].y * rstd); w.y = pk2(v[j].z * rstd, v[j].w * rstd); xo[64 * j] = w; }
        float f[8];
#pragma unroll
        for (int i = 0; i < 8; ++i) f[i] = 0.f;
#pragma unroll
        for (int j = 0; j < 8; ++j) {
            const int k0 = 4 * (lane + 64 * j);
            const f32x4 g = *(const f32x4*)(P.g_mix + k0);
#pragma unroll
            for (int e = 0; e < 4; ++e) {
                const float hv = v[j][e] * g[e];
                const f32x4* w = (const f32x4*)(P.w_in + (size_t)(k0 + e) * IN_COLS + C_F);
                const f32x4 w0 = w[0], w1 = w[1];
                f[0] += hv * w0.x; f[1] += hv * w0.y; f[2] += hv * w0.z; f[3] += hv * w0.w;
                f[4] += hv * w1.x; f[5] += hv * w1.y; f[6] += hv * w1.z; f[7] += hv * w1.w;
            }
        }
#pragma unroll
        for (int i = 0; i < 8; ++i) f[i] = wave_sum(f[i]);
        if (lane == 0) { rstd1[t] = rstd;
#pragma unroll
            for (int i = 0; i < 8; ++i) { const float a = f[i] * rstd + P.b_f[i]; logf[(size_t)t * 8 + i] = fminf(a, 0.f) - log1pf(__expf(-fabsf(a))); } }
    }
}
__device__ __forceinline__ void thin_cumsum(const Params& P, int gw, int ngw, int lane) {
    const float* logf = (const float*)(P.ws + WS_LOGF); float* cum = (float*)(P.ws + WS_CUM);
    for (int bh = gw; bh < BATCH * NH; bh += ngw) {
        const int b = bh / NH, h = bh % NH;
        const float* src = logf + ((size_t)b * SEQ + lane * 64) * 8 + h;
        double s = 0.0;
        for (int i = 0; i < 64; ++i) s += (double)src[(size_t)i * 8];
        double incl = s;
#pragma unroll
        for (int o = 1; o < 64; o <<= 1) { const double up = __shfl_up(incl, o); if (lane >= o) incl += up; }
        double run = incl - s;
        float* dst = cum + (size_t)bh * SEQ + lane * 64;
        for (int i = 0; i < 64; ++i) { run += (double)src[(size_t)i * 8]; dst[i] = (float)run; }
    }
}
__device__ __forceinline__ void thin_conv(const Params& P, long gt, long ngt) {
    const bf16* Z = (const bf16*)(P.ws + WS_Z); bf16* BG = (bf16*)(P.ws + WS_BG);
    for (long i = gt; i < (long)T * (CW / 8); i += ngt) {
        const int t = (int)(i / (CW / 8)), c = (int)(i % (CW / 8)) * 8, s = t % SEQ;
        const u32x4 z2 = *(const u32x4*)(Z + (size_t)t * CW + c);
        u32x4 z1 = (u32x4){0u, 0u, 0u, 0u}, z0 = (u32x4){0u, 0u, 0u, 0u};
        if (s >= 1) z1 = *(const u32x4*)(Z + (size_t)(t - 1) * CW + c);
        if (s >= 2) z0 = *(const u32x4*)(Z + (size_t)(t - 2) * CW + c);
        const u32x4 b = *(const u32x4*)(BG + (size_t)t * CW + c);
        u32x4 o;
#pragma unroll
        for (int q = 0; q < 4; ++q) {
            const int c0 = c + 2 * q;
            const float lo = bflo(b[q]) * (P.conv_w[c0] * bflo(z0[q]) + P.conv_w[CW + c0] * bflo(z1[q]) + P.conv_w[2 * CW + c0] * bflo(z2[q]));
            const float hi = bfhi(b[q]) * (P.conv_w[c0 + 1] * bfhi(z0[q]) + P.conv_w[CW + c0 + 1] * bfhi(z1[q]) + P.conv_w[2 * CW + c0 + 1] * bfhi(z2[q]));
            o[q] = pk2(lo, hi);
        }
        *(u32x4*)(BG + (size_t)t * CW + c) = o;
    }
}
__device__ __forceinline__ void thin_rowcast(const Params& P, bf16* XnB, float* RSTD, int gw, int ngw, int lane) {
    for (int t = gw; t < T; t += ngw) {
        const f32x4* xr = (const f32x4*)(P.out + (size_t)t * DM) + lane; float ss = 0.f;
        u32x2* xo = (u32x2*)(XnB + (size_t)t * DM) + lane;
#pragma unroll
        for (int j = 0; j < 8; ++j) { const f32x4 v = xr[64 * j]; ss += (v.x * v.x + v.y * v.y) + (v.z * v.z + v.w * v.w);
            if (XnB) { u32x2 w; w.x = pk2(v.x, v.y); w.y = pk2(v.z, v.w); xo[64 * j] = w; } }
        ss = wave_sum(ss);
        if (lane == 0) RSTD[t] = 1.0f / sqrtf(ss * (1.0f / DM) + EPS);
    }
}
__device__ __forceinline__ void thin_router(const Params& P, int gw, int ngw, int lane) {
    unsigned char* ws = P.ws; int* EID = (int*)(ws + WS_EID); float* WTS = (float*)(ws + WS_WTS); int* POS = (int*)(ws + WS_POS); int* TOKL = (int*)(ws + WS_TOKL);
    unsigned* CNT = (unsigned*)(ws + WS_CTL) + CW_CNT;
    for (int t = gw; t < T; t += ngw) {
        const f32x4* xr = (const f32x4*)(P.out + (size_t)t * DM) + lane;
        float gl[4], el[32]; float ss = 0.f;
#pragma unroll
        for (int i = 0; i < 4; ++i) gl[i] = 0.f;
#pragma unroll
        for (int i = 0; i < 32; ++i) el[i] = 0.f;
#pragma unroll 1
        for (int j = 0; j < 8; ++j) {
            const f32x4 v = xr[64 * j]; const int k0 = 4 * (lane + 64 * j);
            ss += (v.x * v.x + v.y * v.y) + (v.z * v.z + v.w * v.w);
            const f32x4 g = *(const f32x4*)(P.g_ffn + k0);
#pragma unroll
            for (int e = 0; e < 4; ++e) {
                const float hv = v[e] * g[e];
                const f32x4 wg = *(const f32x4*)(P.w_rg + (size_t)(k0 + e) * NGRP);
                gl[0] += hv * wg.x; gl[1] += hv * wg.y; gl[2] += hv * wg.z; gl[3] += hv * wg.w;
                const f32x4* we = (const f32x4*)(P.w_re + (size_t)(k0 + e) * NE);
#pragma unroll
                for (int q = 0; q < 8; ++q) { const f32x4 w = we[q]; el[4 * q] += hv * w.x; el[4 * q + 1] += hv * w.y; el[4 * q + 2] += hv * w.z; el[4 * q + 3] += hv * w.w; }
            }
        }
        ss = wave_sum(ss);
        const float rstd = 1.0f / sqrtf(ss * (1.0f / DM) + EPS);
#pragma unroll
        for (int i = 0; i < 4; ++i) gl[i] = wave_sum(gl[i]) * rstd + P.b_rg[i];
#pragma unroll
        for (int i = 0; i < 32; ++i) el[i] = wave_sum(el[i]) * rstd + P.b_re[i];
        int grp = 0; float gm = gl[0];
#pragma unroll
        for (int i = 1; i < 4; ++i) if (gl[i] > gm) { gm = gl[i]; grp = i; }
        float gsum = 0.f;
#pragma unroll
        for (int i = 0; i < 4; ++i) gsum += __expf(gl[i] - gm);
        const float p_grp = 1.0f / gsum;
        float es[8];
#pragma unroll
        for (int i = 0; i < 8; ++i) { es[i] = el[i]; if (grp == 1) es[i] = el[8 + i]; if (grp == 2) es[i] = el[16 + i]; if (grp == 3) es[i] = el[24 + i]; }
        int i1 = 0; float l1 = es[0];
#pragma unroll
        for (int i = 1; i < 8; ++i) if (es[i] > l1) { l1 = es[i]; i1 = i; }
        int i2 = -1; float l2 = -3.0e38f;
#pragma unroll
        for (int i = 0; i < 8; ++i) if (i != i1 && es[i] > l2) { l2 = es[i]; i2 = i; }
        const float w1 = 1.0f / (1.0f + __expf(l2 - l1)), w2 = 1.0f - w1;
        if (lane == 0) {
            ((float*)(ws + WS_RSTD2))[t] = rstd;
            const int e1 = grp * EPG + i1, e2 = grp * EPG + i2;
            const int s0 = e1, s1 = NE + e2;
            const unsigned p0 = atomicAdd(&CNT[s0], 1u), p1 = atomicAdd(&CNT[s1], 1u);
            EID[2 * t] = e1; EID[2 * t + 1] = e2; WTS[2 * t] = p_grp * w1; WTS[2 * t + 1] = p_grp * w2; POS[2 * t] = (int)p0; POS[2 * t + 1] = (int)p1;
            TOKL[(size_t)s0 * T + p0] = t; TOKL[(size_t)s1 * T + p1] = t;
        }
    }
}
__device__ __forceinline__ void thin_final(const Params& P, int gw, int ngw, int lane) {
    for (int t = gw; t < T; t += ngw) {
        f32x4* xr = (f32x4*)(P.out + (size_t)t * DM) + lane; f32x4 v[8]; float ss = 0.f;
#pragma unroll
        for (int j = 0; j < 8; ++j) { v[j] = xr[64 * j]; ss += (v[j].x * v[j].x + v[j].y * v[j].y) + (v[j].z * v[j].z + v[j].w * v[j].w); }
        ss = wave_sum(ss);
        const float rstd = 1.0f / sqrtf(ss * (1.0f / DM) + EPS);
#pragma unroll
        for (int j = 0; j < 8; ++j) { const f32x4 g = *((const f32x4*)P.g_final + lane + 64 * j); xr[64 * j] = v[j] * rstd * g; }
    }
}

#define GW_DECL const int lane = threadIdx.x & 63, gw = (blockIdx.x * blockDim.x + threadIdx.x) >> 6, ngw = (gridDim.x * blockDim.x) >> 6
__global__ __launch_bounds__(256) void k_rowstats(Params P) { GW_DECL; thin_rowstats(P, gw, ngw, lane); }
__global__ __launch_bounds__(256) void k_cumsum(Params P) { GW_DECL; thin_cumsum(P, gw, ngw, lane); }
__global__ __launch_bounds__(256) void k_conv(Params P) { thin_conv(P, (long)blockIdx.x * blockDim.x + threadIdx.x, (long)gridDim.x * blockDim.x); }
__global__ __launch_bounds__(256) void k_rowcast(Params P, size_t xnb_off, size_t rs_off) { GW_DECL; thin_rowcast(P, xnb_off ? (bf16*)(P.ws + xnb_off) : nullptr, (float*)(P.ws + rs_off), gw, ngw, lane); }
__global__ __launch_bounds__(256) void k_router(Params P) { GW_DECL; thin_router(P, gw, ngw, lane); }
__global__ __launch_bounds__(256) void k_final(Params P) { GW_DECL; thin_final(P, gw, ngw, lane); }
__global__ void k_segscan(Params P) {
    if (threadIdx.x == 0 && blockIdx.x == 0) { const unsigned* CNT = (const unsigned*)(P.ws + WS_CTL) + CW_CNT; int* SEGB = (int*)(P.ws + WS_SEGB); int b = 0;
        for (int s = 0; s < NSEG; ++s) { SEGB[s] = b; b += ((int)CNT[s] + 255) & ~255; } SEGB[NSEG] = b; }
}

struct NOp { const void* A; const float* B; const float* gain; long lda, ldb; int K, abf16; };
__device__ __forceinline__ void ngemm_pass(const NOp& o, long arow, long bshift, int n0, float (&acc)[4][4], float (*As)[68], float (*Bs)[64]) {
    const int tid = threadIdx.x, tx = tid & 15, ty = tid >> 4, ar = tid >> 2, ak = (tid & 3) * 4, bk = tid >> 4, bn = (tid & 15) * 4;
    const float* Bp = o.B + bshift;
    for (int k0 = 0; k0 < o.K; k0 += 16) {
        float a4[4] = {0.f, 0.f, 0.f, 0.f};
        if (arow >= 0) {
            if (o.abf16) { const unsigned short* p = (const unsigned short*)o.A + arow * o.lda + k0 + ak;
#pragma unroll
                for (int i = 0; i < 4; ++i) a4[i] = bf2f(p[i]); }
            else { const float* p = (const float*)o.A + arow * o.lda + k0 + ak;
#pragma unroll
                for (int i = 0; i < 4; ++i) a4[i] = p[i]; }
            if (o.gain) {
#pragma unroll
                for (int i = 0; i < 4; ++i) a4[i] *= o.gain[k0 + ak + i]; }
        }
#pragma unroll
        for (int i = 0; i < 4; ++i) As[ak + i][ar] = a4[i];
        const f32x4 b4 = *(const f32x4*)(Bp + (size_t)(k0 + bk) * o.ldb + n0 + bn);
        Bs[bk][bn] = b4.x; Bs[bk][bn + 1] = b4.y; Bs[bk][bn + 2] = b4.z; Bs[bk][bn + 3] = b4.w;
        __syncthreads();
#pragma unroll
        for (int kk = 0; kk < 16; ++kk) {
            const f32x4 a = *(const f32x4*)&As[kk][ty * 4], b = *(const f32x4*)&Bs[kk][tx * 4];
#pragma unroll
            for (int i = 0; i < 4; ++i)
#pragma unroll
                for (int j = 0; j < 4; ++j) acc[i][j] += a[i] * b[j];
        }
        __syncthreads();
    }
}
template <int DUAL, class Epi>
__global__ __launch_bounds__(256) void ngemm(NOp o1, NOp o2, Epi epi) {
    __shared__ __attribute__((aligned(16))) float As[16][68]; __shared__ __attribute__((aligned(16))) float Bs[16][64];
    const int tid = threadIdx.x, tx = tid & 15, ty = tid >> 4, ar = tid >> 2;
    const int m0 = blockIdx.y * 64, n0 = blockIdx.x * 64;
    if (!epi.live(m0)) return;
    float acc1[4][4], acc2[4][4];
#pragma unroll
    for (int i = 0; i < 4; ++i)
#pragma unroll
        for (int j = 0; j < 4; ++j) { acc1[i][j] = 0.f; acc2[i][j] = 0.f; }
    ngemm_pass(o1, epi.arow(0, m0 + ar), epi.bshift(0, m0), n0, acc1, As, Bs);
    if (DUAL) ngemm_pass(o2, epi.arow(1, m0 + ar), epi.bshift(1, m0), n0, acc2, As, Bs);
#pragma unroll
    for (int i = 0; i < 4; ++i)
#pragma unroll
        for (int j = 0; j < 4; ++j) epi(m0 + ty * 4 + i, n0 + tx * 4 + j, acc1[i][j], acc2[i][j]);
}
struct EpiDenseBase {
    __device__ bool live(int) const { return true; }
    __device__ long arow(int, int m) const { return m; }
    __device__ long bshift(int, int) const { return 0; }
};
struct EpiQKV : EpiDenseBase { bf16* QKV; const float* rstd;
    __device__ void operator()(int m, int n, float v1, float) const { QKV[(size_t)(n >> 10) * ((size_t)T * FW) + (size_t)m * FW + (n & 1023)] = (bf16)f2bf(v1 * rstd[m]); } };
struct EpiZ : EpiDenseBase { bf16* Z; const float* rstd;
    __device__ void operator()(int m, int n, float v1, float v2) const { const float r = rstd[m]; Z[(size_t)m * CW + n] = (bf16)f2bf((v1 * r) * (v2 * r)); } };
struct EpiBG : EpiDenseBase { bf16* BG; const float* rstd;
    __device__ void operator()(int m, int n, float v1, float) const { BG[(size_t)m * CW + n] = (bf16)f2bf(v1 * rstd[m]); } };
struct EpiGAB : EpiDenseBase { bf16* GAB; const float* rstd;
    __device__ void operator()(int m, int n, float v1, float) const { GAB[(size_t)m * 4096 + n] = (bf16)f2bf(sigmoidf_(v1 * rstd[m])); } };
struct EpiMerged : EpiDenseBase { bf16* MG; const bf16* GAB;
    __device__ void operator()(int m, int n, float v1, float v2) const { const float ga = bf2f(GAB[(size_t)m * 4096 + n]), gb = bf2f(GAB[(size_t)m * 4096 + 2048 + n]); MG[(size_t)m * DM + n] = (bf16)f2bf(ga * v1 + gb * v2); } };
struct EpiX1 : EpiDenseBase { const float* x; float* out;
    __device__ void operator()(int m, int n, float v1, float) const { out[(size_t)m * DM + n] = x[(size_t)m * DM + n] + v1; } };
struct EpiPle : EpiDenseBase { float* out; const float* RS;
    __device__ void operator()(int m, int n, float v1, float v2) const { const float r = RS[m]; out[(size_t)m * DM + n] += sigmoidf_(v1 * r) * v2; } };
struct EpiSegBase { const int* SEGB; const unsigned* CNT; const int* TOKL; int rank_only;
    __device__ int seg_of(int m) const { int s = 0; while (s < NSEG - 1 && m >= SEGB[s + 1]) ++s; return s; }
    __device__ bool live(int m0) const { if (m0 >= SEGB[NSEG]) return false; const int s = seg_of(m0); if (rank_only >= 0 && (s >> 5) != rank_only) return false; return (m0 - SEGB[s]) < (int)CNT[s]; }
    __device__ int tok_of(int m, int& s) const { s = seg_of(m); const int l = m - SEGB[s]; return l < (int)CNT[s] ? TOKL[(size_t)s * T + l] : -1; }
};
struct EpiGU : EpiSegBase { bf16* HACT; const float* RS; const float* WTS;
    __device__ long arow(int, int m) const { int s; return tok_of(m, s); }
    __device__ long bshift(int, int m0) const { return (long)(seg_of(m0) & 31) * DM * (2 * FF); }
    __device__ void operator()(int m, int n, float v1, float v2) const { int s; const int tok = tok_of(m, s); if (tok < 0) return;
        const float r = RS[tok], g = v1 * r, u = v2 * r, wt = WTS[2 * tok + (s >> 5)];
        HACT[(size_t)m * FF + n] = (bf16)f2bf(g * sigmoidf_(g) * u * wt); } };
struct EpiDN : EpiSegBase { float* out;
    __device__ long arow(int, int m) const { int s; return tok_of(m, s) >= 0 ? m : -1; }
    __device__ long bshift(int, int m0) const { return (long)(seg_of(m0) & 31) * FF * DM; }
    __device__ void operator()(int m, int n, float v1, float) const { int s; const int tok = tok_of(m, s); if (tok < 0) return; out[(size_t)tok * DM + n] += v1; } };

__global__ __launch_bounds__(256) void nattn(Params P) {
    __shared__ float sc[4][SEQ];
    const bf16* Q = (const bf16*)(P.ws + WS_Q); const bf16* K = (const bf16*)(P.ws + WS_K); const bf16* V = (const bf16*)(P.ws + WS_V); bf16* O = (bf16*)(P.ws + WS_Q);
    const float* CUM = (const float*)(P.ws + WS_CUM);
    const int lane = threadIdx.x & 63, wid = threadIdx.x >> 6;
    const int r = blockIdx.x * 4 + wid, bh = r / SEQ, t = r % SEQ, b = bh / NH, h = bh % NH;
    const size_t rowq = ((size_t)b * SEQ + t) * FW + h * HD;
    float* s_ = sc[wid];
    const float* cum = CUM + (size_t)bh * SEQ; const float ct = cum[t];
    const float scale = 0.08838834764831845f;
    float mx = -3.0e38f;
    for (int s0 = 0; s0 <= t; s0 += 64) {
        const int s = s0 + lane;
        if (s <= t) {
            const u32x4* kp = (const u32x4*)(K + ((size_t)b * SEQ + s) * FW + h * HD); const u32x4* qp = (const u32x4*)(Q + rowq);
            float d = 0.f;
#pragma unroll 4
            for (int c = 0; c < 16; ++c) { const u32x4 kv = kp[c], qv = qp[c];
#pragma unroll
                for (int e = 0; e < 4; ++e) d += bflo(kv[e]) * bflo(qv[e]) + bfhi(kv[e]) * bfhi(qv[e]); }
            const float lg = d * scale + (ct - cum[s]);
            s_[s] = lg; mx = fmaxf(mx, lg);
        }
    }
    mx = wave_max(mx);
    __syncthreads();
    float l = 0.f;
    for (int s = lane; s <= t; s += 64) { const float p = __expf(s_[s] - mx); s_[s] = p; l += p; }
    l = wave_sum(l);
    __syncthreads();
    float o0 = 0.f, o1 = 0.f;
    const unsigned* vp = (const unsigned*)(V + (size_t)b * SEQ * FW + h * HD) + lane;
    for (int s = 0; s <= t; ++s) { const float p = s_[s]; const unsigned w = vp[(size_t)s * (FW / 2)]; o0 += p * bflo(w); o1 += p * bfhi(w); }
    const float il = 1.0f / l;
    *((unsigned*)(O + rowq) + lane) = pk2(o0 * il, o1 * il);
}

#define LAS __attribute__((address_space(3)))
#define GAS __attribute__((address_space(1)))
typedef short bf16x8 __attribute__((ext_vector_type(8)));
typedef float f32x2 __attribute__((ext_vector_type(2)));
constexpr int NWAVES = 8;
constexpr int RING_OFF = 0, RING_BYTES = 131072;
constexpr int LDSCTL_OFF = RING_BYTES, MISC_OFF = LDSCTL_OFF + 320;
constexpr int SEGT_OFF = LDSCTL_OFF + 1024;
constexpr int LDS_BYTES = 147456;
constexpr int CW_BAR = 4096;
typedef __bf16 bf16x2_t __attribute__((ext_vector_type(2)));
__device__ __forceinline__ unsigned cvt_pk_bf16(float lo, float hi) { f32x2 v = {lo, hi}; bf16x2_t b = __builtin_convertvector(v, bf16x2_t); return __builtin_bit_cast(unsigned, b); }
__device__ __forceinline__ float fast_sigmoid(float v) { return __builtin_amdgcn_rcpf(1.0f + __builtin_amdgcn_exp2f(v * -1.4426950408889634f)); }

#define XB_TMO      128
#define XB_XCNT(j)  (256  + 64 * (j))
#define XB_XSUB(j)  (1280 + 64 * (j))
#define XB_XGEN(j)  (2304 + 64 * (j))
#define XB_TOP      3328
#define XB_TOPGEN   3392
#define XCD_BAR_WORDS 3456
#define XB_SPIN_CAP (1u << 18)
__device__ __forceinline__ unsigned xb_ld(unsigned* p)              { return __hip_atomic_load(p, __ATOMIC_RELAXED, __HIP_MEMORY_SCOPE_AGENT); }
__device__ __forceinline__ unsigned xb_add(unsigned* p, unsigned v) { return __hip_atomic_fetch_add(p, v, __ATOMIC_RELAXED, __HIP_MEMORY_SCOPE_AGENT); }
__device__ __forceinline__ unsigned xb_xcc_id() { return (unsigned)__builtin_amdgcn_s_getreg((3 << 11) | 20) & 0xFu; }
#define XB_SPIN(cond, bar) do { unsigned _sp = 0; while (cond) { __builtin_amdgcn_s_sleep(1); \
    if ((++_sp & 255u) == 0u) { if (xb_ld(&(bar)[XB_TMO])) break; if (_sp > XB_SPIN_CAP) { atomicAdd(&(bar)[XB_TMO], 1u); break; } } } } while (0)
struct XcdBarrier { unsigned* bar; unsigned x; volatile LAS unsigned* st; };
__device__ __forceinline__ XcdBarrier xcd_barrier_post(unsigned* bar, volatile LAS unsigned* st) {
    XcdBarrier b; b.bar = bar; b.x = xb_xcc_id(); b.st = st;
    if (threadIdx.x == 0) (void)xb_add(&bar[XB_XCNT(b.x)], 1u);
    return b;
}
__device__ __forceinline__ void xcd_barrier_complete(unsigned* bar, unsigned x, unsigned& nloc, unsigned& nx) {
    const unsigned G = gridDim.x * gridDim.y * gridDim.z;
    unsigned sum, cnt, mine, sp = 0u;
    for (;;) {
        sum = 0u; cnt = 0u; mine = 0u;
#pragma unroll
        for (unsigned j = 0; j < 16; ++j) { const unsigned c = xb_ld(&bar[XB_XCNT(j)]); sum += c; cnt += (c > 0u) ? 1u : 0u; mine = (j == x) ? c : mine; }
        if (sum == G) break;
        __builtin_amdgcn_s_sleep(1);
        if ((++sp & 255u) == 0u) { if (xb_ld(&bar[XB_TMO])) break; if (sp > XB_SPIN_CAP) { atomicAdd(&bar[XB_TMO], 1u); break; } }
    }
    nloc = mine > 0u ? mine : 1u; nx = cnt > 0u ? cnt : 1u;
}
__device__ __forceinline__ void xcd_barrier(const XcdBarrier& b) {
    asm volatile("s_waitcnt vmcnt(0)" ::: "memory");
    __syncthreads();
    if (threadIdx.x == 0) {
        unsigned* bar = b.bar;
        __builtin_amdgcn_s_waitcnt(0);
        unsigned nloc = b.st[0], nx = b.st[1];
        if (nloc == 0u) { xcd_barrier_complete(bar, b.x, nloc, nx); b.st[0] = nloc; b.st[1] = nx; }
        const unsigned old = xb_add(&bar[XB_XSUB(b.x)], 1u);
        const unsigned gen = old / nloc;
        if (old + 1u == (gen + 1u) * nloc) {
            __builtin_amdgcn_fence(__ATOMIC_RELEASE, "agent");
            asm volatile("s_waitcnt vmcnt(0)" ::: "memory");
            const unsigned og = xb_add(&bar[XB_TOP], 1u);
            const unsigned tg = og / nx;
            if (og + 1u == (tg + 1u) * nx) xb_add(&bar[XB_TOPGEN], 1u);
            else XB_SPIN(xb_ld(&bar[XB_TOPGEN]) == tg, bar);
            __builtin_amdgcn_fence(__ATOMIC_ACQUIRE, "agent");
            xb_add(&bar[XB_XGEN(b.x)], 1u);
            asm volatile("s_waitcnt vmcnt(0)" ::: "memory");
        } else {
            XB_SPIN(xb_ld(&bar[XB_XGEN(b.x)]) == gen, bar);
            __builtin_amdgcn_fence(__ATOMIC_ACQUIRE, "agent");
            asm volatile("s_waitcnt vmcnt(0)" ::: "memory");
        }
    }
    __syncthreads();
}

namespace pg8 {
constexpr int BM = 256, BK = 64, HALF = 128, HTB = HALF * BK * 2, STAGE_BYTES = 8 * HTB, NXCD = 8, WGM = 8;
__host__ __device__ __forceinline__ int lds_byte(int r, int c) { const int st = (r >> 4) * 2 + (c >> 5), rr = r & 15, cc = c & 31, ob = rr * 64 + cc * 2; return st * 1024 + (ob ^ (((ob >> 9) & 1) << 5)); }
__host__ __device__ __forceinline__ void stage_rc(int b, int& R, int& C) { const int st = b / 1024, sb = b % 1024, swz = sb ^ (((sb >> 9) & 1) << 5); R = (st >> 1) * 16 + swz / 64; C = (st & 1) * 32 + (swz % 64) / 2; }
__host__ __device__ __forceinline__ int perm32(int rho) { const int n = rho >> 4, i = rho & 15; return 8 * (i >> 2) + 4 * n + (i & 3); }

struct Unit { int pm, pn, seg, mt, nrow, slot0; const char* a; const char* b; };

struct StaticOrder {
    int nM, nN, nwg, G, c, K; const char* A; const char* Bt;
    __device__ void init(const void* A_, const void* Bt_, int M, int N, int K_, int G_, int c_) { A = (const char*)A_; Bt = (const char*)Bt_; nM = M / BM; nN = N / BM; nwg = nM * nN; G = G_; c = c_; K = K_; }
    __device__ bool next(int i, Unit& u) const {
        const long L = (long)i * G + c; if (L >= nwg) return false;
        int wgid = (int)L; { const int q = nwg / NXCD, r = nwg % NXCD, xcd = wgid % NXCD, off = wgid / NXCD; wgid = (xcd < r ? xcd * (q + 1) : r * (q + 1) + (xcd - r) * q) + off; }
        const int nig = WGM * nN, gid = wgid / nig, fm = gid * WGM, gsz = (nM - fm) < WGM ? (nM - fm) : WGM;
        u.pm = fm + ((wgid % nig) % gsz); u.pn = (wgid % nig) / gsz;
#if defined(REV_PN)
        u.pn = nN - 1 - u.pn;
#endif
        u.seg = 0; u.mt = 0; u.nrow = BM; u.slot0 = 0;
        u.a = A + (size_t)u.pm * BM * K * 2; u.b = Bt + (size_t)u.pn * BM * K * 2; return true;
    }
    __device__ __forceinline__ unsigned arow(const Unit&, int r) const { return (unsigned)r; }
};

template <class Epi, class Sched, bool GATHER>
__device__ __forceinline__ void gemm_phase(LAS unsigned char* lds, const int K, const Sched& S, const Epi& E) {
    const int tid = threadIdx.x, wid = __builtin_amdgcn_readfirstlane(tid >> 6), lane = tid & 63, wr = wid >> 2, wc = wid & 3, fr = lane & 15, fq = lane >> 4;
    const int nt = K / BK;
    int Rr[2], Cc[2]; unsigned voffB[2];
#pragma unroll
    for (int i = 0; i < 2; ++i) { int R, C; stage_rc(tid * 16 + i * 8192, R, C); const int Rb = Epi::PERM ? ((R & ~31) + perm32(R & 31)) : R; Rr[i] = R; Cc[i] = C; voffB[i] = (unsigned)(Rb * K + C) * 2u; }
    const size_t kstep = (size_t)(BK * 2);
    const size_t hstep = (size_t)HALF * K * 2;
    const unsigned ldsw = (unsigned)wid * 1024u;
    const int aoff = lds_byte(wr * 64 + fr, fq * 8), boff = lds_byte(wc * 32 + fr, fq * 8);
#define PG8_SA(b, h) (((b) * 2 + (h)) * HTB)
#define PG8_SB(b, h) ((4 + (b) * 2 + (h)) * HTB)
#define PG8_LD1(bufoff, gptr, i_) __builtin_amdgcn_global_load_lds((const unsigned*)(gptr), (LAS unsigned*)(lds + (bufoff) + ldsw + (i_) * 8192), 16, 0, 0)
#define PG8_STAGE_B(bufoff, gbase) do { PG8_LD1(bufoff, (const char*)(gbase) + voffB[0], 0); PG8_LD1(bufoff, (const char*)(gbase) + voffB[1], 1); } while (0)
#define PG8_STAGE_A(bufoff, gbase, v0, v1) do { PG8_LD1(bufoff, (const char*)(gbase) + (v0), 0); PG8_LD1(bufoff, (const char*)(gbase) + (v1), 1); } while (0)
#define PG8_LDA(dst, b, h) do { _Pragma("unroll") for (int m = 0; m < 4; ++m) _Pragma("unroll") for (int k = 0; k < 2; ++k) dst[m][k] = *(const LAS bf16x8*)(lds + PG8_SA(b, h) + aoff + m * 2048 + k * 1024); } while (0)
#define PG8_LDB(dst, b, h) do { _Pragma("unroll") for (int n = 0; n < 2; ++n) _Pragma("unroll") for (int k = 0; k < 2; ++k) dst[n][k] = *(const LAS bf16x8*)(lds + PG8_SB(b, h) + boff + n * 2048 + k * 1024); } while (0)
#define PG8_MMA(ai, bj, At, Bt) do { __builtin_amdgcn_s_setprio(1); _Pragma("unroll") for (int m = 0; m < 4; ++m) _Pragma("unroll") for (int n = 0; n < 2; ++n) _Pragma("unroll") for (int k = 0; k < 2; ++k) \
        acc[ai][bj][m][n] = __builtin_amdgcn_mfma_f32_16x16x32_bf16(Bt[n][k], At[m][k], acc[ai][bj][m][n], 0, 0, 0); __builtin_amdgcn_s_setprio(0); } while (0)
#define PG8_WAIT_V(n) asm volatile("s_waitcnt vmcnt(" #n ")" ::: "memory")
#define PG8_WAIT_L(n) asm volatile("s_waitcnt lgkmcnt(" #n ")" ::: "memory")
#define PG8_BAR __builtin_amdgcn_s_barrier()
#define PG8_SCHED __builtin_amdgcn_sched_barrier(0)
#define PG8_VOFFA(dst, u) do { _Pragma("unroll") for (int h_ = 0; h_ < 2; ++h_) _Pragma("unroll") for (int i_ = 0; i_ < 2; ++i_) \
        dst[h_][i_] = S.arow(u, h_ * HALF + Rr[i_]) * (unsigned)(K * 2) + (unsigned)(Cc[i_] * 2); } while (0)
    Unit cur, nxt; int ui = 0;
    if (!S.next(0, cur)) return;
    f32x4 acc[2][2][4][2];
#pragma unroll
    for (int a = 0; a < 2; ++a)
#pragma unroll
        for (int b = 0; b < 2; ++b)
#pragma unroll
            for (int m = 0; m < 4; ++m)
#pragma unroll
                for (int n = 0; n < 2; ++n) acc[a][b][m][n] = (f32x4){0.f, 0.f, 0.f, 0.f};
    bf16x8 At[4][2], B0[2][2], B1[2][2];
    unsigned voffA[2][2];
    PG8_VOFFA(voffA, cur);
    const char* cA = cur.a; const char* cB = cur.b;
    PG8_STAGE_B(PG8_SB(0, 0), cB); PG8_STAGE_B(PG8_SB(0, 1), cB + hstep); PG8_STAGE_A(PG8_SA(0, 0), cA, voffA[0][0], voffA[0][1]); PG8_STAGE_A(PG8_SA(0, 1), cA, voffA[1][0], voffA[1][1]);
    if (wr == 1) PG8_BAR;
    PG8_WAIT_V(2); PG8_BAR;
    PG8_STAGE_B(PG8_SB(1, 0), cB + kstep); PG8_STAGE_A(PG8_SA(1, 0), cA + kstep, voffA[0][0], voffA[0][1]); PG8_STAGE_B(PG8_SB(1, 1), cB + hstep + kstep);
    PG8_WAIT_V(6); PG8_BAR;
    for (;;) {
        const bool has_next = S.next(ui + 1, nxt);
        const char* nA = has_next ? nxt.a : cA; const char* nB = has_next ? nxt.b : cB;
#pragma unroll 1
        for (int t = 0; t < nt; t += 2) {
            const bool last = (t == nt - 2);
            const char* a1 = cA + (size_t)(t + 1) * kstep;
            const char* a2 = last ? nA : cA + (size_t)(t + 2) * kstep; const char* b2 = last ? nB : cB + (size_t)(t + 2) * kstep;
            const char* a3 = a2 + kstep; const char* b3 = b2 + kstep;
            PG8_LDB(B0, 0, 0); PG8_LDB(B1, 0, 1); PG8_SCHED; PG8_LDA(At, 0, 0); PG8_STAGE_A(PG8_SA(1, 1), a1, voffA[1][0], voffA[1][1]);
            if constexpr (GATHER) { if (last && has_next) { PG8_VOFFA(voffA, nxt); } }
            PG8_WAIT_V(8); PG8_WAIT_L(0); PG8_BAR; PG8_MMA(0, 0, At, B0); PG8_MMA(0, 1, At, B1); PG8_BAR; PG8_SCHED;
            PG8_LDA(At, 0, 1); PG8_STAGE_B(PG8_SB(0, 0), b2); PG8_STAGE_B(PG8_SB(0, 1), b2 + hstep); PG8_STAGE_A(PG8_SA(0, 0), a2, voffA[0][0], voffA[0][1]);
            PG8_WAIT_V(8); PG8_WAIT_L(0); PG8_BAR; PG8_MMA(1, 0, At, B0); PG8_MMA(1, 1, At, B1); PG8_BAR; PG8_SCHED;
            PG8_LDB(B0, 1, 0); PG8_LDB(B1, 1, 1); PG8_SCHED; PG8_LDA(At, 1, 0); PG8_STAGE_A(PG8_SA(0, 1), a2, voffA[1][0], voffA[1][1]);
            PG8_WAIT_V(8); PG8_WAIT_L(0); PG8_BAR; PG8_MMA(0, 0, At, B0); PG8_MMA(0, 1, At, B1); PG8_BAR; PG8_SCHED;
            PG8_LDA(At, 1, 1); PG8_STAGE_B(PG8_SB(1, 0), b3); PG8_STAGE_B(PG8_SB(1, 1), b3 + hstep); PG8_STAGE_A(PG8_SA(1, 0), a3, voffA[0][0], voffA[0][1]);
            PG8_WAIT_V(8); PG8_WAIT_L(0); PG8_BAR; PG8_MMA(1, 0, At, B0); PG8_MMA(1, 1, At, B1); PG8_BAR; PG8_SCHED;
        }
        if (wr == 0) PG8_BAR;
        E(acc, cur, wr, wc, fr, fq);
        if (!has_next) break;
#pragma unroll
        for (int a = 0; a < 2; ++a)
#pragma unroll
            for (int b = 0; b < 2; ++b)
#pragma unroll
                for (int m = 0; m < 4; ++m)
#pragma unroll
                    for (int n = 0; n < 2; ++n) acc[a][b][m][n] = (f32x4){0.f, 0.f, 0.f, 0.f};
        cur = nxt; cA = nA; cB = nB; ++ui;
        if (wr == 1) PG8_BAR;
    }
    PG8_WAIT_V(0);
    PG8_BAR;
#undef PG8_SA
#undef PG8_SB
#undef PG8_LD1
#undef PG8_STAGE_A
#undef PG8_STAGE_B
#undef PG8_LDA
#undef PG8_LDB
#undef PG8_MMA
#undef PG8_WAIT_V
#undef PG8_WAIT_L
#undef PG8_BAR
#undef PG8_SCHED
#undef PG8_VOFFA
}

typedef const f32x4 (&AccRef)[2][2][4][2];
__device__ __forceinline__ u32x4 pack8(f32x4 v0, f32x4 v1) { u32x4 w; w.x = cvt_pk_bf16(v0[0], v0[1]); w.y = cvt_pk_bf16(v0[2], v0[3]); w.z = cvt_pk_bf16(v1[0], v1[1]); w.w = cvt_pk_bf16(v1[2], v1[3]); return w; }
__device__ __forceinline__ f32x4 sig4(f32x4 v) { return (f32x4){fast_sigmoid(v[0]), fast_sigmoid(v[1]), fast_sigmoid(v[2]), fast_sigmoid(v[3])}; }
__device__ __forceinline__ f32x4 bflo4(u32x4 w) { return (f32x4){bflo(w.x), bfhi(w.x), bflo(w.y), bfhi(w.y)}; }
__device__ __forceinline__ f32x4 bfhi4(u32x4 w) { return (f32x4){bflo(w.z), bfhi(w.z), bflo(w.w), bfhi(w.w)}; }

struct EpiIn {
    static constexpr bool PERM = true;
    unsigned char* ws;
    __device__ __forceinline__ void operator()(AccRef acc, const Unit& u, int wr, int wc, int fr, int fq) const {
        asm volatile("" : "+v"(fr), "+v"(fq));
        const int row0 = u.pm * BM + wr * 64 + fr, cw = wc * 32 + 8 * fq;
        const int pn = u.pn;
        if (pn < 12 || (pn >= 20 && pn < 24)) {
            bf16* base; if (pn < 12) base = (bf16*)(ws + WS_Q) + (size_t)(pn >> 2) * ((size_t)T * FW) + (pn & 3) * BM; else base = (bf16*)(ws + WS_BG) + (pn - 20) * BM;
#pragma unroll
            for (int ai = 0; ai < 2; ++ai)
#pragma unroll
                for (int m = 0; m < 4; ++m) { bf16* rowp = base + (size_t)(row0 + ai * HALF + m * 16) * FW + cw;
#pragma unroll
                    for (int bj = 0; bj < 2; ++bj) *(u32x4*)(rowp + bj * HALF) = pack8(acc[ai][bj][m][0], acc[ai][bj][m][1]); }
        } else if (pn < 20) {
            bf16* base = (bf16*)(ws + WS_Z) + (pn - 12) * HALF;
#pragma unroll
            for (int ai = 0; ai < 2; ++ai)
#pragma unroll
                for (int m = 0; m < 4; ++m) { bf16* rowp = base + (size_t)(row0 + ai * HALF + m * 16) * CW + cw;
                    *(u32x4*)rowp = pack8(acc[ai][0][m][0] * acc[ai][1][m][0], acc[ai][0][m][1] * acc[ai][1][m][1]); }
        } else {
            bf16* base = (bf16*)(ws + WS_GAB) + (pn - 24) * BM;
#pragma unroll
            for (int ai = 0; ai < 2; ++ai)
#pragma unroll
                for (int m = 0; m < 4; ++m) { bf16* rowp = base + (size_t)(row0 + ai * HALF + m * 16) * 4096 + cw;
#pragma unroll
                    for (int bj = 0; bj < 2; ++bj) *(u32x4*)(rowp + bj * HALF) = pack8(sig4(acc[ai][bj][m][0]), sig4(acc[ai][bj][m][1])); }
        }
    }
};

template <int PASS> struct EpiMerge {
    static constexpr bool PERM = true;
    unsigned char* ws;
    __device__ __forceinline__ void operator()(AccRef acc, const Unit& u, int wr, int wc, int fr, int fq) const {
        asm volatile("" : "+v"(fr), "+v"(fq));
        const int row0 = u.pm * BM + wr * 64 + fr, c0 = u.pn * BM + wc * 32 + 8 * fq;
        const bf16* G = (const bf16*)(ws + WS_GAB) + PASS * DM; bf16* MG = (bf16*)(ws + WS_MERGED);
#pragma unroll
        for (int ai = 0; ai < 2; ++ai)
#pragma unroll
            for (int m = 0; m < 4; ++m) { const size_t row = (size_t)(row0 + ai * HALF + m * 16);
#pragma unroll
                for (int bj = 0; bj < 2; ++bj) { const u32x4 gv = *(const u32x4*)(G + row * 4096 + c0 + bj * HALF);
                    f32x4 v0 = acc[ai][bj][m][0] * bflo4(gv), v1 = acc[ai][bj][m][1] * bfhi4(gv);
                    if (PASS == 1) { const u32x4 tv = *(const u32x4*)(MG + row * DM + c0 + bj * HALF); v0 += bflo4(tv); v1 += bfhi4(tv); }
                    *(u32x4*)(MG + row * DM + c0 + bj * HALF) = pack8(v0, v1); } }
    }
};
struct EpiX1 {
    static constexpr bool PERM = true;
    const float* x; float* out; bf16* X1B;
    __device__ __forceinline__ void operator()(AccRef acc, const Unit& u, int wr, int wc, int fr, int fq) const {
        asm volatile("" : "+v"(fr), "+v"(fq));
        const int row0 = u.pm * BM + wr * 64 + fr, c0 = u.pn * BM + wc * 32 + 8 * fq;
#pragma unroll
        for (int ai = 0; ai < 2; ++ai)
#pragma unroll
            for (int m = 0; m < 4; ++m) { const size_t off = (size_t)(row0 + ai * HALF + m * 16) * DM + c0;
#pragma unroll
                for (int bj = 0; bj < 2; ++bj) { const f32x4 a0 = *(const f32x4*)(x + off + bj * HALF), a1 = *(const f32x4*)(x + off + bj * HALF + 4);
                    const f32x4 v0 = a0 + acc[ai][bj][m][0], v1 = a1 + acc[ai][bj][m][1];
                    *(f32x4*)(out + off + bj * HALF) = v0; *(f32x4*)(out + off + bj * HALF + 4) = v1; *(u32x4*)(X1B + off + bj * HALF) = pack8(v0, v1); }
                if (m & 1) asm volatile("" ::: "memory"); }
    }
};
struct EpiPlain {
    static constexpr bool PERM = true;
    bf16* O; int ldc;
    __device__ __forceinline__ void operator()(AccRef acc, const Unit& u, int wr, int wc, int fr, int fq) const {
        asm volatile("" : "+v"(fr), "+v"(fq));
        const int row0 = u.pm * BM + wr * 64 + fr, c0 = u.pn * BM + wc * 32 + 8 * fq;
#pragma unroll
        for (int ai = 0; ai < 2; ++ai)
#pragma unroll
            for (int m = 0; m < 4; ++m) { bf16* rowp = O + (size_t)(row0 + ai * HALF + m * 16) * ldc + c0;
#pragma unroll
                for (int bj = 0; bj < 2; ++bj) *(u32x4*)(rowp + bj * HALF) = pack8(acc[ai][bj][m][0], acc[ai][bj][m][1]); }
    }
};
struct EpiPle {
    static constexpr bool PERM = true;
    float* out; const bf16* PP; const float* RS;
    __device__ __forceinline__ void operator()(AccRef acc, const Unit& u, int wr, int wc, int fr, int fq) const {
        asm volatile("" : "+v"(fr), "+v"(fq));
        const int row0 = u.pm * BM + wr * 64 + fr, c0 = u.pn * BM + wc * 32 + 8 * fq;
#pragma unroll
        for (int ai = 0; ai < 2; ++ai)
#pragma unroll
            for (int m = 0; m < 4; ++m) { const int row = row0 + ai * HALF + m * 16; const size_t off = (size_t)row * DM + c0; const float r = RS[row];
#pragma unroll
                for (int bj = 0; bj < 2; ++bj) { const u32x4 pv = *(const u32x4*)(PP + off + bj * HALF);
                    const f32x4 a0 = *(const f32x4*)(out + off + bj * HALF), a1 = *(const f32x4*)(out + off + bj * HALF + 4);
                    *(f32x4*)(out + off + bj * HALF) = a0 + sig4(acc[ai][bj][m][0] * r) * bflo4(pv);
                    *(f32x4*)(out + off + bj * HALF + 4) = a1 + sig4(acc[ai][bj][m][1] * r) * bfhi4(pv); } }
    }
};

struct SegOrder {
    const LAS int* tab;
    int nN, G, c, seg_lo, seg_hi, K, down; const char* A; const char* Bt; const int* TOKL;
    __device__ __forceinline__ int rd(int i) const { return __builtin_amdgcn_readfirstlane(tab[i]); }
    __device__ bool next(int i, Unit& u) const {
        const int m_lo = rd(64 + seg_lo), m_hi = rd(64 + seg_hi);
        const long L = (long)i * G + c; if (L >= (long)(m_hi - m_lo) * nN) return false;
        const int mtile = m_lo + (int)(L / nN); u.pn = (int)(L % nN);
        int s = seg_lo; while (s + 1 < seg_hi && rd(64 + s + 1) <= mtile) ++s;
        u.seg = s; u.mt = mtile - rd(64 + s); u.pm = 0; const int left = rd(s) - u.mt * BM; u.nrow = left < BM ? left : BM; u.slot0 = rd(129 + s) + u.mt * BM;
        const int e = s & 31;
        if (down) { u.a = A + (size_t)u.slot0 * K * 2; u.b = Bt + ((size_t)e * DM + (size_t)u.pn * BM) * K * 2; }
        else { u.a = A; u.b = Bt + ((size_t)e * 2 * FF + (size_t)u.pn * BM) * K * 2; }
        return true;
    }
    __device__ __forceinline__ unsigned arow(const Unit& u, int r) const {
        if (down) return (unsigned)r;
        const int rr = r < u.nrow ? r : u.nrow - 1;
        return (unsigned)TOKL[(size_t)u.seg * T + u.mt * BM + rr];
    }
};
struct EpiGU {
    static constexpr bool PERM = true;
    unsigned char* ws;
    __device__ __forceinline__ void operator()(AccRef acc, const Unit& u, int wr, int wc, int fr, int fq) const {
        asm volatile("" : "+v"(fr), "+v"(fq));
        const int* TOKL = (const int*)(ws + WS_TOKL) + (size_t)u.seg * T + u.mt * BM; const float* RS = (const float*)(ws + WS_RSTD2); const float* WTS = (const float*)(ws + WS_WTS) + (u.seg >> 5);
        bf16* H = (bf16*)(ws + WS_HACT) + (size_t)u.slot0 * FF + u.pn * HALF + wc * 32 + 8 * fq;
#pragma unroll
        for (int ai = 0; ai < 2; ++ai)
#pragma unroll
            for (int m = 0; m < 4; ++m) { const int r = ai * HALF + wr * 64 + m * 16 + fr; const bool live = r < u.nrow; const int tok = TOKL[live ? r : 0];
                const float rs = RS[tok], wt = WTS[2 * tok];
                f32x4 g0 = acc[ai][0][m][0] * rs, g1 = acc[ai][0][m][1] * rs; const f32x4 u0 = acc[ai][1][m][0] * (rs * wt), u1 = acc[ai][1][m][1] * (rs * wt);
                g0 = g0 * sig4(g0) * u0; g1 = g1 * sig4(g1) * u1;
                if (live) *(u32x4*)(H + (size_t)r * FF) = pack8(g0, g1); }
    }
};
template <bool LAST> struct EpiDN {
    static constexpr bool PERM = true;
    unsigned char* ws; float* out;
    __device__ __forceinline__ void operator()(AccRef acc, const Unit& u, int wr, int wc, int fr, int fq) const {
        asm volatile("" : "+v"(fr), "+v"(fq));
        const int* TOKL = (const int*)(ws + WS_TOKL) + (size_t)u.seg * T + u.mt * BM; bf16* X2B = (bf16*)(ws + WS_X2B);
        const int c0 = u.pn * BM + wc * 32 + 8 * fq;
#pragma unroll
        for (int ai = 0; ai < 2; ++ai)
#pragma unroll
            for (int m = 0; m < 4; ++m) { const int r = ai * HALF + wr * 64 + m * 16 + fr; const bool live = r < u.nrow; const int tok = TOKL[live ? r : 0];
                const size_t off = (size_t)tok * DM + c0;
#pragma unroll
                for (int bj = 0; bj < 2; ++bj) { const f32x4 a0 = *(const f32x4*)(out + off + bj * HALF), a1 = *(const f32x4*)(out + off + bj * HALF + 4);
                    const f32x4 v0 = a0 + acc[ai][bj][m][0], v1 = a1 + acc[ai][bj][m][1];
                    if (live) { *(f32x4*)(out + off + bj * HALF) = v0; *(f32x4*)(out + off + bj * HALF + 4) = v1; if (LAST) *(u32x4*)(X2B + off + bj * HALF) = pack8(v0, v1); } } }
    }
};
}

namespace fox {
typedef short s16x4 __attribute__((ext_vector_type(4)));
typedef float f32x16 __attribute__((ext_vector_type(16)));
constexpr int D = 128, LDQ = 1024, NW = 8, QBLK = 32, KVBLK = 64, QB = NW * QBLK;
constexpr float SCALE = 0.08838834764831845f, INVS = 11.313708498984761f, THR = 8.f;
constexpr int SHM_V = KVBLK * D * 2, SHM_K = KVBLK * D * 2;
constexpr int OFF_WS = 2 * SHM_V + 2 * SHM_K, OFF_B = OFF_WS + NW * 64 * 4, LDS_ATT = OFF_B + SEQ * 4;
#define KSWZ(row, colB) ((row) * 256 + ((colB) ^ (((row) & 7) << 4)))
#define SBAR() __builtin_amdgcn_sched_barrier(0)
__device__ __forceinline__ int v_st(int k, int c) { const int kk = (k & ~0xC) | ((k & 4) << 1) | ((k & 8) >> 1); return ((kk >> 3) * 4 + (c >> 5)) * 512 + ((kk & 7) * 32 + (c & 31)) * 2; }
__device__ __forceinline__ int v_rd_base(int lane) { return ((lane & 3) << 3) | (((lane >> 2) & 3) << 6) | (((lane >> 4) & 1) << 5) | (((lane >> 5) & 1) << 8); }
constexpr int v_rd_off(int d0, int ks, int half) { return d0 * 512 + ks * 4096 + half * 2048; }
__device__ __forceinline__ int crow(int r, int hi) { return (r & 3) + 8 * (r >> 2) + 4 * hi; }
__device__ __forceinline__ unsigned cvtpk(float lo, float hi) { return cvt_pk_bf16(lo, hi); }
__device__ __forceinline__ void mask_tile(f32x16& p0, f32x16& p1, int dq) {
    const float NEG = -__builtin_inff();
#pragma unroll
    for (int r = 0; r < 16; ++r) { const int c = (r & 3) + 8 * (r >> 2);
        if (dq - c < 0) p0[r] = NEG;
        if (dq - c - 32 < 0) p1[r] = NEG; }
}
__device__ __forceinline__ void partialSM(f32x16& p0, f32x16& p1, float& m_reg, float& mn, float& alpha) {
    float pmax = p0[0];
#pragma unroll
    for (int r = 1; r < 16; ++r) pmax = fmaxf(pmax, p0[r]);
#pragma unroll
    for (int r = 0; r < 16; ++r) pmax = fmaxf(pmax, p1[r]);
    { auto rr = __builtin_amdgcn_permlane32_swap(__float_as_uint(pmax), __float_as_uint(pmax), false, false);
      pmax = fmaxf(__uint_as_float(rr[0]), __uint_as_float(rr[1])); }
    constexpr float C2 = 1.4426950408889634f * SCALE;
    if (__builtin_expect(__all((pmax - m_reg) * SCALE <= THR), 1)) { mn = m_reg; alpha = 1.f; }
    else { mn = fmaxf(m_reg, pmax); alpha = __builtin_amdgcn_exp2f((m_reg - mn) * C2); m_reg = mn; }
    const float mnL = -mn * C2;
#pragma unroll
    for (int r = 0; r < 16; ++r) p0[r] = fmaf(p0[r], C2, mnL);
#pragma unroll
    for (int r = 0; r < 16; ++r) p1[r] = fmaf(p1[r], C2, mnL);
#pragma unroll
    for (int r = 0; r < 16; ++r) p0[r] = __builtin_amdgcn_exp2f(p0[r]);
}
__device__ __forceinline__ void finishSM(f32x16& p0, f32x16& p1, float alpha, float& l_reg, bf16x8& pa0, bf16x8& pa1, bf16x8& pa2, bf16x8& pa3) {
#pragma unroll
    for (int r = 0; r < 16; ++r) p1[r] = __builtin_amdgcn_exp2f(p1[r]);
    float ps = 0;
#pragma unroll
    for (int r = 0; r < 16; ++r) ps += p0[r];
#pragma unroll
    for (int r = 0; r < 16; ++r) ps += p1[r];
    { auto rr = __builtin_amdgcn_permlane32_swap(__float_as_uint(ps), __float_as_uint(ps), false, false);
      ps = __uint_as_float(rr[0]) + __uint_as_float(rr[1]); }
    l_reg = l_reg * alpha + ps;
#define PK4(P, B_, OUT) do { unsigned a0 = cvtpk(P[B_+0], P[B_+1]), a1 = cvtpk(P[B_+2], P[B_+3]);                          \
        unsigned b0 = cvtpk(P[B_+4], P[B_+5]), b1 = cvtpk(P[B_+6], P[B_+7]);                                             \
        auto r0 = __builtin_amdgcn_permlane32_swap(a0, b0, false, false); auto r1 = __builtin_amdgcn_permlane32_swap(a1, b1, false, false); \
        u32x4 w = {r0[0], r1[0], r0[1], r1[1]}; OUT = __builtin_bit_cast(bf16x8, w); } while (0)
    PK4(p0, 0, pa0); PK4(p0, 8, pa1); PK4(p1, 0, pa2); PK4(p1, 8, pa3);
#undef PK4
}
template <int KB>
__device__ __forceinline__ void qkt(f32x16& p0, f32x16& p1, const char* K_lds, const char* bias_t, int r32, int hi, const bf16x8* qr) {
    const f32x4* bl = (const f32x4*)(bias_t + hi * 16);
#pragma unroll
    for (int q = 0; q < 4; ++q) { const f32x4 b0 = bl[2 * q], b1 = bl[8 + 2 * q];
        p0[4 * q] = b0.x; p0[4 * q + 1] = b0.y; p0[4 * q + 2] = b0.z; p0[4 * q + 3] = b0.w;
        p1[4 * q] = b1.x; p1[4 * q + 1] = b1.y; p1[4 * q + 2] = b1.z; p1[4 * q + 3] = b1.w; }
    const char* kb[4];
#pragma unroll
    for (int dd = 0; dd < 4; ++dd) kb[dd] = K_lds + KB * SHM_K + KSWZ(r32, (dd * 16 + hi * 8) * 2);
#pragma unroll
    for (int d0 = 0; d0 < 8; ++d0) { const char* a = kb[d0 & 3] + (d0 >> 2) * 128;
        bf16x8 b0 = *reinterpret_cast<const bf16x8*>(a);
        bf16x8 b1 = *reinterpret_cast<const bf16x8*>(a + 32 * 256);
        p0 = __builtin_amdgcn_mfma_f32_32x32x16_bf16(b0, qr[d0], p0, 0, 0, 0);
        p1 = __builtin_amdgcn_mfma_f32_32x32x16_bf16(b1, qr[d0], p1, 0, 0, 0); }
}
template <int VB>
__device__ __forceinline__ void pv_tile(f32x16* o, int vb0, bf16x8 pa0, bf16x8 pa1, bf16x8 pa2, bf16x8 pa3) {
#define TRRD(dst, off) asm volatile("ds_read_b64_tr_b16 %0, %1 offset:%2" : "=&v"(dst) : "v"(vb0), "i"(off) : "memory")
#define PV_D0(d0) do { s16x4 l0, l1, l2, l3, h0, h1, h2, h3; constexpr int b_ = VB * SHM_V + v_rd_off(d0, 0, 0);   \
        TRRD(l0, b_); TRRD(h0, b_ + 2048); TRRD(l1, b_ + 4096); TRRD(h1, b_ + 6144); TRRD(l2, b_ + 8192); TRRD(h2, b_ + 10240); TRRD(l3, b_ + 12288); TRRD(h3, b_ + 14336); \
        asm volatile("s_waitcnt lgkmcnt(0)" ::: "memory"); SBAR();   \
        o[d0] = __builtin_amdgcn_mfma_f32_32x32x16_bf16(pa0, (bf16x8){l0[0], l0[1], l0[2], l0[3], h0[0], h0[1], h0[2], h0[3]}, o[d0], 0, 0, 0);   \
        o[d0] = __builtin_amdgcn_mfma_f32_32x32x16_bf16(pa1, (bf16x8){l1[0], l1[1], l1[2], l1[3], h1[0], h1[1], h1[2], h1[3]}, o[d0], 0, 0, 0);   \
        o[d0] = __builtin_amdgcn_mfma_f32_32x32x16_bf16(pa2, (bf16x8){l2[0], l2[1], l2[2], l2[3], h2[0], h2[1], h2[2], h2[3]}, o[d0], 0, 0, 0);   \
        o[d0] = __builtin_amdgcn_mfma_f32_32x32x16_bf16(pa3, (bf16x8){l3[0], l3[1], l3[2], l3[3], h3[0], h3[1], h3[2], h3[3]}, o[d0], 0, 0, 0); } while (0)
    PV_D0(0); PV_D0(1); PV_D0(2); PV_D0(3);
#undef PV_D0
#undef TRRD
}
struct BlockRef { const bf16* Q; const bf16* K; const bf16* V; bf16* O; const float* C; int P0; float cref; };
struct Seam { bf16x8 qr[8]; bf16x8 st_v0, st_v1, st_k0, st_k1; };
__device__ __forceinline__ bf16x8 load8(const bf16* p) { return *reinterpret_cast<const bf16x8*>(p); }
#define ROW(p, k0, rr) ((p) + (size_t)((k0) + (rr)) * LDQ + sc)
#define VMW() asm volatile("s_waitcnt vmcnt(0)" ::: "memory")
#define VMWN(n) asm volatile("s_waitcnt vmcnt(%0)" :: "i"(n) : "memory")
#define SLOAD_H(Kp, Vp, k0) do { S.st_v0 = load8(ROW(Vp, k0, sr)); S.st_v1 = load8(ROW(Vp, k0, 32 + sr));              \
                         S.st_k0 = load8(ROW(Kp, k0, sr)); S.st_k1 = load8(ROW(Kp, k0, 32 + sr)); } while (0)
#define SWRITE_HK(bf) do { *(bf16x8*)(K_lds + (bf) * SHM_K + kws) = S.st_k0; *(bf16x8*)(K_lds + (bf) * SHM_K + kws + 32 * 256) = S.st_k1; } while (0)
#define SWRITE_HV(bf) do { *(bf16x8*)(V_lds + (bf) * SHM_V + vst0) = S.st_v0; *(bf16x8*)(V_lds + (bf) * SHM_V + vst1) = S.st_v1; } while (0)
#define SWRITE_H(bf) do { SWRITE_HV(bf); SWRITE_HK(bf); } while (0)
#define BIAS_FILL(ref_) do { int k_ = (int)threadIdx.x * 4; asm volatile("" : "+v"(k_)); for (; k_ < (ref_).P0 + QB; k_ += NW * 64 * 4) *(f32x4*)(B_lds + k_ * 4) = ((ref_).cref - *(const f32x4*)((ref_).C + k_)) * INVS; } while (0)
__device__ __forceinline__ void prime(const BlockRef& cur, char* lds, Seam& S) {
    const int tid = threadIdx.x, wid = __builtin_amdgcn_readfirstlane(tid >> 6), lane = tid & 63, r32 = lane & 31, hi = lane >> 5;
    const int sr = tid >> 4, sc = (tid & 15) * 8, kws = KSWZ(sr, sc * 2); char* K_lds = lds + 2 * SHM_V; char* B_lds = lds + OFF_B;
#pragma unroll
    for (int d0 = 0; d0 < 8; ++d0) S.qr[d0] = load8(cur.Q + (size_t)(wid * QBLK + r32) * LDQ + d0 * 16 + hi * 8);
    SLOAD_H(cur.K, cur.V, 0); BIAS_FILL(cur); VMW(); SWRITE_HK(0);
    __syncthreads();
}
__device__ __forceinline__ void block(const BlockRef& cur, const BlockRef& nxt, char* lds, Seam& S) {
    const int tid = threadIdx.x, wid = __builtin_amdgcn_readfirstlane(tid >> 6), lane = tid & 63, r32 = lane & 31, hi = lane >> 5;
    const int NT = (cur.P0 + QB) / KVBLK;
    const int qlo = cur.P0 + wid * QBLK, qm = qlo + r32 - 4 * hi;
    char* V_lds = lds; char* K_lds = lds + 2 * SHM_V; char* B_lds = lds + OFF_B;
    float* ws = (float*)(lds + OFF_WS) + wid * 64; float* li_l = ws, * al_l = ws + 32;
    float m_reg = -1e30f, l_reg = 0; f32x16 o[4] = {};
    const int sr = tid >> 4, sc = (tid & 15) * 8, vst0 = v_st(sr, sc), vst1 = v_st(32 + sr, sc), kws = KSWZ(sr, sc * 2);
    const int vb0 = (int)(uintptr_t)V_lds + v_rd_base(lane);
    const bf16* Kh = cur.K; const bf16* Vh = cur.V;
#define RESC(a) do { if (__any((a) < 1.f)) { if (hi == 0) al_l[r32] = (a); asm volatile("s_waitcnt lgkmcnt(0)" ::: "memory");              \
                     for (int d_ = 0; d_ < 4; ++d_) for (int r = 0; r < 16; ++r) o[d_][r] *= al_l[crow(r, hi)]; } } while (0)
#define KBASE(t) ((t) * KVBLK)
#define MASKT(P0_, P1_, t) do { const int kb_ = KBASE(t); if (kb_ + KVBLK - 1 > qlo) mask_tile(P0_, P1_, qm - kb_); } while (0)
    constexpr int NQL = 8;
#define SEAM_K0() do { VMWN(NQL); SWRITE_HK(0); SBAR(); } while (0)
    f32x16 pA0, pA1, pB0, pB1; float mnA, mnB, alA, alB; bf16x8 pa0, pa1, pa2, pa3;
    SWRITE_HV(0); SBAR();
    SLOAD_H(Kh, Vh, KBASE(1));
    SBAR(); qkt<0>(pA0, pA1, K_lds, B_lds, r32, hi, S.qr);
    MASKT(pA0, pA1, 0); partialSM(pA0, pA1, m_reg, mnA, alA);
    VMW(); SWRITE_H(1);
    __syncthreads();
#define HALF_STEP(PX0, PX1, mnX, alX, PY0, PY1, alY, t, KB, VB, SB) do {                                                      \
        SBAR(); qkt<KB>(PX0, PX1, K_lds, B_lds + (t) * 256, r32, hi, S.qr);                                             \
        finishSM(PY0, PY1, alY, l_reg, pa0, pa1, pa2, pa3); SBAR();                                                           \
        if ((t) + 1 < NT) { SLOAD_H(Kh, Vh, KBASE((t) + 1)); SBAR(); }                                               \
        pv_tile<VB>(o, vb0, pa0, pa1, pa2, pa3); MASKT(PX0, PX1, (t)); partialSM(PX0, PX1, m_reg, mnX, alX);                                        \
        __syncthreads();                                                                                                      \
        if ((t) + 1 < NT) { VMW(); SWRITE_H(SB); }                                                                          \
        RESC(alX); __syncthreads(); } while (0)
    for (int t = 1; t + 1 < NT; t += 2) {
        HALF_STEP(pB0, pB1, mnB, alB, pA0, pA1, alA, t, 1, 0, 0);
        HALF_STEP(pA0, pA1, mnA, alA, pB0, pB1, alB, t + 1, 0, 1, 1);
    }
    SBAR(); qkt<1>(pB0, pB1, K_lds, B_lds + (NT - 1) * 256, r32, hi, S.qr); SBAR();
    SLOAD_H(nxt.K, nxt.V, 0); SBAR();
#pragma unroll
    for (int d0 = 0; d0 < 8; ++d0) S.qr[d0] = load8(nxt.Q + (size_t)(wid * QBLK + r32) * LDQ + d0 * 16 + hi * 8);
    SBAR();
    finishSM(pA0, pA1, alA, l_reg, pa0, pa1, pa2, pa3); SBAR();
    pv_tile<0>(o, vb0, pa0, pa1, pa2, pa3);
    MASKT(pB0, pB1, NT - 1); partialSM(pB0, pB1, m_reg, mnB, alB); __syncthreads(); RESC(alB);
    finishSM(pB0, pB1, alB, l_reg, pa0, pa1, pa2, pa3); SBAR(); pv_tile<1>(o, vb0, pa0, pa1, pa2, pa3);
    SBAR(); SEAM_K0();
    if (hi == 0) li_l[r32] = l_reg; asm volatile("s_waitcnt lgkmcnt(0)" ::: "memory");
    float rli[16];
#pragma unroll
    for (int r = 0; r < 16; ++r) rli[r] = __builtin_amdgcn_rcpf(li_l[crow(r, hi)]);
    bf16* Ow = cur.O + (size_t)(wid * QBLK) * LDQ;
#pragma unroll
    for (int r = 0; r < 16; ++r) { const int orow = crow(r, hi);
#pragma unroll
        for (int d0 = 0; d0 < 4; ++d0) { const float v = o[d0][r] * rli[r];
            const float vn = __shfl_xor(v, 1);
            if ((r32 & 1) == 0) *(unsigned*)(Ow + (size_t)orow * LDQ + d0 * 32 + r32) = cvtpk(v, vn); } }
    BIAS_FILL(nxt);
    __syncthreads();
#undef RESC
#undef KBASE
#undef MASKT
#undef SEAM_K0
#undef HALF_STEP
}
#undef ROW
#undef VMW
#undef VMWN
#undef SLOAD_H
#undef SWRITE_HK
#undef SWRITE_HV
#undef SWRITE_H
#undef BIAS_FILL
#undef KSWZ
#undef SBAR
__device__ __forceinline__ BlockRef ref(int L, int pass, const bf16* Q, const bf16* K, const bf16* V, bf16* O, const float* CUM) {
    const int k = L >> 3, bh = (k >> 3) * 8 + (L & 7), x = k & 7, qb = pass ? 15 - x : x, b = bh / NH, h = bh % NH;
    BlockRef r; const size_t base = (size_t)b * SEQ * LDQ + h * D;
    r.Q = Q + base + (size_t)qb * QB * LDQ; r.O = O + base + (size_t)qb * QB * LDQ; r.K = K + base; r.V = V + base; r.C = CUM + (size_t)bh * SEQ; r.P0 = qb * QB; r.cref = r.C[r.P0];
    return r;
}
__device__ __forceinline__ void attn_phase(char* lds, const bf16* Q, const bf16* K, const bf16* V, bf16* O, const float* CUM, int G, int blk) {
    constexpr int TOTAL = BATCH * NH * 8;
    int L = blk; if (L >= TOTAL) return;
    int pass = 0;
    BlockRef cur = ref(L, 0, Q, K, V, O, CUM);
    Seam S;
    prime(cur, lds, S);
    for (;;) {
        const bool more_pass = pass == 0, more_item = L + G < TOTAL, last = !more_pass && !more_item;
        int passn = pass + 1, Ln = L;
        if (!more_pass) { passn = 0; Ln = more_item ? L + G : L; }
        const BlockRef nxt = last ? cur : ref(Ln, passn, Q, K, V, O, CUM);
        block(cur, nxt, lds, S);
        if (last) break;
        cur = nxt; pass = passn; L = Ln;
    }
}
}
__device__ __forceinline__ int tid_now() { int t = (int)threadIdx.x; asm volatile("" : "+v"(t)); return t; }
struct Frame {
    LAS unsigned char* lds; volatile LAS unsigned* MISC; unsigned* ctl;
    int tid, lane, wave, vcu, G;
};

__device__ __forceinline__ void p0_transpose_item(const float* W, int ldw, int col0, int k0, const float* gain, bf16* WT, int K, int drow0, LAS float* scr, int lane) {
#pragma unroll 8
    for (int i = 0; i < 32; ++i) { const int kk = 2 * i + (lane >> 5); scr[kk * 33 + (lane & 31)] = W[(size_t)(k0 + kk) * ldw + col0 + (lane & 31)]; }
    asm volatile("s_waitcnt lgkmcnt(0)" ::: "memory");
    const int c = lane & 7;
    f32x4 g0 = (f32x4){1.f, 1.f, 1.f, 1.f}, g1 = g0;
    if (gain) { g0 = *(const f32x4*)(gain + k0 + 8 * c); g1 = *(const f32x4*)(gain + k0 + 8 * c + 4); }
#pragma unroll
    for (int j = 0; j < 4; ++j) { const int n = (lane >> 3) + 8 * j; const LAS float* s = scr + (8 * c) * 33 + n;
        u32x4 o; o.x = pk2(s[0 * 33] * g0.x, s[1 * 33] * g0.y); o.y = pk2(s[2 * 33] * g0.z, s[3 * 33] * g0.w); o.z = pk2(s[4 * 33] * g1.x, s[5 * 33] * g1.y); o.w = pk2(s[6 * 33] * g1.z, s[7 * 33] * g1.w);
        *(u32x4*)(WT + (size_t)(drow0 + n) * K + k0 + 8 * c) = o; }
    asm volatile("s_waitcnt lgkmcnt(0)" ::: "memory");
}
__device__ __forceinline__ int win_src_col(int n0) {
    if (n0 < 3072) return C_Q + n0;
    if (n0 < 5120) { const int j = (n0 - 3072) >> 8, w = (n0 - 3072) & 255; return w < 128 ? C_U + 128 * j + w : C_CG + 128 * j + (w - 128); }
    if (n0 < 6144) return C_BG + (n0 - 5120);
    return C_GA + (n0 - 6144);
}
__device__ __forceinline__ void p0_weights(const Params& P, const Frame& F) {
    LAS float* scr = (LAS float*)(F.lds + RING_OFF + F.wave * 16384); const int lane = tid_now() & 63;
    unsigned char* ws = P.ws;
    const int gw = F.vcu * NWAVES + F.wave, NGW = F.G * NWAVES;
    constexpr int I_IN = 32 * 320, I_A = 16 * 64, I_B = 16 * 64, I_OUT = 32 * 64, I_PG = 32 * 64, I_PE = 4 * 64, I_GU = 32 * 32 * 32, I_DN = 32 * 8 * 64;
    constexpr int NITEMS = I_IN + I_A + I_B + I_OUT + I_PG + I_PE + I_GU + I_DN;
    for (int it = gw; it < NITEMS; it += NGW) {
        int r = it;
        if (r < I_IN) { const int kb = r / 320, g = r % 320; p0_transpose_item(P.w_in, IN_COLS, win_src_col(32 * g), 64 * kb, P.g_mix, (bf16*)(ws + WS_WT_IN), DM, 32 * g, scr, lane); continue; } r -= I_IN;
        if (r < I_A) { const int kb = r / 64, g = r % 64; p0_transpose_item(P.w_a, DM, 32 * g, 64 * kb, nullptr, (bf16*)(ws + WS_WT_A), FW, 32 * g, scr, lane); continue; } r -= I_A;
        if (r < I_B) { const int kb = r / 64, g = r % 64; p0_transpose_item(P.w_b, DM, 32 * g, 64 * kb, nullptr, (bf16*)(ws + WS_WT_B), CW, 32 * g, scr, lane); continue; } r -= I_B;
        if (r < I_OUT) { const int kb = r / 64, g = r % 64; p0_transpose_item(P.w_out, DM, 32 * g, 64 * kb, nullptr, (bf16*)(ws + WS_WT_OUT), DM, 32 * g, scr, lane); continue; } r -= I_OUT;
        if (r < I_PG) { const int kb = r / 64, g = r % 64; p0_transpose_item(P.w_pg, DM, 32 * g, 64 * kb, P.g_ple, (bf16*)(ws + WS_WT_PG), DM, 32 * g, scr, lane); continue; } r -= I_PG;
        if (r < I_PE) { const int kb = r / 64, g = r % 64; p0_transpose_item(P.w_pe, DM, 32 * g, 64 * kb, nullptr, (bf16*)(ws + WS_WT_PE), PLE, 32 * g, scr, lane); continue; } r -= I_PE;
        if (r < I_GU) { const int e = r / 1024, kb = (r % 1024) / 32, g = r % 32, n0 = 32 * g, j = n0 >> 8, w = n0 & 255; const int sc = w < 128 ? 128 * j + w : FF + 128 * j + (w - 128);
            p0_transpose_item(P.w_gu + (size_t)e * DM * 2 * FF, 2 * FF, sc, 64 * kb, P.g_ffn, (bf16*)(ws + WS_WT_GU) + (size_t)e * 2 * FF * DM, DM, n0, scr, lane); continue; } r -= I_GU;
        { const int e = r / 512, kb = (r % 512) / 64, g = r % 64; p0_transpose_item(P.w_dn + (size_t)e * FF * DM, DM, 32 * g, 64 * kb, nullptr, (bf16*)(ws + WS_WT_DN) + (size_t)e * DM * FF, FF, 32 * g, scr, lane); }
    }
}
__device__ __forceinline__ void p0_pcast(const Params& P, const Frame& F) {
    const long gt = (long)F.vcu * (NWAVES * 64) + tid_now(), ngt = (long)F.G * NWAVES * 64;
    bf16* PB = (bf16*)(P.ws + WS_PB);
    for (long i = gt; i < (long)T * PLE / 8; i += ngt) { const f32x4 a = *(const f32x4*)(P.p + i * 8), b = *(const f32x4*)(P.p + i * 8 + 4);
        u32x4 o; o.x = pk2(a.x, a.y); o.y = pk2(a.z, a.w); o.z = pk2(b.x, b.y); o.w = pk2(b.z, b.w); *(u32x4*)(PB + i * 8) = o; }
}

struct MegaArgs { Params P; int ph_lo, ph_hi; };
constexpr int NPHASE = 12;
__global__ void __launch_bounds__(NWAVES * 64, 2) mega_fwd(MegaArgs args) {
    extern __shared__ __attribute__((aligned(16))) unsigned char lds_raw[];
    const Params& P = args.P;
    Frame F;
    F.lds = (LAS unsigned char*)lds_raw;
    F.MISC = (volatile LAS unsigned*)(F.lds + MISC_OFF);
    F.tid = threadIdx.x; F.lane = F.tid & 63; F.wave = __builtin_amdgcn_readfirstlane(F.tid >> 6);
    F.G = gridDim.x; { const int bx = blockIdx.x; F.vcu = (F.G % 8 == 0) ? (bx % 8) * (F.G / 8) + bx / 8 : bx; }
    F.ctl = (unsigned*)(P.ws + WS_CTL);
    for (int u = F.tid; u < (LDS_BYTES - LDSCTL_OFF) / 4; u += NWAVES * 64) ((LAS unsigned*)(F.lds + LDSCTL_OFF))[u] = 0u;
    __syncthreads();
    const int lo = args.ph_lo, hi = args.ph_hi;
    XcdBarrier bar; bar.bar = F.ctl + CW_BAR; bar.x = 0; bar.st = nullptr;
    if (hi - lo > 1) bar = xcd_barrier_post(F.ctl + CW_BAR, F.MISC + 8);
#ifndef PH_MASK
#define PH_MASK 0xFFF
#endif
#define IN(k) (((PH_MASK >> (k)) & 1) && lo <= (k) && (k) < hi)
#define SEAM(k) do { if (IN(k) && IN((k) + 1)) xcd_barrier(bar); } while (0)
    const int gw = F.vcu * NWAVES + F.wave, NGW = F.G * NWAVES;
    unsigned char* ws = P.ws;

    if (IN(0)) { p0_weights(P, F); thin_rowstats(P, gw, NGW, tid_now() & 63); p0_pcast(P, F); }
    SEAM(0);
    if (IN(1)) {
        thin_cumsum(P, gw, NGW, tid_now() & 63);
#if defined(LDS_NAN_CHECK)
        for (int u = F.tid; u < RING_BYTES / 4; u += NWAVES * 64) ((LAS unsigned*)(F.lds + RING_OFF))[u] = 0x7FC07FC0u;
        __syncthreads();
#endif
        pg8::StaticOrder S; S.init(ws + WS_XB, ws + WS_WT_IN, T, 10240, DM, F.G, (int)blockIdx.x);
        pg8::EpiIn E{ws};
        pg8::gemm_phase<pg8::EpiIn, pg8::StaticOrder, false>(F.lds + RING_OFF, DM, S, E);
    }
    SEAM(1);
    if (IN(2)) { thin_conv(P, (long)F.vcu * (NWAVES * 64) + tid_now(), (long)F.G * NWAVES * 64);
#if MEGA_ATTN
        fox::attn_phase((char*)lds_raw, (const bf16*)(ws + WS_Q), (const bf16*)(ws + WS_K), (const bf16*)(ws + WS_V), (bf16*)(ws + WS_Q), (const float*)(ws + WS_CUM), F.G, (int)blockIdx.x);
#endif
    }
    SEAM(2);
    if (IN(3)) {
        { pg8::StaticOrder S; S.init(ws + WS_Q, ws + WS_WT_A, T, DM, FW, F.G, (int)blockIdx.x); pg8::EpiMerge<0> E{ws};
          pg8::gemm_phase<pg8::EpiMerge<0>, pg8::StaticOrder, false>(F.lds + RING_OFF, FW, S, E); }
        asm volatile("s_waitcnt vmcnt(0)" ::: "memory"); __syncthreads();
        { pg8::StaticOrder S; S.init(ws + WS_BG, ws + WS_WT_B, T, DM, CW, F.G, (int)blockIdx.x); pg8::EpiMerge<1> E{ws};
          pg8::gemm_phase<pg8::EpiMerge<1>, pg8::StaticOrder, false>(F.lds + RING_OFF, CW, S, E); }
    }
    SEAM(3);
    if (IN(4)) {
        { pg8::StaticOrder S; S.init(ws + WS_MERGED, ws + WS_WT_OUT, T, DM, DM, F.G, (int)blockIdx.x); pg8::EpiX1 E{P.x, P.out, (bf16*)(ws + WS_X1B)};
          pg8::gemm_phase<pg8::EpiX1, pg8::StaticOrder, false>(F.lds + RING_OFF, DM, S, E); }
        { pg8::StaticOrder S; S.init(ws + WS_PB, ws + WS_WT_PE, T, DM, PLE, F.G, (int)blockIdx.x); pg8::EpiPlain E{(bf16*)(ws + WS_PP), DM};
          pg8::gemm_phase<pg8::EpiPlain, pg8::StaticOrder, false>(F.lds + RING_OFF, PLE, S, E); }
    }
    SEAM(4);
    if (IN(5)) { thin_router(P, gw, NGW, tid_now() & 63); }
    SEAM(5);
    LAS int* segt = (LAS int*)(F.lds + SEGT_OFF);
    if (IN(6) || IN(7) || IN(8)) {
        if (tid_now() == 0) { const unsigned* CNT = F.ctl + CW_CNT; int mt = 0, sb = 0;
            for (int s = 0; s < NSEG; ++s) { const int c = (int)__hip_atomic_load(CNT + s, __ATOMIC_RELAXED, __HIP_MEMORY_SCOPE_AGENT); segt[s] = c; segt[64 + s] = mt; segt[129 + s] = sb; const int n = (c + 255) >> 8; mt += n; sb += n << 8; }
            segt[64 + NSEG] = mt; segt[129 + NSEG] = sb; }
        __syncthreads();
    }
    if (IN(6)) {
        pg8::SegOrder S; S.tab = segt; S.nN = 2 * FF / 256; S.G = F.G; S.c = F.vcu; S.seg_lo = 0; S.seg_hi = NSEG; S.K = DM; S.down = 0; S.A = (const char*)(ws + WS_X1B); S.Bt = (const char*)(ws + WS_WT_GU); S.TOKL = (const int*)(ws + WS_TOKL);
        pg8::EpiGU E{ws};
        pg8::gemm_phase<pg8::EpiGU, pg8::SegOrder, true>(F.lds + RING_OFF, DM, S, E);
    }
    SEAM(6);
    if (IN(7)) {
        pg8::SegOrder S; S.tab = segt; S.nN = DM / 256; S.G = F.G; S.c = F.vcu; S.seg_lo = 0; S.seg_hi = NE; S.K = FF; S.down = 1; S.A = (const char*)(ws + WS_HACT); S.Bt = (const char*)(ws + WS_WT_DN); S.TOKL = (const int*)(ws + WS_TOKL);
        pg8::EpiDN<false> E{ws, P.out};
        pg8::gemm_phase<pg8::EpiDN<false>, pg8::SegOrder, false>(F.lds + RING_OFF, FF, S, E);
    }
    SEAM(7);
    if (IN(8)) {
        pg8::SegOrder S; S.tab = segt; S.nN = DM / 256; S.G = F.G; S.c = F.vcu; S.seg_lo = NE; S.seg_hi = NSEG; S.K = FF; S.down = 1; S.A = (const char*)(ws + WS_HACT); S.Bt = (const char*)(ws + WS_WT_DN); S.TOKL = (const int*)(ws + WS_TOKL);
        pg8::EpiDN<true> E{ws, P.out};
        pg8::gemm_phase<pg8::EpiDN<true>, pg8::SegOrder, false>(F.lds + RING_OFF, FF, S, E);
    }
    SEAM(8);
    if (IN(9)) { thin_rowcast(P, nullptr, (float*)(ws + WS_RSTD3), gw, NGW, tid_now() & 63); }
    SEAM(9);
    if (IN(10)) {
        pg8::StaticOrder S; S.init(ws + WS_X2B, ws + WS_WT_PG, T, DM, DM, F.G, (int)blockIdx.x); pg8::EpiPle E{P.out, (const bf16*)(ws + WS_PP), (const float*)(ws + WS_RSTD3)};
        pg8::gemm_phase<pg8::EpiPle, pg8::StaticOrder, false>(F.lds + RING_OFF, DM, S, E);
    }
    SEAM(10);
    if (IN(11)) { thin_final(P, gw, NGW, tid_now() & 63); }
#undef IN
#undef SEAM
}
static void launch_mega(const Params& P, int lo, int hi, hipStream_t stream) {
    static bool attr_done = false;
    if (!attr_done) { attr_done = true;
        if (hipFuncSetAttribute((const void*)mega_fwd, hipFuncAttributeMaxDynamicSharedMemorySize, LDS_BYTES) != hipSuccess) fprintf(stderr, "kernel_launch: hipFuncSetAttribute failed\n");
        (void)hipGetLastError(); }
    if (lo >= hi) return;
    (void)hipMemsetAsync(P.ws + WS_CTL + (size_t)CW_BAR * 4, 0, XCD_BAR_WORDS * 4, stream);
    MegaArgs a; memset(&a, 0, sizeof(a)); a.P = P; a.ph_lo = lo; a.ph_hi = hi;
    hipLaunchKernelGGL(mega_fwd, dim3(256), dim3(NWAVES * 64), LDS_BYTES, stream, a);
    const hipError_t le = hipPeekAtLastError();
    if (le != hipSuccess) fprintf(stderr, "kernel_launch: mega launch [%d,%d) failed: %s\n", lo, hi, hipGetErrorName(le));
}
#ifndef NAIVE_FROM
#define NAIVE_FROM 12
#endif
#ifndef MEGA_ATTN
#define MEGA_ATTN 0
#endif
extern "C" void kernel_launch(void* const* d_in, const int* in_sizes, int n_in, void* d_out, int out_size, void* d_ws, size_t ws_size, hipStream_t stream) {
    if (n_in != 20 || in_sizes[0] != T * DM || out_size != T * DM || ws_size < WS_END) {
        fprintf(stderr, "kernel_launch: unexpected shapes (n_in %d, in0 %d, out %d, ws %zu; need ws >= %zu); nothing launched\n", n_in, n_in > 0 ? in_sizes[0] : -1, out_size, ws_size, (size_t)WS_END); return; }
    Params P; memset(&P, 0, sizeof(P));
    const float** pp = (const float**)&P;
    for (int i = 0; i < 20; ++i) pp[i] = (const float*)d_in[i];
    P.out = (float*)d_out; P.ws = (unsigned char*)d_ws;
    unsigned char* ws = P.ws;
    (void)hipMemsetAsync(ws + WS_CTL, 0, 1 * MiB, stream);
    const dim3 blk(256);
    NOp none; memset(&none, 0, sizeof(none));
    constexpr int NF = NAIVE_FROM;
#if MEGA_ATTN
    launch_mega(P, 0, NF, stream);
#else
    launch_mega(P, 0, 3, stream);
    nattn<<<BATCH * NH * SEQ / 4, blk, 0, stream>>>(P);
    launch_mega(P, 3, NF, stream);
#endif
    if (NF <= 3) { NOp o1{ws + WS_Q, P.w_a, nullptr, FW, DM, FW, 1}, o2{ws + WS_BG, P.w_b, nullptr, CW, DM, CW, 1}; EpiMerged e; memset(&e, 0, sizeof(e)); e.MG = (bf16*)(ws + WS_MERGED); e.GAB = (const bf16*)(ws + WS_GAB);
      ngemm<1, EpiMerged><<<dim3(DM / 64, T / 64), blk, 0, stream>>>(o1, o2, e); }
    if (NF <= 4) { NOp o{ws + WS_MERGED, P.w_out, nullptr, DM, DM, DM, 1}; EpiX1 e; memset(&e, 0, sizeof(e)); e.x = P.x; e.out = P.out; ngemm<0, EpiX1><<<dim3(DM / 64, T / 64), blk, 0, stream>>>(o, none, e);
      k_rowcast<<<2048, blk, 0, stream>>>(P, WS_X1B, WS_RSTD2); }
    if (NF <= 5) k_router<<<2048, blk, 0, stream>>>(P);
    if (NF <= 8) k_segscan<<<1, 64, 0, stream>>>(P);
    const int* SEGB = (const int*)(ws + WS_SEGB); const unsigned* CNT = (const unsigned*)(ws + WS_CTL) + CW_CNT; const int* TOKL = (const int*)(ws + WS_TOKL);
    if (NF <= 6) { NOp o1{ws + WS_X1B, P.w_gu, P.g_ffn, DM, 2 * FF, DM, 1}, o2{ws + WS_X1B, P.w_gu + FF, P.g_ffn, DM, 2 * FF, DM, 1};
      EpiGU e; memset(&e, 0, sizeof(e)); e.SEGB = SEGB; e.CNT = CNT; e.TOKL = TOKL; e.rank_only = -1; e.HACT = (bf16*)(ws + WS_HACT); e.RS = (const float*)(ws + WS_RSTD2); e.WTS = (const float*)(ws + WS_WTS);
      ngemm<1, EpiGU><<<dim3(FF / 64, 81920 / 64), blk, 0, stream>>>(o1, o2, e); }
    for (int rank = 0; rank < 2; ++rank) if (NF <= 7 + rank) { NOp o{ws + WS_HACT, P.w_dn, nullptr, FF, DM, FF, 1};
      EpiDN e; memset(&e, 0, sizeof(e)); e.SEGB = SEGB; e.CNT = CNT; e.TOKL = TOKL; e.rank_only = rank; e.out = P.out;
      ngemm<0, EpiDN><<<dim3(DM / 64, 81920 / 64), blk, 0, stream>>>(o, none, e); }
    if (NF <= 9) k_rowcast<<<2048, blk, 0, stream>>>(P, WS_X2B, WS_RSTD3);
    if (NF <= 10) { NOp o1{ws + WS_X2B, P.w_pg, P.g_ple, DM, DM, DM, 1}, o2{P.p, P.w_pe, nullptr, PLE, DM, PLE, 0}; EpiPle e; memset(&e, 0, sizeof(e)); e.out = P.out; e.RS = (const float*)(ws + WS_RSTD3);
      ngemm<1, EpiPle><<<dim3(DM / 64, T / 64), blk, 0, stream>>>(o1, o2, e); }
    if (NF <= 11) k_final<<<2048, blk, 0, stream>>>(P);
}
```

```cpp
#include <hip/hip_runtime.h>
#include <cstdio>
#include <cstdint>
#include <cstring>

constexpr int BATCH = 8, SEQ = 4096, DM = 2048, T = BATCH * SEQ;
constexpr int NH = 8, HD = 128, FW = 1024, CW = 1024, PLE = 256, NGRP = 4, EPG = 8, NE = 32, FF = 512;
constexpr int IN_COLS = 3 * FW + NH + 3 * CW + 2 * DM;
constexpr int C_Q = 0, C_K = 1024, C_V = 2048, C_F = 3072, C_U = 3080, C_BG = 4104, C_CG = 5128, C_GA = 6152;
constexpr float EPS = 1e-6f;
constexpr int NSEG = 64;

constexpr size_t MiB = 1u << 20;
constexpr size_t WS_CTL = 0;
constexpr size_t WS_RSTD1 = 1 * MiB;
constexpr size_t WS_LOGF = 2 * MiB;
constexpr size_t WS_CUM = 3 * MiB;
constexpr size_t WS_RSTD2 = 4 * MiB, WS_RSTD3 = 5 * MiB;
constexpr size_t WS_EID = 7 * MiB;
constexpr size_t WS_WTS = 7 * MiB + 512 * 1024;
constexpr size_t WS_POS = 8 * MiB;
constexpr size_t WS_SEGB = 8 * MiB + 512 * 1024;
constexpr size_t WS_TOKL = 9 * MiB;
constexpr size_t WS_WRH = 17 * MiB, WS_WRL = 17 * MiB + 256 * 1024;
constexpr size_t WS_WT_IN = 20 * MiB, WS_WT_A = 60 * MiB, WS_WT_B = 64 * MiB, WS_WT_OUT = 68 * MiB, WS_WT_PG = 76 * MiB, WS_WT_PE = 84 * MiB;
constexpr size_t WS_PB = 86 * MiB;
constexpr size_t WS_WT_GU = 104 * MiB, WS_WT_DN = 232 * MiB;
constexpr size_t WS_XB = 296 * MiB;
constexpr size_t WS_Q = 424 * MiB, WS_K = 488 * MiB, WS_V = 552 * MiB;
constexpr size_t WS_Z = 616 * MiB, WS_BG = 680 * MiB;
constexpr size_t WS_GAB = 744 * MiB;
constexpr size_t WS_MERGED = WS_XB;
constexpr size_t WS_X1B = 424 * MiB;
constexpr size_t WS_HACT = 552 * MiB;
constexpr size_t WS_X2B = 744 * MiB;
constexpr size_t WS_PP = 872 * MiB;
constexpr size_t WS_X2F8 = 632 * MiB;
constexpr size_t WS_X1F8 = 680 * MiB;
constexpr size_t WS_END = 1000 * MiB;
constexpr int CW_CNT = 1024;
constexpr int CW_N2 = 2048;
constexpr int CW_ATT = 3072;

typedef unsigned short bf16;
typedef float f32x4 __attribute__((ext_vector_type(4)));
typedef unsigned u32x4 __attribute__((ext_vector_type(4)));
typedef unsigned u32x2 __attribute__((ext_vector_type(2)));

struct Params {
    const float *x, *p, *g_mix, *w_in, *b_f, *conv_w, *w_a, *w_b, *w_out, *g_ffn, *w_rg, *b_rg, *w_re, *b_re, *w_gu, *w_dn, *g_ple, *w_pg, *w_pe, *g_final;
    float* out; unsigned char* ws;
};

__device__ __forceinline__ unsigned f2bf(float f) { unsigned u = __builtin_bit_cast(unsigned, f); return (u + 0x7fffu + ((u >> 16) & 1u)) >> 16; }
__device__ __forceinline__ unsigned pk2(float lo, float hi) { return f2bf(lo) | (f2bf(hi) << 16); }
__device__ __forceinline__ float bf2f(unsigned short b) { return __builtin_bit_cast(float, (unsigned)b << 16); }
__device__ __forceinline__ float bflo(unsigned w) { return __builtin_bit_cast(float, w << 16); }
__device__ __forceinline__ float bfhi(unsigned w) { return __builtin_bit_cast(float, w & 0xffff0000u); }
__device__ __forceinline__ float wave_sum(float v) {
#pragma unroll
    for (int o = 1; o < 64; o <<= 1) v += __shfl_xor(v, o);
    return v;
}
__device__ __forceinline__ float wave_max(float v) {
#pragma unroll
    for (int o = 1; o < 64; o <<= 1) v = fmaxf(v, __shfl_xor(v, o));
    return v;
}
__device__ __forceinline__ float sigmoidf_(float v) { return 1.0f / (1.0f + __expf(-v)); }

__device__ __forceinline__ void thin_cumsum(const Params& P, int gw, int ngw, int lane) {
    const float* logf = (const float*)(P.ws + WS_LOGF); float* cum = (float*)(P.ws + WS_CUM);
    for (int bh = gw; bh < BATCH * NH; bh += ngw) {
        const int b = bh / NH, h = bh % NH;
        const float* src = logf + ((size_t)b * SEQ + lane * 64) * 8 + h;
        double s = 0.0;
        for (int i = 0; i < 64; ++i) s += (double)src[(size_t)i * 8];
        double incl = s;
#pragma unroll
        for (int o = 1; o < 64; o <<= 1) { const double up = __shfl_up(incl, o); if (lane >= o) incl += up; }
        double run = incl - s;
        float* dst = cum + (size_t)bh * SEQ + lane * 64;
        for (int i = 0; i < 64; ++i) { run += (double)src[(size_t)i * 8]; dst[i] = (float)run; }
    }
}
__device__ __forceinline__ void thin_conv(const Params& P, long gt, long ngt) {
    const bf16* Z = (const bf16*)(P.ws + WS_Z); bf16* BG = (bf16*)(P.ws + WS_BG);
    for (long i = gt; i < (long)T * (CW / 8); i += ngt) {
        const int t = (int)(i / (CW / 8)), c = (int)(i % (CW / 8)) * 8, s = t % SEQ;
        const u32x4 z2 = *(const u32x4*)(Z + (size_t)t * CW + c);
        u32x4 z1 = (u32x4){0u, 0u, 0u, 0u}, z0 = (u32x4){0u, 0u, 0u, 0u};
        if (s >= 1) z1 = *(const u32x4*)(Z + (size_t)(t - 1) * CW + c);
        if (s >= 2) z0 = *(const u32x4*)(Z + (size_t)(t - 2) * CW + c);
        const u32x4 b = *(const u32x4*)(BG + (size_t)t * CW + c);
        u32x4 o;
#pragma unroll
        for (int q = 0; q < 4; ++q) {
            const int c0 = c + 2 * q;
            const float lo = bflo(b[q]) * (P.conv_w[c0] * bflo(z0[q]) + P.conv_w[CW + c0] * bflo(z1[q]) + P.conv_w[2 * CW + c0] * bflo(z2[q]));
            const float hi = bfhi(b[q]) * (P.conv_w[c0 + 1] * bfhi(z0[q]) + P.conv_w[CW + c0 + 1] * bfhi(z1[q]) + P.conv_w[2 * CW + c0 + 1] * bfhi(z2[q]));
            o[q] = pk2(lo, hi);
        }
        *(u32x4*)(BG + (size_t)t * CW + c) = o;
    }
}
#define LAS __attribute__((address_space(3)))
#define GAS __attribute__((address_space(1)))
typedef short bf16x8 __attribute__((ext_vector_type(8)));
typedef float f32x2 __attribute__((ext_vector_type(2)));
constexpr int NWAVES = 8;
constexpr int RING_OFF = 0, RING_BYTES = 131072;
constexpr int LDSCTL_OFF = RING_BYTES, MISC_OFF = LDSCTL_OFF + 320;
constexpr int SEGT_OFF = LDSCTL_OFF + 1024;
constexpr int LDS_BYTES = 147456;
constexpr int CW_BAR = 4096;
typedef __bf16 bf16x2_t __attribute__((ext_vector_type(2)));
__device__ __forceinline__ unsigned cvt_pk_bf16(float lo, float hi) { f32x2 v = {lo, hi}; bf16x2_t b = __builtin_convertvector(v, bf16x2_t); return __builtin_bit_cast(unsigned, b); }
typedef int i32x8 __attribute__((ext_vector_type(8)));
typedef unsigned u32x8 __attribute__((ext_vector_type(8)));
__device__ __forceinline__ u32x2 pack8_fp8(f32x4 a, f32x4 b) { u32x2 w; int t = __builtin_amdgcn_cvt_pk_fp8_f32(a.x, a.y, 0, false); t = __builtin_amdgcn_cvt_pk_fp8_f32(a.z, a.w, t, true); w.x = (unsigned)t;
    t = __builtin_amdgcn_cvt_pk_fp8_f32(b.x, b.y, 0, false); t = __builtin_amdgcn_cvt_pk_fp8_f32(b.z, b.w, t, true); w.y = (unsigned)t; return w; }
__device__ __forceinline__ float fast_sigmoid(float v) { return __builtin_amdgcn_rcpf(1.0f + __builtin_amdgcn_exp2f(v * -1.4426950408889634f)); }

#define XB_TMO      128
#define XB_XCNT(j)  (256  + 64 * (j))
#define XB_XSUB(j)  (1280 + 64 * (j))
#define XB_XGEN(j)  (2304 + 64 * (j))
#define XB_TOP      3328
#define XB_TOPGEN   3392
#define XCD_BAR_WORDS 3456
#define XB_SPIN_CAP (1u << 18)
__device__ __forceinline__ unsigned xb_ld(unsigned* p)              { return __hip_atomic_load(p, __ATOMIC_RELAXED, __HIP_MEMORY_SCOPE_AGENT); }
__device__ __forceinline__ unsigned xb_add(unsigned* p, unsigned v) { return __hip_atomic_fetch_add(p, v, __ATOMIC_RELAXED, __HIP_MEMORY_SCOPE_AGENT); }
__device__ __forceinline__ unsigned xb_xcc_id() { return (unsigned)__builtin_amdgcn_s_getreg((3 << 11) | 20) & 0xFu; }
#define XB_SPIN(cond, bar) do { unsigned _sp = 0; while (cond) { __builtin_amdgcn_s_sleep(1); \
    if ((++_sp & 255u) == 0u) { if (xb_ld(&(bar)[XB_TMO])) break; if (_sp > XB_SPIN_CAP) { atomicAdd(&(bar)[XB_TMO], 1u); break; } } } } while (0)
struct XcdBarrier { unsigned* bar; unsigned x; volatile LAS unsigned* st; };
__device__ __forceinline__ XcdBarrier xcd_barrier_post(unsigned* bar, volatile LAS unsigned* st) {
    XcdBarrier b; b.bar = bar; b.x = xb_xcc_id(); b.st = st;
    if (threadIdx.x == 0) (void)xb_add(&bar[XB_XCNT(b.x)], 1u);
    return b;
}
__device__ __forceinline__ void xcd_barrier_complete(unsigned* bar, unsigned x, unsigned& nloc, unsigned& nx) {
    const unsigned G = gridDim.x * gridDim.y * gridDim.z;
    unsigned sum, cnt, mine, sp = 0u;
    for (;;) {
        sum = 0u; cnt = 0u; mine = 0u;
#pragma unroll
        for (unsigned j = 0; j < 16; ++j) { const unsigned c = xb_ld(&bar[XB_XCNT(j)]); sum += c; cnt += (c > 0u) ? 1u : 0u; mine = (j == x) ? c : mine; }
        if (sum == G) break;
        __builtin_amdgcn_s_sleep(1);
        if ((++sp & 255u) == 0u) { if (xb_ld(&bar[XB_TMO])) break; if (sp > XB_SPIN_CAP) { atomicAdd(&bar[XB_TMO], 1u); break; } }
    }
    nloc = mine > 0u ? mine : 1u; nx = cnt > 0u ? cnt : 1u;
}
__device__ __forceinline__ void xcd_barrier(const XcdBarrier& b) {
    asm volatile("s_waitcnt vmcnt(0)" ::: "memory");
    __syncthreads();
    if (threadIdx.x == 0) {
        unsigned* bar = b.bar;
        __builtin_amdgcn_s_waitcnt(0);
        unsigned nloc = b.st[0], nx = b.st[1];
        if (nloc == 0u) { xcd_barrier_complete(bar, b.x, nloc, nx); b.st[0] = nloc; b.st[1] = nx; }
        const unsigned old = xb_add(&bar[XB_XSUB(b.x)], 1u);
        const unsigned gen = old / nloc;
        if (old + 1u == (gen + 1u) * nloc) {
            __builtin_amdgcn_fence(__ATOMIC_RELEASE, "agent");
            asm volatile("s_waitcnt vmcnt(0)" ::: "memory");
            const unsigned og = xb_add(&bar[XB_TOP], 1u);
            const unsigned tg = og / nx;
            if (og + 1u == (tg + 1u) * nx) xb_add(&bar[XB_TOPGEN], 1u);
            else XB_SPIN(xb_ld(&bar[XB_TOPGEN]) == tg, bar);
            __builtin_amdgcn_fence(__ATOMIC_ACQUIRE, "agent");
            xb_add(&bar[XB_XGEN(b.x)], 1u);
            asm volatile("s_waitcnt vmcnt(0)" ::: "memory");
        } else {
            XB_SPIN(xb_ld(&bar[XB_XGEN(b.x)]) == gen, bar);
            __builtin_amdgcn_fence(__ATOMIC_ACQUIRE, "agent");
            asm volatile("s_waitcnt vmcnt(0)" ::: "memory");
        }
    }
    __syncthreads();
}

namespace pg8 {
constexpr int BM = 256, BK = 64, HALF = 128, HTB = HALF * BK * 2, STAGE_BYTES = 8 * HTB, NXCD = 8, WGM = 8;
__host__ __device__ __forceinline__ int lds_byte(int r, int c) { const int st = (r >> 4) * 2 + (c >> 5), rr = r & 15, cc = c & 31, ob = rr * 64 + cc * 2; return st * 1024 + (ob ^ (((ob >> 9) & 1) << 5)); }
__host__ __device__ __forceinline__ void stage_rc(int b, int& R, int& C) { const int st = b / 1024, sb = b % 1024, swz = sb ^ (((sb >> 9) & 1) << 5); R = (st >> 1) * 16 + swz / 64; C = (st & 1) * 32 + (swz % 64) / 2; }
__host__ __device__ __forceinline__ int perm32(int rho) { const int n = rho >> 4, i = rho & 15; return 8 * (i >> 2) + 4 * n + (i & 3); }

struct Unit { int pm, pn, seg, mt, nrow, slot0; const char* a; const char* b; };

struct StaticOrder {
    int nM, nN, nwg, G, c, K; const char* A; const char* Bt;
    __device__ void init(const void* A_, const void* Bt_, int M, int N, int K_, int G_, int c_) { A = (const char*)A_; Bt = (const char*)Bt_; nM = M / BM; nN = N / BM; nwg = nM * nN; G = G_; c = c_; K = K_; }
    __device__ bool next(int i, Unit& u) const {
        const long L = (long)i * G + c; if (L >= nwg) return false;
        int wgid = (int)L; { const int q = nwg / NXCD, r = nwg % NXCD, xcd = wgid % NXCD, off = wgid / NXCD; wgid = (xcd < r ? xcd * (q + 1) : r * (q + 1) + (xcd - r) * q) + off; }
        const int nig = WGM * nN, gid = wgid / nig, fm = gid * WGM, gsz = (nM - fm) < WGM ? (nM - fm) : WGM;
        u.pm = fm + ((wgid % nig) % gsz); u.pn = (wgid % nig) / gsz;
#if defined(REV_PN)
        u.pn = nN - 1 - u.pn;
#endif
        u.seg = 0; u.mt = 0; u.nrow = BM; u.slot0 = 0;
        u.a = A + (size_t)u.pm * BM * K * 2; u.b = Bt + (size_t)u.pn * BM * K * 2; return true;
    }
    __device__ __forceinline__ unsigned arow(const Unit&, int r) const { return (unsigned)r; }
};

template <class Epi, class Sched, bool GATHER, bool FP8 = false, int SCW = 121, int SCA = 127>
__device__ __forceinline__ void gemm_phase(LAS unsigned char* lds, const int K, const Sched& S, const Epi& E) {
    const int tid = threadIdx.x, wid = __builtin_amdgcn_readfirstlane(tid >> 6), lane = tid & 63, wr = wid >> 2, wc = wid & 3, fr = lane & 15, fq = lane >> 4;
    const int nt = K / BK;
    int Rr[2], Cc[2]; unsigned voffB[2];
#pragma unroll
    for (int i = 0; i < 2; ++i) { int R, C; stage_rc(tid * 16 + i * 8192, R, C); const int Rb = Epi::PERM ? ((R & ~31) + perm32(R & 31)) : R; Rr[i] = R; Cc[i] = C; voffB[i] = (unsigned)(Rb * K + C) * 2u; }
    const size_t kstep = (size_t)(BK * 2);
    const size_t hstep = (size_t)HALF * K * 2;
    const unsigned ldsw = (unsigned)wid * 1024u;
    const int aoff = lds_byte(wr * 64 + fr, fq * 8), boff = lds_byte(wc * 32 + fr, fq * 8);
#define PG8_SA(b, h) (((b) * 2 + (h)) * HTB)
#define PG8_SB(b, h) ((4 + (b) * 2 + (h)) * HTB)
#define PG8_LD1(bufoff, gptr, i_) __builtin_amdgcn_global_load_lds((const unsigned*)(gptr), (LAS unsigned*)(lds + (bufoff) + ldsw + (i_) * 8192), 16, 0, 0)
#define PG8_STAGE_B(bufoff, gbase) do { PG8_LD1(bufoff, (const char*)(gbase) + voffB[0], 0); PG8_LD1(bufoff, (const char*)(gbase) + voffB[1], 1); } while (0)
#define PG8_STAGE_A(bufoff, gbase, v0, v1) do { PG8_LD1(bufoff, (const char*)(gbase) + (v0), 0); PG8_LD1(bufoff, (const char*)(gbase) + (v1), 1); } while (0)
#define PG8_LDA(dst, b, h) do { if constexpr (FP8) { _Pragma("unroll") for (int m = 0; m < 4; ++m) dst##8[m] = __builtin_shufflevector(*(const LAS u32x4*)(lds + PG8_SA(b, h) + aoff + m * 2048), *(const LAS u32x4*)(lds + PG8_SA(b, h) + aoff + m * 2048 + 1024), 0, 1, 2, 3, 4, 5, 6, 7); } \
        else { _Pragma("unroll") for (int m = 0; m < 4; ++m) _Pragma("unroll") for (int k = 0; k < 2; ++k) dst[m][k] = *(const LAS bf16x8*)(lds + PG8_SA(b, h) + aoff + m * 2048 + k * 1024); } } while (0)
#define PG8_LDB(dst, b, h) do { if constexpr (FP8) { _Pragma("unroll") for (int n = 0; n < 2; ++n) dst##8[n] = __builtin_shufflevector(*(const LAS u32x4*)(lds + PG8_SB(b, h) + boff + n * 2048), *(const LAS u32x4*)(lds + PG8_SB(b, h) + boff + n * 2048 + 1024), 0, 1, 2, 3, 4, 5, 6, 7); } \
        else { _Pragma("unroll") for (int n = 0; n < 2; ++n) _Pragma("unroll") for (int k = 0; k < 2; ++k) dst[n][k] = *(const LAS bf16x8*)(lds + PG8_SB(b, h) + boff + n * 2048 + k * 1024); } } while (0)
#define PG8_MMA(ai, bj, At, Bt) do { __builtin_amdgcn_s_setprio(1); if constexpr (FP8) { _Pragma("unroll") for (int m = 0; m < 4; ++m) _Pragma("unroll") for (int n = 0; n < 2; ++n) \
        asm volatile("v_mfma_scale_f32_16x16x128_f8f6f4 %0, %1, %2, %0, %3, %4 op_sel_hi:[0,0,0]" : "+v"(acc[ai][bj][m][n]) : "v"(Bt##8[n]), "v"(At##8[m]), "v"(scw), "v"(sca)); } \
        else { _Pragma("unroll") for (int m = 0; m < 4; ++m) _Pragma("unroll") for (int n = 0; n < 2; ++n) _Pragma("unroll") for (int k = 0; k < 2; ++k) \
        acc[ai][bj][m][n] = __builtin_amdgcn_mfma_f32_16x16x32_bf16(Bt[n][k], At[m][k], acc[ai][bj][m][n], 0, 0, 0); } __builtin_amdgcn_s_setprio(0); } while (0)
#define PG8_WAIT_V(n) asm volatile("s_waitcnt vmcnt(" #n ")" ::: "memory")
#define PG8_WAIT_L(n) asm volatile("s_waitcnt lgkmcnt(" #n ")" ::: "memory")
#define PG8_BAR __builtin_amdgcn_s_barrier()
#define PG8_SCHED __builtin_amdgcn_sched_barrier(0)
#define PG8_VOFFA(dst, u) do { _Pragma("unroll") for (int h_ = 0; h_ < 2; ++h_) _Pragma("unroll") for (int i_ = 0; i_ < 2; ++i_) \
        dst[h_][i_] = S.arow(u, h_ * HALF + Rr[i_]) * (unsigned)(K * 2) + (unsigned)(Cc[i_] * 2); } while (0)
    Unit cur, nxt; int ui = 0;
    if (!S.next(0, cur)) return;
    f32x4 acc[2][2][4][2];
#pragma unroll
    for (int a = 0; a < 2; ++a)
#pragma unroll
        for (int b = 0; b < 2; ++b)
#pragma unroll
            for (int m = 0; m < 4; ++m)
#pragma unroll
                for (int n = 0; n < 2; ++n) acc[a][b][m][n] = (f32x4){0.f, 0.f, 0.f, 0.f};
    bf16x8 At[4][2], B0[2][2], B1[2][2];
    u32x8 At8[4], B08[2], B18[2];
    const int scw = SCW, sca = SCA;
    unsigned voffA[2][2];
    PG8_VOFFA(voffA, cur);
    const char* cA = cur.a; const char* cB = cur.b;
    PG8_STAGE_B(PG8_SB(0, 0), cB); PG8_STAGE_B(PG8_SB(0, 1), cB + hstep); PG8_STAGE_A(PG8_SA(0, 0), cA, voffA[0][0], voffA[0][1]); PG8_STAGE_A(PG8_SA(0, 1), cA, voffA[1][0], voffA[1][1]);
    if (wr == 1) PG8_BAR;
    PG8_WAIT_V(2); PG8_BAR;
    PG8_STAGE_B(PG8_SB(1, 0), cB + kstep); PG8_STAGE_A(PG8_SA(1, 0), cA + kstep, voffA[0][0], voffA[0][1]); PG8_STAGE_B(PG8_SB(1, 1), cB + hstep + kstep);
    PG8_WAIT_V(6); PG8_BAR;
    for (;;) {
        const bool has_next = S.next(ui + 1, nxt);
        const char* nA = has_next ? nxt.a : cA; const char* nB = has_next ? nxt.b : cB;
#pragma unroll 1
        for (int t = 0; t < nt; t += 2) {
            const bool last = (t == nt - 2);
            const char* a1 = cA + (size_t)(t + 1) * kstep;
            const char* a2 = last ? nA : cA + (size_t)(t + 2) * kstep; const char* b2 = last ? nB : cB + (size_t)(t + 2) * kstep;
            const char* a3 = a2 + kstep; const char* b3 = b2 + kstep;
            PG8_LDB(B0, 0, 0); PG8_LDB(B1, 0, 1); PG8_SCHED; PG8_LDA(At, 0, 0); PG8_STAGE_A(PG8_SA(1, 1), a1, voffA[1][0], voffA[1][1]);
            if constexpr (GATHER) { if (last && has_next) { PG8_VOFFA(voffA, nxt); } }
            PG8_WAIT_V(8); PG8_WAIT_L(0); PG8_BAR; PG8_MMA(0, 0, At, B0); PG8_MMA(0, 1, At, B1); PG8_BAR; PG8_SCHED;
            PG8_LDA(At, 0, 1); PG8_STAGE_B(PG8_SB(0, 0), b2); PG8_STAGE_B(PG8_SB(0, 1), b2 + hstep); PG8_STAGE_A(PG8_SA(0, 0), a2, voffA[0][0], voffA[0][1]);
            PG8_WAIT_V(8); PG8_WAIT_L(0); PG8_BAR; PG8_MMA(1, 0, At, B0); PG8_MMA(1, 1, At, B1); PG8_BAR; PG8_SCHED;
            PG8_LDB(B0, 1, 0); PG8_LDB(B1, 1, 1); PG8_SCHED; PG8_LDA(At, 1, 0); PG8_STAGE_A(PG8_SA(0, 1), a2, voffA[1][0], voffA[1][1]);
            PG8_WAIT_V(8); PG8_WAIT_L(0); PG8_BAR; PG8_MMA(0, 0, At, B0); PG8_MMA(0, 1, At, B1); PG8_BAR; PG8_SCHED;
            PG8_LDA(At, 1, 1); PG8_STAGE_B(PG8_SB(1, 0), b3); PG8_STAGE_B(PG8_SB(1, 1), b3 + hstep); PG8_STAGE_A(PG8_SA(1, 0), a3, voffA[0][0], voffA[0][1]);
            PG8_WAIT_V(8); PG8_WAIT_L(0); PG8_BAR; PG8_MMA(1, 0, At, B0); PG8_MMA(1, 1, At, B1); PG8_BAR; PG8_SCHED;
        }
        if (wr == 0) PG8_BAR;
        if constexpr (FP8) asm volatile("s_nop 15\n\ts_nop 15" ::: "memory");
        E(acc, cur, wr, wc, fr, fq);
        if (!has_next) break;
#pragma unroll
        for (int a = 0; a < 2; ++a)
#pragma unroll
            for (int b = 0; b < 2; ++b)
#pragma unroll
                for (int m = 0; m < 4; ++m)
#pragma unroll
                    for (int n = 0; n < 2; ++n) acc[a][b][m][n] = (f32x4){0.f, 0.f, 0.f, 0.f};
        cur = nxt; cA = nA; cB = nB; ++ui;
        if (wr == 1) PG8_BAR;
    }
    PG8_WAIT_V(0);
    PG8_BAR;
#undef PG8_SA
#undef PG8_SB
#undef PG8_LD1
#undef PG8_STAGE_A
#undef PG8_STAGE_B
#undef PG8_LDA
#undef PG8_LDB
#undef PG8_MMA
#undef PG8_WAIT_V
#undef PG8_WAIT_L
#undef PG8_BAR
#undef PG8_SCHED
#undef PG8_VOFFA
}

typedef const f32x4 (&AccRef)[2][2][4][2];
__device__ __forceinline__ u32x4 pack8(f32x4 v0, f32x4 v1) { u32x4 w; w.x = cvt_pk_bf16(v0[0], v0[1]); w.y = cvt_pk_bf16(v0[2], v0[3]); w.z = cvt_pk_bf16(v1[0], v1[1]); w.w = cvt_pk_bf16(v1[2], v1[3]); return w; }
__device__ __forceinline__ f32x4 sig4(f32x4 v) { return (f32x4){fast_sigmoid(v[0]), fast_sigmoid(v[1]), fast_sigmoid(v[2]), fast_sigmoid(v[3])}; }
__device__ __forceinline__ f32x4 bflo4(u32x4 w) { return (f32x4){bflo(w.x), bfhi(w.x), bflo(w.y), bfhi(w.y)}; }
__device__ __forceinline__ f32x4 bfhi4(u32x4 w) { return (f32x4){bflo(w.z), bfhi(w.z), bflo(w.w), bfhi(w.w)}; }

struct EpiIn {
    static constexpr bool PERM = true;
    unsigned char* ws;
    __device__ __forceinline__ void operator()(AccRef acc, const Unit& u, int wr, int wc, int fr, int fq) const {
        asm volatile("" : "+v"(fr), "+v"(fq));
        const int row0 = u.pm * BM + wr * 64 + fr, cw = wc * 32 + 8 * fq;
        const int pn = u.pn;
        if (pn < 8) {
            unsigned* N2 = (unsigned*)(ws + WS_CTL) + CW_N2 + (pn >> 2) * 256 + ((u.pm >> 4) * NH + 2 * (pn & 3)) * 4 + wc;
#pragma unroll
            for (int bj = 0; bj < 2; ++bj) { float mx = 0.f;
#pragma unroll
                for (int ai = 0; ai < 2; ++ai)
#pragma unroll
                    for (int m = 0; m < 4; ++m) { const f32x4 a = acc[ai][bj][m][0], b = acc[ai][bj][m][1];
                        float s = (a.x * a.x + a.y * a.y) + (a.z * a.z + a.w * a.w) + (b.x * b.x + b.y * b.y) + (b.z * b.z + b.w * b.w);
                        s += __shfl_xor(s, 16); s += __shfl_xor(s, 32); mx = fmaxf(mx, s); }
#pragma unroll
                for (int o = 1; o < 16; o <<= 1) mx = fmaxf(mx, __shfl_xor(mx, o));
                if (fr == 0 && fq == 0) atomicMax(N2 + bj * 4, __float_as_uint(mx * 1.03f)); }
        }
        if (pn < 12 || (pn >= 20 && pn < 24)) {
            bf16* base; if (pn < 12) base = (bf16*)(ws + WS_Q) + (size_t)(pn >> 2) * ((size_t)T * FW) + (pn & 3) * BM; else base = (bf16*)(ws + WS_BG) + (pn - 20) * BM;
#pragma unroll
            for (int ai = 0; ai < 2; ++ai)
#pragma unroll
                for (int m = 0; m < 4; ++m) { bf16* rowp = base + (size_t)(row0 + ai * HALF + m * 16) * FW + cw;
#pragma unroll
                    for (int bj = 0; bj < 2; ++bj) *(u32x4*)(rowp + bj * HALF) = pack8(acc[ai][bj][m][0], acc[ai][bj][m][1]); }
        } else if (pn < 20) {
            bf16* base = (bf16*)(ws + WS_Z) + (pn - 12) * HALF;
#pragma unroll
            for (int ai = 0; ai < 2; ++ai)
#pragma unroll
                for (int m = 0; m < 4; ++m) { bf16* rowp = base + (size_t)(row0 + ai * HALF + m * 16) * CW + cw;
                    *(u32x4*)rowp = pack8(acc[ai][0][m][0] * acc[ai][1][m][0], acc[ai][0][m][1] * acc[ai][1][m][1]); }
        } else {
            bf16* base = (bf16*)(ws + WS_GAB) + (pn - 24) * BM;
#pragma unroll
            for (int ai = 0; ai < 2; ++ai)
#pragma unroll
                for (int m = 0; m < 4; ++m) { bf16* rowp = base + (size_t)(row0 + ai * HALF + m * 16) * 4096 + cw;
#pragma unroll
                    for (int bj = 0; bj < 2; ++bj) *(u32x4*)(rowp + bj * HALF) = pack8(sig4(acc[ai][bj][m][0]), sig4(acc[ai][bj][m][1])); }
        }
    }
};

template <int PASS> struct EpiMerge {
    static constexpr bool PERM = true;
    unsigned char* ws;
    __device__ __forceinline__ void operator()(AccRef acc, const Unit& u, int wr, int wc, int fr, int fq) const {
        asm volatile("" : "+v"(fr), "+v"(fq));
        const int row0 = u.pm * BM + wr * 64 + fr, c0 = u.pn * BM + wc * 32 + 8 * fq;
        const bf16* G = (const bf16*)(ws + WS_GAB) + PASS * DM; bf16* MG = (bf16*)(ws + WS_MERGED);
#pragma unroll
        for (int ai = 0; ai < 2; ++ai)
#pragma unroll
            for (int m = 0; m < 4; ++m) { const size_t row = (size_t)(row0 + ai * HALF + m * 16);
#pragma unroll
                for (int bj = 0; bj < 2; ++bj) { const u32x4 gv = *(const u32x4*)(G + row * 4096 + c0 + bj * HALF);
                    f32x4 v0 = acc[ai][bj][m][0] * bflo4(gv), v1 = acc[ai][bj][m][1] * bfhi4(gv);
                    if (PASS == 1) { const u32x4 tv = *(const u32x4*)(MG + row * DM + c0 + bj * HALF); v0 += bflo4(tv); v1 += bfhi4(tv); }
                    *(u32x4*)(MG + row * DM + c0 + bj * HALF) = pack8(v0, v1); } }
    }
};
struct EpiX1 {
    static constexpr bool PERM = true;
    const float* x; bf16* XRB; unsigned char* X8;
    __device__ __forceinline__ void operator()(AccRef acc, const Unit& u, int wr, int wc, int fr, int fq) const {
        asm volatile("" : "+v"(fr), "+v"(fq));
        const int row0 = u.pm * BM + wr * 64 + fr, c0 = u.pn * BM + wc * 32 + 8 * fq;
#pragma unroll
        for (int ai = 0; ai < 2; ++ai)
#pragma unroll
            for (int m = 0; m < 4; ++m) { const size_t off = (size_t)(row0 + ai * HALF + m * 16) * DM + c0;
#pragma unroll
                for (int bj = 0; bj < 2; ++bj) { const f32x4 a0 = *(const f32x4*)(x + off + bj * HALF), a1 = *(const f32x4*)(x + off + bj * HALF + 4);
                    const f32x4 v0 = a0 + acc[ai][bj][m][0], v1 = a1 + acc[ai][bj][m][1];
                    *(u32x4*)(XRB + off + bj * HALF) = pack8(v0, v1); *(u32x2*)(X8 + off + bj * HALF) = pack8_fp8(v0, v1); }
                if (m == 3) asm volatile("" ::: "memory"); }
    }
};
struct EpiPlain {
    static constexpr bool PERM = true;
    bf16* O; int ldc;
    __device__ __forceinline__ void operator()(AccRef acc, const Unit& u, int wr, int wc, int fr, int fq) const {
        asm volatile("" : "+v"(fr), "+v"(fq));
        const int row0 = u.pm * BM + wr * 64 + fr, c0 = u.pn * BM + wc * 32 + 8 * fq;
#pragma unroll
        for (int ai = 0; ai < 2; ++ai)
#pragma unroll
            for (int m = 0; m < 4; ++m) { bf16* rowp = O + (size_t)(row0 + ai * HALF + m * 16) * ldc + c0;
#pragma unroll
                for (int bj = 0; bj < 2; ++bj) *(u32x4*)(rowp + bj * HALF) = pack8(acc[ai][bj][m][0], acc[ai][bj][m][1]); }
    }
};
struct EpiPle {
    static constexpr bool PERM = true;
    const bf16* XRB; bf16* X3B; const bf16* PP; const float* RS;
    __device__ __forceinline__ void operator()(AccRef acc, const Unit& u, int wr, int wc, int fr, int fq) const {
        asm volatile("" : "+v"(fr), "+v"(fq));
        const int row0 = u.pm * BM + wr * 64 + fr, c0 = u.pn * BM + wc * 32 + 8 * fq;
#pragma unroll
        for (int ai = 0; ai < 2; ++ai)
#pragma unroll
            for (int m = 0; m < 4; ++m) { const int row = row0 + ai * HALF + m * 16; const size_t off = (size_t)row * DM + c0; const float r = RS[row];
#pragma unroll
                for (int bj = 0; bj < 2; ++bj) { const u32x4 pv = *(const u32x4*)(PP + off + bj * HALF), xv = *(const u32x4*)(XRB + off + bj * HALF);
                    *(u32x4*)(X3B + off + bj * HALF) = pack8(bflo4(xv) + sig4(acc[ai][bj][m][0] * r) * bflo4(pv), bfhi4(xv) + sig4(acc[ai][bj][m][1] * r) * bfhi4(pv)); }
                if (m == 3) asm volatile("" ::: "memory"); }
    }
};

struct SegOrder {
    const LAS int* tab;
    int nN, G, c, seg_lo, seg_hi, K, down; const char* A; const char* Bt; const int* TOKL;
    __device__ __forceinline__ int rd(int i) const { return __builtin_amdgcn_readfirstlane(tab[i]); }
    __device__ bool next(int i, Unit& u) const {
        const int m_lo = rd(64 + seg_lo), m_hi = rd(64 + seg_hi);
        const long L = (long)i * G + c; if (L >= (long)(m_hi - m_lo) * nN) return false;
        const int mtile = m_lo + (int)(L / nN); u.pn = (int)(L % nN);
        int s = seg_lo; while (s + 1 < seg_hi && rd(64 + s + 1) <= mtile) ++s;
        u.seg = s; u.mt = mtile - rd(64 + s); u.pm = 0; const int left = rd(s) - u.mt * BM; u.nrow = left < BM ? left : BM; u.slot0 = rd(129 + s) + u.mt * BM;
        const int e = s & 31;
        if (down) { u.a = A + (size_t)u.slot0 * K * 2; u.b = Bt + ((size_t)e * DM + (size_t)u.pn * BM) * K * 2; }
        else { u.a = A; u.b = Bt + ((size_t)e * 2 * FF + (size_t)u.pn * BM) * K * 2; }
        return true;
    }
    __device__ __forceinline__ unsigned arow(const Unit& u, int r) const {
        if (down) return (unsigned)r;
        const int rr = r < u.nrow ? r : u.nrow - 1;
        return (unsigned)TOKL[(size_t)u.seg * T + u.mt * BM + rr];
    }
};
struct EpiGU {
    static constexpr bool PERM = true;
    unsigned char* ws;
    __device__ __forceinline__ void operator()(AccRef acc, const Unit& u, int wr, int wc, int fr, int fq) const {
        asm volatile("" : "+v"(fr), "+v"(fq));
        const int* TOKL = (const int*)(ws + WS_TOKL) + (size_t)u.seg * T + u.mt * BM; const float* RS = (const float*)(ws + WS_RSTD2); const float* WTS = (const float*)(ws + WS_WTS) + (u.seg >> 5);
        unsigned char* H = ws + WS_HACT + (size_t)u.slot0 * FF + u.pn * HALF + wc * 32 + 8 * fq;
#pragma unroll
        for (int ai = 0; ai < 2; ++ai)
#pragma unroll
            for (int m = 0; m < 4; ++m) { const int r = ai * HALF + wr * 64 + m * 16 + fr; const bool live = r < u.nrow; const int tok = TOKL[live ? r : 0];
                const float rs = RS[tok], wt = WTS[2 * tok];
                f32x4 g0 = acc[ai][0][m][0] * rs, g1 = acc[ai][0][m][1] * rs; const f32x4 u0 = acc[ai][1][m][0] * (rs * wt * 8.0f), u1 = acc[ai][1][m][1] * (rs * wt * 8.0f);
                g0 = g0 * sig4(g0) * u0; g1 = g1 * sig4(g1) * u1;
                { const f32x4 lo4 = (f32x4){-448.f, -448.f, -448.f, -448.f}, hi4 = (f32x4){448.f, 448.f, 448.f, 448.f}; g0 = __builtin_elementwise_min(__builtin_elementwise_max(g0, lo4), hi4); g1 = __builtin_elementwise_min(__builtin_elementwise_max(g1, lo4), hi4); }
                if (live) *(u32x2*)(H + (size_t)r * FF) = pack8_fp8(g0, g1); }
    }
};
template <bool LAST> struct EpiDN {
    static constexpr bool PERM = true;
    unsigned char* ws;
    __device__ __forceinline__ void operator()(AccRef acc, const Unit& u, int wr, int wc, int fr, int fq) const {
        asm volatile("" : "+v"(fr), "+v"(fq));
        const int* TOKL = (const int*)(ws + WS_TOKL) + (size_t)u.seg * T + u.mt * BM; bf16* XRB = (bf16*)(ws + WS_X1B); unsigned char* X8 = ws + WS_X2F8;
        const int c0 = u.pn * BM + wc * 32 + 8 * fq;
#pragma unroll
        for (int ai = 0; ai < 2; ++ai)
#pragma unroll
            for (int m = 0; m < 4; ++m) { const int r = ai * HALF + wr * 64 + m * 16 + fr; const bool live = r < u.nrow; const int tok = TOKL[live ? r : 0];
                const size_t off = (size_t)tok * DM + c0;
#pragma unroll
                for (int bj = 0; bj < 2; ++bj) { const u32x4 xv = *(const u32x4*)(XRB + off + bj * HALF);
                    const f32x4 v0 = bflo4(xv) + acc[ai][bj][m][0], v1 = bfhi4(xv) + acc[ai][bj][m][1];
                    if (live) { *(u32x4*)(XRB + off + bj * HALF) = pack8(v0, v1); if (LAST) *(u32x2*)(X8 + off + bj * HALF) = pack8_fp8(v0, v1); } } }
    }
};
}
using pg8::bflo4; using pg8::bfhi4;

namespace fox {
typedef short s16x4 __attribute__((ext_vector_type(4)));
typedef float f32x16 __attribute__((ext_vector_type(16)));
constexpr int D = 128, LDQ = 1024, NW = 8, QBLK = 32, KVBLK = 64, QB = NW * QBLK;
constexpr float SCALE = 0.08838834764831845f, INVS = 11.313708498984761f, THR = 8.f;
constexpr int SHM_V = KVBLK * D * 2, SHM_K = KVBLK * D * 2;
constexpr int OFF_WS = 2 * SHM_V + 2 * SHM_K, OFF_B = OFF_WS + NW * 64 * 4, LDS_ATT = OFF_B + SEQ * 4;
#define KSWZ(row, colB) ((row) * 256 + ((colB) ^ (((row) & 7) << 4)))
#define SBAR() __builtin_amdgcn_sched_barrier(0)
__device__ __forceinline__ int v_st(int k, int c) { const int kk = (k & ~0xC) | ((k & 4) << 1) | ((k & 8) >> 1); return ((kk >> 3) * 4 + (c >> 5)) * 512 + ((kk & 7) * 32 + (c & 31)) * 2; }
__device__ __forceinline__ int v_rd_base(int lane) { return ((lane & 3) << 3) | (((lane >> 2) & 3) << 6) | (((lane >> 4) & 1) << 5) | (((lane >> 5) & 1) << 8); }
constexpr int v_rd_off(int d0, int ks, int half) { return d0 * 512 + ks * 4096 + half * 2048; }
__device__ __forceinline__ int crow(int r, int hi) { return (r & 3) + 8 * (r >> 2) + 4 * hi; }
__device__ __forceinline__ unsigned cvtpk(float lo, float hi) { return cvt_pk_bf16(lo, hi); }
__device__ __forceinline__ void mask_tile(f32x16& p0, f32x16& p1, int dq) {
    const float NEG = -__builtin_inff();
#pragma unroll
    for (int r = 0; r < 16; ++r) { const int c = (r & 3) + 8 * (r >> 2);
        if (dq - c < 0) p0[r] = NEG;
        if (dq - c - 32 < 0) p1[r] = NEG; }
}
__device__ __forceinline__ void partialSM(f32x16& p0, f32x16& p1, float& m_reg, float& mn, float& alpha) {
    float pmax = p0[0];
#pragma unroll
    for (int r = 1; r < 16; ++r) pmax = fmaxf(pmax, p0[r]);
#pragma unroll
    for (int r = 0; r < 16; ++r) pmax = fmaxf(pmax, p1[r]);
    { auto rr = __builtin_amdgcn_permlane32_swap(__float_as_uint(pmax), __float_as_uint(pmax), false, false);
      pmax = fmaxf(__uint_as_float(rr[0]), __uint_as_float(rr[1])); }
    constexpr float C2 = 1.4426950408889634f * SCALE;
    if (__builtin_expect(__all((pmax - m_reg) * SCALE <= THR), 1)) { mn = m_reg; alpha = 1.f; }
    else { mn = fmaxf(m_reg, pmax); alpha = __builtin_amdgcn_exp2f((m_reg - mn) * C2); m_reg = mn; }
    const float mnL = -mn * C2;
#pragma unroll
    for (int r = 0; r < 16; ++r) p0[r] = fmaf(p0[r], C2, mnL);
#pragma unroll
    for (int r = 0; r < 16; ++r) p1[r] = fmaf(p1[r], C2, mnL);
#pragma unroll
    for (int r = 0; r < 16; ++r) p0[r] = __builtin_amdgcn_exp2f(p0[r]);
}
__device__ __forceinline__ void finishSM(f32x16& p0, f32x16& p1, float alpha, float& l_reg, bf16x8& pa0, bf16x8& pa1, bf16x8& pa2, bf16x8& pa3) {
#pragma unroll
    for (int r = 0; r < 16; ++r) p1[r] = __builtin_amdgcn_exp2f(p1[r]);
    float ps = 0;
#pragma unroll
    for (int r = 0; r < 16; ++r) ps += p0[r];
#pragma unroll
    for (int r = 0; r < 16; ++r) ps += p1[r];
    { auto rr = __builtin_amdgcn_permlane32_swap(__float_as_uint(ps), __float_as_uint(ps), false, false);
      ps = __uint_as_float(rr[0]) + __uint_as_float(rr[1]); }
    l_reg = l_reg * alpha + ps;
#define PK4(P, B_, OUT) do { unsigned a0 = cvtpk(P[B_+0], P[B_+1]), a1 = cvtpk(P[B_+2], P[B_+3]);                          \
        unsigned b0 = cvtpk(P[B_+4], P[B_+5]), b1 = cvtpk(P[B_+6], P[B_+7]);                                             \
        auto r0 = __builtin_amdgcn_permlane32_swap(a0, b0, false, false); auto r1 = __builtin_amdgcn_permlane32_swap(a1, b1, false, false); \
        u32x4 w = {r0[0], r1[0], r0[1], r1[1]}; OUT = __builtin_bit_cast(bf16x8, w); } while (0)
    PK4(p0, 0, pa0); PK4(p0, 8, pa1); PK4(p1, 0, pa2); PK4(p1, 8, pa3);
#undef PK4
}
template <int KB>
__device__ __forceinline__ void qkt(f32x16& p0, f32x16& p1, const char* K_lds, const char* bias_t, int r32, int hi, const bf16x8* qr) {
    const f32x4* bl = (const f32x4*)(bias_t + hi * 16);
#pragma unroll
    for (int q = 0; q < 4; ++q) { const f32x4 b0 = bl[2 * q], b1 = bl[8 + 2 * q];
        p0[4 * q] = b0.x; p0[4 * q + 1] = b0.y; p0[4 * q + 2] = b0.z; p0[4 * q + 3] = b0.w;
        p1[4 * q] = b1.x; p1[4 * q + 1] = b1.y; p1[4 * q + 2] = b1.z; p1[4 * q + 3] = b1.w; }
    const char* kb[4];
#pragma unroll
    for (int dd = 0; dd < 4; ++dd) kb[dd] = K_lds + KB * SHM_K + KSWZ(r32, (dd * 16 + hi * 8) * 2);
#pragma unroll
    for (int d0 = 0; d0 < 8; ++d0) { const char* a = kb[d0 & 3] + (d0 >> 2) * 128;
        bf16x8 b0 = *reinterpret_cast<const bf16x8*>(a);
        bf16x8 b1 = *reinterpret_cast<const bf16x8*>(a + 32 * 256);
        p0 = __builtin_amdgcn_mfma_f32_32x32x16_bf16(b0, qr[d0], p0, 0, 0, 0);
        p1 = __builtin_amdgcn_mfma_f32_32x32x16_bf16(b1, qr[d0], p1, 0, 0, 0); }
}
template <int VB>
__device__ __forceinline__ void pv_tile(f32x16* o, int vb0, bf16x8 pa0, bf16x8 pa1, bf16x8 pa2, bf16x8 pa3) {
#define TRRD(dst, off) asm volatile("ds_read_b64_tr_b16 %0, %1 offset:%2" : "=&v"(dst) : "v"(vb0), "i"(off) : "memory")
#define PV_D0(d0) do { s16x4 l0, l1, l2, l3, h0, h1, h2, h3; constexpr int b_ = VB * SHM_V + v_rd_off(d0, 0, 0);   \
        TRRD(l0, b_); TRRD(h0, b_ + 2048); TRRD(l1, b_ + 4096); TRRD(h1, b_ + 6144); TRRD(l2, b_ + 8192); TRRD(h2, b_ + 10240); TRRD(l3, b_ + 12288); TRRD(h3, b_ + 14336); \
        asm volatile("s_waitcnt lgkmcnt(0)" ::: "memory"); SBAR();   \
        o[d0] = __builtin_amdgcn_mfma_f32_32x32x16_bf16(pa0, (bf16x8){l0[0], l0[1], l0[2], l0[3], h0[0], h0[1], h0[2], h0[3]}, o[d0], 0, 0, 0);   \
        o[d0] = __builtin_amdgcn_mfma_f32_32x32x16_bf16(pa1, (bf16x8){l1[0], l1[1], l1[2], l1[3], h1[0], h1[1], h1[2], h1[3]}, o[d0], 0, 0, 0);   \
        o[d0] = __builtin_amdgcn_mfma_f32_32x32x16_bf16(pa2, (bf16x8){l2[0], l2[1], l2[2], l2[3], h2[0], h2[1], h2[2], h2[3]}, o[d0], 0, 0, 0);   \
        o[d0] = __builtin_amdgcn_mfma_f32_32x32x16_bf16(pa3, (bf16x8){l3[0], l3[1], l3[2], l3[3], h3[0], h3[1], h3[2], h3[3]}, o[d0], 0, 0, 0); } while (0)
    PV_D0(0); PV_D0(1); PV_D0(2); PV_D0(3);
#undef PV_D0
#undef TRRD
}
struct BlockRef { const bf16* K; const float* C; int P0, jlo; float cref;
    __device__ __forceinline__ const bf16* Kp() const { return K; }
    __device__ __forceinline__ const bf16* Vp() const { return K + (WS_V - WS_K) / 2; }
    __device__ __forceinline__ const bf16* Qp() const { return K - (WS_K - WS_Q) / 2 + (size_t)P0 * LDQ; }
    __device__ __forceinline__ bf16* Op() const { return const_cast<bf16*>(Qp()); } };
struct Seam { bf16x8 qr[8]; bf16x8 st_v0, st_v1, st_k0, st_k1; };
__device__ __forceinline__ bf16x8 load8(const bf16* p) { return *reinterpret_cast<const bf16x8*>(p); }
#define ROW(p, k0, rr) ((p) + (size_t)((k0) + (rr)) * LDQ + sc)
#define VMW() asm volatile("s_waitcnt vmcnt(0)" ::: "memory")
#define VMWN(n) asm volatile("s_waitcnt vmcnt(%0)" :: "i"(n) : "memory")
#define SLOAD_H(Kp, Vp, k0) do { S.st_v0 = load8(ROW(Vp, k0, sr)); S.st_v1 = load8(ROW(Vp, k0, 32 + sr));              \
                         S.st_k0 = load8(ROW(Kp, k0, sr)); S.st_k1 = load8(ROW(Kp, k0, 32 + sr)); } while (0)
#define SWRITE_HK(bf) do { *(bf16x8*)(K_lds + (bf) * SHM_K + kws) = S.st_k0; *(bf16x8*)(K_lds + (bf) * SHM_K + kws + 32 * 256) = S.st_k1; } while (0)
#define SWRITE_HV(bf) do { *(bf16x8*)(V_lds + (bf) * SHM_V + vst0) = S.st_v0; *(bf16x8*)(V_lds + (bf) * SHM_V + vst1) = S.st_v1; } while (0)
#define SWRITE_H(bf) do { SWRITE_HV(bf); SWRITE_HK(bf); } while (0)
#define BIAS_FILL(ref_) do { int k_ = (int)threadIdx.x * 4; asm volatile("" : "+v"(k_)); const int kb_ = (ref_).jlo * KVBLK; for (; kb_ + k_ < (ref_).P0 + QB; k_ += NW * 64 * 4) *(f32x4*)(B_lds + k_ * 4) = ((ref_).cref - *(const f32x4*)((ref_).C + kb_ + k_)) * INVS; } while (0)
__device__ __forceinline__ void prime(const BlockRef& cur, char* lds, Seam& S) {
    const int tid = threadIdx.x, wid = __builtin_amdgcn_readfirstlane(tid >> 6), lane = tid & 63, r32 = lane & 31, hi = lane >> 5;
    const int sr = tid >> 4, sc = (tid & 15) * 8, kws = KSWZ(sr, sc * 2); char* K_lds = lds + 2 * SHM_V; char* B_lds = lds + OFF_B;
#pragma unroll
    for (int d0 = 0; d0 < 8; ++d0) S.qr[d0] = load8(cur.Qp() + (size_t)(wid * QBLK + r32) * LDQ + d0 * 16 + hi * 8);
    SLOAD_H(cur.Kp(), cur.Vp(), cur.jlo * KVBLK); BIAS_FILL(cur); VMW(); SWRITE_HK(0);
    __syncthreads();
}
__device__ __forceinline__ void block(const BlockRef& cur, const BlockRef& nxt, char* lds, Seam& S) {
    const int tid = threadIdx.x, wid = __builtin_amdgcn_readfirstlane(tid >> 6), lane = tid & 63, r32 = lane & 31, hi = lane >> 5;
    const int j_lo = cur.jlo, NT = (cur.P0 + QB) / KVBLK - j_lo;
    const int qlo = cur.P0 + wid * QBLK, qm = qlo + r32 - 4 * hi;
    char* V_lds = lds; char* K_lds = lds + 2 * SHM_V; char* B_lds = lds + OFF_B;
    float* ws = (float*)(lds + OFF_WS) + wid * 64; float* li_l = ws, * al_l = ws + 32;
    float m_reg = -1e30f, l_reg = 0; f32x16 o[4] = {};
    const int sr = tid >> 4, sc = (tid & 15) * 8, vst0 = v_st(sr, sc), vst1 = v_st(32 + sr, sc), kws = KSWZ(sr, sc * 2);
    const int vb0 = (int)(uintptr_t)V_lds + v_rd_base(lane);
    const bf16* Kh = cur.Kp(); const bf16* Vh = cur.Vp();
#define RESC(a) do { if (__any((a) < 1.f)) { if (hi == 0) al_l[r32] = (a); asm volatile("s_waitcnt lgkmcnt(0)" ::: "memory");              \
                     for (int d_ = 0; d_ < 4; ++d_) for (int r = 0; r < 16; ++r) o[d_][r] *= al_l[crow(r, hi)]; } } while (0)
#define KBASE(t) ((j_lo + (t)) * KVBLK)
#define MASKT(P0_, P1_, t) do { const int kb_ = KBASE(t); if (kb_ + KVBLK - 1 > qlo) mask_tile(P0_, P1_, qm - kb_); } while (0)
    constexpr int NQL = 8;
#define SEAM_K0() do { VMWN(NQL); SWRITE_HK(0); SBAR(); } while (0)
    f32x16 pA0, pA1, pB0, pB1; float mnA, mnB, alA, alB; bf16x8 pa0, pa1, pa2, pa3;
    SWRITE_HV(0); SBAR();
    SLOAD_H(Kh, Vh, KBASE(1));
    SBAR(); qkt<0>(pA0, pA1, K_lds, B_lds, r32, hi, S.qr);
    MASKT(pA0, pA1, 0); partialSM(pA0, pA1, m_reg, mnA, alA);
    VMW(); SWRITE_H(1);
    __syncthreads();
#define HALF_STEP(PX0, PX1, mnX, alX, PY0, PY1, alY, t, KB, VB, SB) do {                                                      \
        SBAR(); qkt<KB>(PX0, PX1, K_lds, B_lds + (t) * 256, r32, hi, S.qr);                                             \
        finishSM(PY0, PY1, alY, l_reg, pa0, pa1, pa2, pa3); SBAR();                                                           \
        if ((t) + 1 < NT) { SLOAD_H(Kh, Vh, KBASE((t) + 1)); SBAR(); }                                               \
        pv_tile<VB>(o, vb0, pa0, pa1, pa2, pa3); MASKT(PX0, PX1, (t)); partialSM(PX0, PX1, m_reg, mnX, alX);                                        \
        __syncthreads();                                                                                                      \
        if ((t) + 1 < NT) { VMW(); SWRITE_H(SB); }                                                                          \
        RESC(alX); __syncthreads(); } while (0)
    for (int t = 1; t + 1 < NT; t += 2) {
        HALF_STEP(pB0, pB1, mnB, alB, pA0, pA1, alA, t, 1, 0, 0);
        HALF_STEP(pA0, pA1, mnA, alA, pB0, pB1, alB, t + 1, 0, 1, 1);
    }
    SBAR(); qkt<1>(pB0, pB1, K_lds, B_lds + (NT - 1) * 256, r32, hi, S.qr); SBAR();
    SLOAD_H(nxt.Kp(), nxt.Vp(), nxt.jlo * KVBLK); SBAR();
#pragma unroll
    for (int d0 = 0; d0 < 8; ++d0) S.qr[d0] = load8(nxt.Qp() + (size_t)(wid * QBLK + r32) * LDQ + d0 * 16 + hi * 8);
    SBAR();
    finishSM(pA0, pA1, alA, l_reg, pa0, pa1, pa2, pa3); SBAR();
    pv_tile<0>(o, vb0, pa0, pa1, pa2, pa3);
    MASKT(pB0, pB1, NT - 1); partialSM(pB0, pB1, m_reg, mnB, alB); __syncthreads(); RESC(alB);
    finishSM(pB0, pB1, alB, l_reg, pa0, pa1, pa2, pa3); SBAR(); pv_tile<1>(o, vb0, pa0, pa1, pa2, pa3);
    SBAR(); SEAM_K0();
    if (hi == 0) li_l[r32] = l_reg; asm volatile("s_waitcnt lgkmcnt(0)" ::: "memory");
    float rli[16];
#pragma unroll
    for (int r = 0; r < 16; ++r) rli[r] = __builtin_amdgcn_rcpf(li_l[crow(r, hi)]);
    bf16* Ow = cur.Op() + (size_t)(wid * QBLK) * LDQ;
#pragma unroll
    for (int r = 0; r < 16; ++r) { const int orow = crow(r, hi);
#pragma unroll
        for (int d0 = 0; d0 < 4; ++d0) { const float v = o[d0][r] * rli[r];
            const float vn = __shfl_xor(v, 1);
            if ((r32 & 1) == 0) *(unsigned*)(Ow + (size_t)orow * LDQ + d0 * 32 + r32) = cvtpk(v, vn); } }
    BIAS_FILL(nxt);
    __syncthreads();
#undef RESC
#undef KBASE
#undef MASKT
#undef SEAM_K0
#undef HALF_STEP
}
#undef ROW
#undef VMW
#undef VMWN
#undef SLOAD_H
#undef SWRITE_HK
#undef SWRITE_HV
#undef SWRITE_H
#undef BIAS_FILL
#undef KSWZ
#undef SBAR
__device__ __forceinline__ BlockRef ref(int i, unsigned char* ws) {
    const int bh = i & 63, qb = 15 - (i >> 6), b = bh / NH, h = bh % NH;
    int lane = (int)threadIdx.x & 63; asm volatile("" : "+v"(lane));
    const unsigned* N2 = (const unsigned*)(ws + WS_CTL) + CW_N2;
    BlockRef r; r.K = (const bf16*)(ws + WS_K) + (size_t)b * SEQ * LDQ + h * D; r.C = (const float*)(ws + WS_CUM) + (size_t)bh * SEQ; r.P0 = qb * QB; r.cref = r.C[r.P0];
    float q2 = 0.f, k2 = 0.f;
#pragma unroll
    for (int w = 0; w < 4; ++w) { q2 += __uint_as_float(N2[bh * 4 + w]); k2 += __uint_as_float(N2[256 + bh * 4 + w]); }
    const float thr = 2.0f * (sqrtf(q2 * k2) * SCALE) + 8.4f + 25.0f;
    const float cj = r.C[64 * lane + 63];
    const bool skip = (lane < (r.P0 >> 6)) && (cj >= r.cref + thr);
    const unsigned long long bal = __ballot(skip);
    r.jlo = __builtin_amdgcn_readfirstlane((int)__builtin_ctzll(~bal)) & ~1;
    return r;
}
__device__ __forceinline__ void attn_phase(char* lds, unsigned char* ws, volatile int* slot) {
    constexpr int TOTAL = BATCH * NH * 16;
    unsigned* ctr = (unsigned*)(ws + WS_CTL) + CW_ATT;
    if (threadIdx.x == 0) { slot[0] = (int)atomicAdd(ctr, 1u); slot[1] = (int)atomicAdd(ctr, 1u); }
    __syncthreads();
    const int i0 = __builtin_amdgcn_readfirstlane(slot[0]), i1 = __builtin_amdgcn_readfirstlane(slot[1]);
    __syncthreads();
    if (i0 >= TOTAL) return;
    BlockRef cur = ref(i0, ws);
    bool has_nxt = i1 < TOTAL;
    BlockRef nxt = has_nxt ? ref(i1, ws) : cur;
    Seam S;
    prime(cur, lds, S);
    for (int it = 0;; ++it) {
        if (threadIdx.x == 0 && has_nxt) slot[it & 1] = (int)atomicAdd(ctr, 1u);
        block(cur, nxt, lds, S);
        if (!has_nxt) break;
        const int i2 = __builtin_amdgcn_readfirstlane(slot[it & 1]);
        cur = nxt; has_nxt = i2 < TOTAL;
        if (has_nxt) nxt = ref(i2, ws);
    }
}
}
__device__ __forceinline__ int tid_now() { int t = (int)threadIdx.x; asm volatile("" : "+v"(t)); return t; }
struct Frame {
    LAS unsigned char* lds; volatile LAS unsigned* MISC; unsigned* ctl;
    int tid, lane, wave, vcu, G;
};

__device__ __forceinline__ void p0_transpose_item(const float* W, int ldw, int col0, int k0, const float* gain, bf16* WT, int K, int drow0, int lane) {
    const int nq = lane & 7, ko = lane >> 3;
    const float* src = W + (size_t)(k0 + 8 * ko) * ldw + col0 + 4 * nq;
    f32x4 v[8];
#pragma unroll
    for (int j = 0; j < 8; ++j) v[j] = *(const f32x4*)(src + (size_t)j * ldw);
    f32x4 g0 = (f32x4){1.f, 1.f, 1.f, 1.f}, g1 = g0;
    if (gain) { g0 = *(const f32x4*)(gain + k0 + 8 * ko); g1 = *(const f32x4*)(gain + k0 + 8 * ko + 4); }
    bf16* dst = WT + (size_t)(drow0 + 4 * nq) * K + k0 + 8 * ko;
#pragma unroll
    for (int e = 0; e < 4; ++e) { u32x4 o; o.x = pk2(v[0][e] * g0.x, v[1][e] * g0.y); o.y = pk2(v[2][e] * g0.z, v[3][e] * g0.w); o.z = pk2(v[4][e] * g1.x, v[5][e] * g1.y); o.w = pk2(v[6][e] * g1.z, v[7][e] * g1.w);
        *(u32x4*)(dst + (size_t)e * K) = o; }
}
__device__ __forceinline__ void p0_transpose_item_fp8(const float* W, int ldw, int col0, int k0, const float* gain, unsigned char* WT8, int K, int drow0, int lane) {
    const int nq = lane & 7, ko = lane >> 3;
    const float* src = W + (size_t)(k0 + 8 * ko) * ldw + col0 + 4 * nq;
    f32x4 v[8];
#pragma unroll
    for (int j = 0; j < 8; ++j) v[j] = *(const f32x4*)(src + (size_t)j * ldw);
    f32x4 g0 = (f32x4){64.f, 64.f, 64.f, 64.f}, g1 = g0;
    if (gain) { g0 = *(const f32x4*)(gain + k0 + 8 * ko) * 64.0f; g1 = *(const f32x4*)(gain + k0 + 8 * ko + 4) * 64.0f; }
    unsigned char* dst = WT8 + (size_t)(drow0 + 4 * nq) * K + k0 + 8 * ko;
#pragma unroll
    for (int e = 0; e < 4; ++e) *(u32x2*)(dst + (size_t)e * K) = pack8_fp8((f32x4){v[0][e] * g0.x, v[1][e] * g0.y, v[2][e] * g0.z, v[3][e] * g0.w}, (f32x4){v[4][e] * g1.x, v[5][e] * g1.y, v[6][e] * g1.z, v[7][e] * g1.w});
}
__device__ __forceinline__ int win_src_col(int n0) {
    if (n0 < 3072) return C_Q + n0;
    if (n0 < 5120) { const int j = (n0 - 3072) >> 8, w = (n0 - 3072) & 255; return w < 128 ? C_U + 128 * j + w : C_CG + 128 * j + (w - 128); }
    if (n0 < 6144) return C_BG + (n0 - 5120);
    return C_GA + (n0 - 6144);
}
__device__ __forceinline__ void p0_weights(const Params& P, const Frame& F) {
    const int lane = tid_now() & 63;
    unsigned char* ws = P.ws;
    const int gw = F.vcu * NWAVES + F.wave, NGW = F.G * NWAVES;
    constexpr int I_IN = 32 * 320, I_A = 16 * 64, I_B = 16 * 64, I_OUT = 32 * 64, I_PG = 32 * 64, I_PE = 4 * 64, I_GU = 32 * 32 * 32, I_DN = 32 * 8 * 64;
    constexpr int NITEMS = I_IN + I_A + I_B + I_OUT + I_PG + I_PE + I_GU + I_DN;
    for (int it = gw; it < NITEMS; it += NGW) {
        int r = it;
        if (r < I_IN) { const int kb = r / 320, g = r % 320; p0_transpose_item(P.w_in, IN_COLS, win_src_col(32 * g), 64 * kb, P.g_mix, (bf16*)(ws + WS_WT_IN), DM, 32 * g, lane); continue; } r -= I_IN;
        if (r < I_A) { const int kb = r / 64, g = r % 64; p0_transpose_item(P.w_a, DM, 32 * g, 64 * kb, nullptr, (bf16*)(ws + WS_WT_A), FW, 32 * g, lane); continue; } r -= I_A;
        if (r < I_B) { const int kb = r / 64, g = r % 64; p0_transpose_item(P.w_b, DM, 32 * g, 64 * kb, nullptr, (bf16*)(ws + WS_WT_B), CW, 32 * g, lane); continue; } r -= I_B;
        if (r < I_OUT) { const int kb = r / 64, g = r % 64; p0_transpose_item(P.w_out, DM, 32 * g, 64 * kb, nullptr, (bf16*)(ws + WS_WT_OUT), DM, 32 * g, lane); continue; } r -= I_OUT;
        if (r < I_PG) { const int kb = r / 64, g = r % 64;
            p0_transpose_item_fp8(P.w_pg, DM, 32 * g, 64 * kb, P.g_ple, ws + WS_WT_PG, DM, 32 * g, lane); continue; }
 r -= I_PG;
        if (r < I_PE) { const int kb = r / 64, g = r % 64; p0_transpose_item(P.w_pe, DM, 32 * g, 64 * kb, nullptr, (bf16*)(ws + WS_WT_PE), PLE, 32 * g, lane); continue; } r -= I_PE;
        if (r < I_GU) { const int e = r / 1024, kb = (r % 1024) / 32, g = r % 32, n0 = 32 * g, j = n0 >> 8, w = n0 & 255; const int sc = w < 128 ? 128 * j + w : FF + 128 * j + (w - 128);
            p0_transpose_item_fp8(P.w_gu + (size_t)e * DM * 2 * FF, 2 * FF, sc, 64 * kb, P.g_ffn, ws + WS_WT_GU + (size_t)e * 2 * FF * DM, DM, n0, lane); continue; } r -= I_GU;
        { const int e = r / 512, kb = (r % 512) / 64, g = r % 64; p0_transpose_item_fp8(P.w_dn + (size_t)e * FF * DM, DM, 32 * g, 64 * kb, nullptr, ws + WS_WT_DN + (size_t)e * DM * FF, FF, 32 * g, lane); }
    }
}
__device__ __forceinline__ void p0_rowstats(const Params& P, const Frame& F) {
    unsigned char* ws = P.ws; float* rstd1 = (float*)(ws + WS_RSTD1); float* logf = (float*)(ws + WS_LOGF); bf16* XB = (bf16*)(ws + WS_XB);
    const int tid = tid_now(), lane = tid & 63;
    LAS f32x4* wfA = (LAS f32x4*)(F.lds + RING_OFF); LAS f32x4* wfB = wfA + DM;
    for (int k = tid; k < DM; k += NWAVES * 64) { const f32x4* w = (const f32x4*)(P.w_in + (size_t)k * IN_COLS + C_F); const float g = P.g_mix[k];
        const int s = (((k >> 8) * 4 + (k & 3)) << 6) + ((k >> 2) & 63); wfA[s] = w[0] * g; wfB[s] = w[1] * g; }
    __syncthreads();
    const int gw = F.vcu * NWAVES + F.wave, ngw = F.G * NWAVES;
    for (int t = gw; t < T; t += ngw) {
        const f32x4* xr = (const f32x4*)(P.x + (size_t)t * DM) + lane;
        f32x4 v[8]; float ss = 0.f;
#pragma unroll
        for (int j = 0; j < 8; ++j) { v[j] = xr[64 * j]; ss += (v[j].x * v[j].x + v[j].y * v[j].y) + (v[j].z * v[j].z + v[j].w * v[j].w); }
        ss = wave_sum(ss);
        const float rstd = 1.0f / sqrtf(ss * (1.0f / DM) + EPS);
        u32x2* xo = (u32x2*)(XB + (size_t)t * DM) + lane;
#pragma unroll
        for (int j = 0; j < 8; ++j) { u32x2 w; w.x = pk2(v[j].x * rstd, v[j].y * rstd); w.y = pk2(v[j].z * rstd, v[j].w * rstd); xo[64 * j] = w; }
        f32x4 fa = (f32x4){0.f, 0.f, 0.f, 0.f}, fb = fa;
        int lo = lane; asm volatile("" : "+v"(lo));
#pragma unroll
        for (int j = 0; j < 8; ++j)
#pragma unroll
            for (int e = 0; e < 4; ++e) { const int s = ((j * 4 + e) << 6) + lo; fa += wfA[s] * v[j][e]; fb += wfB[s] * v[j][e]; }
        float f[8] = {fa.x, fa.y, fa.z, fa.w, fb.x, fb.y, fb.z, fb.w};
#pragma unroll
        for (int i = 0; i < 8; ++i) f[i] = wave_sum(f[i]);
        if (lane == 0) { rstd1[t] = rstd;
#pragma unroll
            for (int i = 0; i < 8; ++i) { const float a = f[i] * rstd + P.b_f[i]; logf[(size_t)t * 8 + i] = fminf(a, 0.f) - log1pf(__expf(-fabsf(a))); } }
    }
    __syncthreads();
}
__device__ __forceinline__ void p0_pcast(const Params& P, const Frame& F) {
    const long gt = (long)F.vcu * (NWAVES * 64) + tid_now(), ngt = (long)F.G * NWAVES * 64;
    bf16* PB = (bf16*)(P.ws + WS_PB);
    for (long i = gt; i < (long)T * PLE / 8; i += ngt) { const f32x4 a = *(const f32x4*)(P.p + i * 8), b = *(const f32x4*)(P.p + i * 8 + 4);
        u32x4 o; o.x = pk2(a.x, a.y); o.y = pk2(a.z, a.w); o.z = pk2(b.x, b.y); o.w = pk2(b.z, b.w); *(u32x4*)(PB + i * 8) = o; }
}


__device__ __forceinline__ void p0_router_weights(const Params& P, const Frame& F) {
    const int gt = F.vcu * (NWAVES * 64) + tid_now(), ngt = F.G * NWAVES * 64;
    bf16* WRH = (bf16*)(P.ws + WS_WRH); bf16* WRL = (bf16*)(P.ws + WS_WRL);
    for (int i = gt; i < 48 * DM; i += ngt) { const int n = i / DM, k = i % DM;
        float v = 0.f; if (n < NE) v = P.w_re[(size_t)k * NE + n]; else if (n < NE + NGRP) v = P.w_rg[(size_t)k * NGRP + (n - NE)];
        v *= P.g_ffn[k]; const unsigned h = f2bf(v); const float lo = v - bf2f((unsigned short)h);
        WRH[i] = (bf16)h; WRL[i] = (bf16)f2bf(lo); }
}
__device__ __forceinline__ void router_mfma(const Params& P, const Frame& F) {
    unsigned char* ws = P.ws; const int tid = tid_now(), lane = tid & 63, r16 = lane & 15, kq = lane >> 4;
    const int gw = F.vcu * NWAVES + F.wave, NGW = F.G * NWAVES;
    const bf16* WRH = (const bf16*)(ws + WS_WRH); const bf16* WRL = (const bf16*)(ws + WS_WRL);
    int* EID = (int*)(ws + WS_EID); float* WTS = (float*)(ws + WS_WTS); int* POS = (int*)(ws + WS_POS); int* TOKL = (int*)(ws + WS_TOKL); float* RSTD2 = (float*)(ws + WS_RSTD2);
    unsigned* CNT = F.ctl + CW_CNT;
    LAS float* L = (LAS float*)(F.lds + RING_OFF + F.wave * 4096);
    for (int task = gw; task < T / 16; task += NGW) {
        const bf16* xr = (const bf16*)(ws + WS_X1B) + (size_t)(task * 16 + r16) * DM + 8 * kq;
        const bf16* wh = WRH + (size_t)r16 * DM + 8 * kq; const bf16* wl = WRL + (size_t)r16 * DM + 8 * kq;
        f32x4 acc[3]; float ss = 0.f;
#pragma unroll
        for (int nb = 0; nb < 3; ++nb) acc[nb] = (f32x4){0.f, 0.f, 0.f, 0.f};
#pragma unroll 2
        for (int ks = 0; ks < DM / 32; ++ks) {
            const u32x4 xw = *(const u32x4*)(xr + ks * 32);
            { const f32x4 a0 = bflo4(xw), a1 = bfhi4(xw); ss += (a0.x * a0.x + a0.y * a0.y) + (a0.z * a0.z + a0.w * a0.w) + (a1.x * a1.x + a1.y * a1.y) + (a1.z * a1.z + a1.w * a1.w); }
            const bf16x8 ah = __builtin_bit_cast(bf16x8, xw);
#pragma unroll
            for (int nb = 0; nb < 3; ++nb) { const bf16x8 bh = *(const bf16x8*)(wh + (size_t)nb * 16 * DM + ks * 32), bl = *(const bf16x8*)(wl + (size_t)nb * 16 * DM + ks * 32);
                acc[nb] = __builtin_amdgcn_mfma_f32_16x16x32_bf16(ah, bh, acc[nb], 0, 0, 0);
                acc[nb] = __builtin_amdgcn_mfma_f32_16x16x32_bf16(ah, bl, acc[nb], 0, 0, 0); }
        }
        ss += __shfl_xor(ss, 16); ss += __shfl_xor(ss, 32);
#pragma unroll
        for (int nb = 0; nb < 3; ++nb)
#pragma unroll
            for (int j = 0; j < 4; ++j) L[(4 * kq + j) * 48 + nb * 16 + r16] = acc[nb][j];
        asm volatile("s_waitcnt lgkmcnt(0)" ::: "memory");
        if (lane < 16) {
            const int t = task * 16 + lane; const LAS float* lg = L + lane * 48;
            const float rstd = 1.0f / sqrtf(ss * (1.0f / DM) + EPS);
            float gl[4];
#pragma unroll
            for (int i = 0; i < 4; ++i) gl[i] = lg[32 + i] * rstd + P.b_rg[i];
            int grp = 0; float gm = gl[0];
#pragma unroll
            for (int i = 1; i < 4; ++i) if (gl[i] > gm) { gm = gl[i]; grp = i; }
            float gsum = 0.f;
#pragma unroll
            for (int i = 0; i < 4; ++i) gsum += __expf(gl[i] - gm);
            const float p_grp = 1.0f / gsum;
            float es[8];
#pragma unroll
            for (int i = 0; i < 8; ++i) es[i] = lg[grp * 8 + i] * rstd + P.b_re[grp * 8 + i];
            int i1 = 0; float l1 = es[0];
#pragma unroll
            for (int i = 1; i < 8; ++i) if (es[i] > l1) { l1 = es[i]; i1 = i; }
            int i2 = -1; float l2 = -3.0e38f;
#pragma unroll
            for (int i = 0; i < 8; ++i) if (i != i1 && es[i] > l2) { l2 = es[i]; i2 = i; }
            const float w1 = 1.0f / (1.0f + __expf(l2 - l1)), w2 = 1.0f - w1;
            const int e1 = grp * EPG + i1, e2 = grp * EPG + i2, s0 = e1, s1 = NE + e2;
            const unsigned p0 = atomicAdd(&CNT[s0], 1u), p1 = atomicAdd(&CNT[s1], 1u);
            RSTD2[t] = rstd; EID[2 * t] = e1; EID[2 * t + 1] = e2; WTS[2 * t] = p_grp * w1; WTS[2 * t + 1] = p_grp * w2; POS[2 * t] = (int)p0; POS[2 * t + 1] = (int)p1;
            TOKL[(size_t)s0 * T + p0] = t; TOKL[(size_t)s1 * T + p1] = t;
        }
        asm volatile("s_waitcnt lgkmcnt(0)" ::: "memory");
    }
}


__device__ __forceinline__ void thin_rstd_bf16(const bf16* X, float* RSTD, int gw, int ngw, int lane) {
    for (int t = gw; t < T; t += ngw) { const u32x4* xr = (const u32x4*)(X + (size_t)t * DM) + lane; float ss = 0.f;
#pragma unroll
        for (int j = 0; j < 4; ++j) { const u32x4 w = xr[64 * j]; const f32x4 a = bflo4(w), b = bfhi4(w); ss += (a.x * a.x + a.y * a.y) + (a.z * a.z + a.w * a.w) + (b.x * b.x + b.y * b.y) + (b.z * b.z + b.w * b.w); }
        ss = wave_sum(ss);
        if (lane == 0) RSTD[t] = 1.0f / sqrtf(ss * (1.0f / DM) + EPS); }
}
__device__ __forceinline__ void thin_final_bf16(const Params& P, const bf16* X, int gw, int ngw, int lane) {
    for (int t = gw; t < T; t += ngw) { const u32x4* xr = (const u32x4*)(X + (size_t)t * DM) + lane; u32x4 w[4]; float ss = 0.f;
#pragma unroll
        for (int j = 0; j < 4; ++j) { w[j] = xr[64 * j]; const f32x4 a = bflo4(w[j]), b = bfhi4(w[j]); ss += (a.x * a.x + a.y * a.y) + (a.z * a.z + a.w * a.w) + (b.x * b.x + b.y * b.y) + (b.z * b.z + b.w * b.w); }
        ss = wave_sum(ss);
        const float rstd = 1.0f / sqrtf(ss * (1.0f / DM) + EPS);
        f32x4* o = (f32x4*)(P.out + (size_t)t * DM); const f32x4* g = (const f32x4*)P.g_final;
#pragma unroll
        for (int j = 0; j < 4; ++j) { const int c = 2 * (lane + 64 * j); o[c] = bflo4(w[j]) * rstd * g[c]; o[c + 1] = bfhi4(w[j]) * rstd * g[c + 1]; } }
}

struct MegaArgs { Params P; int ph_lo, ph_hi; };
constexpr int NPHASE = 12;
__global__ void __launch_bounds__(NWAVES * 64, 2) mega_fwd(MegaArgs args) {
    extern __shared__ __attribute__((aligned(16))) unsigned char lds_raw[];
    const Params& P = args.P;
    Frame F;
    F.lds = (LAS unsigned char*)lds_raw;
    F.MISC = (volatile LAS unsigned*)(F.lds + MISC_OFF);
    F.tid = threadIdx.x; F.lane = F.tid & 63; F.wave = __builtin_amdgcn_readfirstlane(F.tid >> 6);
    F.G = gridDim.x; { const int bx = blockIdx.x; F.vcu = (F.G % 8 == 0) ? (bx % 8) * (F.G / 8) + bx / 8 : bx; }
    F.ctl = (unsigned*)(P.ws + WS_CTL);
    for (int u = F.tid; u < (LDS_BYTES - LDSCTL_OFF) / 4; u += NWAVES * 64) ((LAS unsigned*)(F.lds + LDSCTL_OFF))[u] = 0u;
    __syncthreads();
    const int lo = args.ph_lo, hi = args.ph_hi;
    XcdBarrier bar; bar.bar = F.ctl + CW_BAR; bar.x = 0; bar.st = nullptr;
    if (hi - lo > 1) bar = xcd_barrier_post(F.ctl + CW_BAR, F.MISC + 8);
#define IN(k) (lo <= (k) && (k) < hi)
#define SEAM(k) do { if (IN(k) && IN((k) + 1)) xcd_barrier(bar); } while (0)
    const int gw = F.vcu * NWAVES + F.wave, NGW = F.G * NWAVES;
    unsigned char* ws = P.ws;

    if (IN(0)) { p0_rowstats(P, F); p0_weights(P, F); p0_pcast(P, F); p0_router_weights(P, F); }
    SEAM(0);
    if (IN(1)) {
        thin_cumsum(P, gw, NGW, tid_now() & 63);
#if defined(LDS_NAN_CHECK)
        for (int u = F.tid; u < RING_BYTES / 4; u += NWAVES * 64) ((LAS unsigned*)(F.lds + RING_OFF))[u] = 0x7FC07FC0u;
        __syncthreads();
#endif
        pg8::StaticOrder S; S.init(ws + WS_XB, ws + WS_WT_IN, T, 10240, DM, F.G, (int)blockIdx.x);
        pg8::EpiIn E{ws};
        pg8::gemm_phase<pg8::EpiIn, pg8::StaticOrder, false>(F.lds + RING_OFF, DM, S, E);
    }
    SEAM(1);
    if (IN(2)) { thin_conv(P, (long)F.vcu * (NWAVES * 64) + tid_now(), (long)F.G * NWAVES * 64);
        fox::attn_phase((char*)lds_raw, ws, (volatile int*)((char*)lds_raw + MISC_OFF + 64));
    }
    SEAM(2);
    if (IN(3)) {
        { pg8::StaticOrder S; S.init(ws + WS_Q, ws + WS_WT_A, T, DM, FW, F.G, (int)blockIdx.x); pg8::EpiMerge<0> E{ws};
          pg8::gemm_phase<pg8::EpiMerge<0>, pg8::StaticOrder, false>(F.lds + RING_OFF, FW, S, E); }
        asm volatile("s_waitcnt vmcnt(0)" ::: "memory"); __syncthreads();
        { pg8::StaticOrder S; S.init(ws + WS_BG, ws + WS_WT_B, T, DM, CW, F.G, (int)blockIdx.x); pg8::EpiMerge<1> E{ws};
          pg8::gemm_phase<pg8::EpiMerge<1>, pg8::StaticOrder, false>(F.lds + RING_OFF, CW, S, E); }
    }
    SEAM(3);
    if (IN(4)) {
        { pg8::StaticOrder S; S.init(ws + WS_MERGED, ws + WS_WT_OUT, T, DM, DM, F.G, (int)blockIdx.x); pg8::EpiX1 E{P.x, (bf16*)(ws + WS_X1B), ws + WS_X1F8};
          pg8::gemm_phase<pg8::EpiX1, pg8::StaticOrder, false>(F.lds + RING_OFF, DM, S, E); }
        { pg8::StaticOrder S; S.init(ws + WS_PB, ws + WS_WT_PE, T, DM, PLE, F.G, (int)blockIdx.x); pg8::EpiPlain E{(bf16*)(ws + WS_PP), DM};
          pg8::gemm_phase<pg8::EpiPlain, pg8::StaticOrder, false>(F.lds + RING_OFF, PLE, S, E); }
    }
    SEAM(4);
    if (IN(5)) { router_mfma(P, F); }
    SEAM(5);
    LAS int* segt = (LAS int*)(F.lds + SEGT_OFF);
    if (IN(6) || IN(7) || IN(8)) {
        if (tid_now() == 0) { const unsigned* CNT = F.ctl + CW_CNT; int mt = 0, sb = 0;
            for (int s = 0; s < NSEG; ++s) { const int c = (int)__hip_atomic_load(CNT + s, __ATOMIC_RELAXED, __HIP_MEMORY_SCOPE_AGENT); segt[s] = c; segt[64 + s] = mt; segt[129 + s] = sb; const int n = (c + 255) >> 8; mt += n; sb += n << 8; }
            segt[64 + NSEG] = mt; segt[129 + NSEG] = sb; }
        __syncthreads();
    }
    if (IN(6)) {
        pg8::SegOrder S; S.tab = segt; S.nN = 2 * FF / 256; S.G = F.G; S.c = F.vcu; S.seg_lo = 0; S.seg_hi = NSEG; S.K = DM / 2; S.down = 0; S.A = (const char*)(ws + WS_X1F8); S.Bt = (const char*)(ws + WS_WT_GU); S.TOKL = (const int*)(ws + WS_TOKL);
        pg8::EpiGU E{ws};
        pg8::gemm_phase<pg8::EpiGU, pg8::SegOrder, true, true>(F.lds + RING_OFF, DM / 2, S, E);
    }
    SEAM(6);
    if (IN(7)) {
        pg8::SegOrder S; S.tab = segt; S.nN = DM / 256; S.G = F.G; S.c = F.vcu; S.seg_lo = 0; S.seg_hi = NE; S.K = FF / 2; S.down = 1; S.A = (const char*)(ws + WS_HACT); S.Bt = (const char*)(ws + WS_WT_DN); S.TOKL = (const int*)(ws + WS_TOKL);
        pg8::EpiDN<false> E{ws};
        pg8::gemm_phase<pg8::EpiDN<false>, pg8::SegOrder, false, true, 121, 124>(F.lds + RING_OFF, FF / 2, S, E);
    }
    SEAM(7);
    if (IN(8)) {
        pg8::SegOrder S; S.tab = segt; S.nN = DM / 256; S.G = F.G; S.c = F.vcu; S.seg_lo = NE; S.seg_hi = NSEG; S.K = FF / 2; S.down = 1; S.A = (const char*)(ws + WS_HACT); S.Bt = (const char*)(ws + WS_WT_DN); S.TOKL = (const int*)(ws + WS_TOKL);
        pg8::EpiDN<true> E{ws};
        pg8::gemm_phase<pg8::EpiDN<true>, pg8::SegOrder, false, true, 121, 124>(F.lds + RING_OFF, FF / 2, S, E);
    }
    SEAM(8);
    if (IN(9)) { thin_rstd_bf16((const bf16*)(ws + WS_X1B), (float*)(ws + WS_RSTD3), gw, NGW, tid_now() & 63); }
    SEAM(9);
    if (IN(10)) {
        pg8::EpiPle E{(const bf16*)(ws + WS_X1B), (bf16*)(ws + WS_X2B), (const bf16*)(ws + WS_PP), (const float*)(ws + WS_RSTD3)};
        pg8::StaticOrder S; S.init(ws + WS_X2F8, ws + WS_WT_PG, T, DM, DM / 2, F.G, (int)blockIdx.x);
        pg8::gemm_phase<pg8::EpiPle, pg8::StaticOrder, false, true>(F.lds + RING_OFF, DM / 2, S, E);
    }
    SEAM(10);
    if (IN(11)) { thin_final_bf16(P, (const bf16*)(ws + WS_X2B), gw, NGW, tid_now() & 63); }
#undef IN
#undef SEAM
}
static void launch_mega(const Params& P, int lo, int hi, hipStream_t stream) {
    static bool attr_done = false;
    if (!attr_done) { attr_done = true;
        if (hipFuncSetAttribute((const void*)mega_fwd, hipFuncAttributeMaxDynamicSharedMemorySize, LDS_BYTES) != hipSuccess) fprintf(stderr, "kernel_launch: hipFuncSetAttribute failed\n");
        (void)hipGetLastError(); }
    if (lo >= hi) return;
    MegaArgs a; memset(&a, 0, sizeof(a)); a.P = P; a.ph_lo = lo; a.ph_hi = hi;
    hipLaunchKernelGGL(mega_fwd, dim3(256), dim3(NWAVES * 64), LDS_BYTES, stream, a);
    const hipError_t le = hipPeekAtLastError();
    if (le != hipSuccess) fprintf(stderr, "kernel_launch: mega launch [%d,%d) failed: %s\n", lo, hi, hipGetErrorName(le));
}
extern "C" void kernel_launch(void* const* d_in, const int* in_sizes, int n_in, void* d_out, int out_size, void* d_ws, size_t ws_size, hipStream_t stream) {
    if (n_in != 20 || in_sizes[0] != T * DM || out_size != T * DM || ws_size < WS_END) {
        fprintf(stderr, "kernel_launch: unexpected shapes (n_in %d, in0 %d, out %d, ws %zu; need ws >= %zu); nothing launched\n", n_in, n_in > 0 ? in_sizes[0] : -1, out_size, ws_size, (size_t)WS_END); return; }
    Params P; memset(&P, 0, sizeof(P));
    const float** pp = (const float**)&P;
    for (int i = 0; i < 20; ++i) pp[i] = (const float*)d_in[i];
    P.out = (float*)d_out; P.ws = (unsigned char*)d_ws;
    unsigned char* ws = P.ws;
    (void)hipMemsetAsync(ws + WS_CTL, 0, 1 * MiB, stream);
    launch_mega(P, 0, NPHASE, stream);
}
```

```cpp
#include <hip/hip_runtime.h>
#include <cstdio>
#include <cstdint>
#include <cstring>

constexpr int BATCH = 8, SEQ = 4096, DM = 2048, T = BATCH * SEQ;
constexpr int NH = 8, HD = 128, FW = 1024, CW = 1024, PLE = 256, NGRP = 4, EPG = 8, NE = 32, FF = 512;
constexpr int IN_COLS = 3 * FW + NH + 3 * CW + 2 * DM;
constexpr int C_Q = 0, C_K = 1024, C_V = 2048, C_F = 3072, C_U = 3080, C_BG = 4104, C_CG = 5128, C_GA = 6152;
constexpr float EPS = 1e-6f;
constexpr int NSEG = 64;

constexpr size_t MiB = 1u << 20;
constexpr size_t WS_CTL = 0;
constexpr size_t WS_RSTD1 = 1 * MiB;
constexpr size_t WS_LOGF = 2 * MiB;
constexpr size_t WS_CUM = 3 * MiB;
constexpr size_t WS_NQ = 6 * MiB;
constexpr size_t WS_RSTD2 = 4 * MiB, WS_RSTD3 = 5 * MiB;
constexpr size_t WS_EID = 7 * MiB;
constexpr size_t WS_WTS = 7 * MiB + 512 * 1024;
constexpr size_t WS_POS = 8 * MiB;
constexpr size_t WS_SEGB = 8 * MiB + 512 * 1024;
constexpr size_t WS_TOKL = 9 * MiB;
constexpr size_t WS_WRH = 17 * MiB, WS_WRL = 17 * MiB + 256 * 1024;
constexpr size_t WS_WT_IN = 20 * MiB, WS_WT_A = 60 * MiB, WS_WT_B = 64 * MiB, WS_WT_OUT = 68 * MiB, WS_WT_PG = 76 * MiB, WS_WT_PE = 84 * MiB;
constexpr size_t WS_PB = 86 * MiB;
constexpr size_t WS_WT_GU = 104 * MiB, WS_WT_DN = 232 * MiB;
constexpr size_t WS_WT_IN8 = WS_WT_IN + (size_t)6144 * 2048 * 2;
constexpr size_t WS_SC = 264 * MiB;
constexpr size_t WS_XB8 = 168 * MiB;
constexpr size_t WS_XB = 296 * MiB;
constexpr size_t WS_Q = 424 * MiB, WS_K = 488 * MiB, WS_V = 552 * MiB;
constexpr size_t WS_Z = 616 * MiB, WS_BG = 680 * MiB;
constexpr size_t WS_GAB = 744 * MiB;
constexpr size_t WS_MERGED = 552 * MiB;
constexpr size_t WS_X1B = 424 * MiB;
constexpr size_t WS_HACT = 552 * MiB;
constexpr size_t WS_X2B = 744 * MiB;
constexpr size_t WS_PP = 872 * MiB;
constexpr size_t WS_X2F8 = 632 * MiB;
constexpr size_t WS_X1F8 = 680 * MiB;
constexpr size_t WS_END = 1000 * MiB;
constexpr int CW_CNT = 16384, CNT_STRIDE = 64;
constexpr int CW_N2 = 2048;
constexpr int CW_ATT = 3072;

typedef unsigned short bf16;
typedef float f32x4 __attribute__((ext_vector_type(4)));
typedef unsigned u32x4 __attribute__((ext_vector_type(4)));
typedef unsigned u32x2 __attribute__((ext_vector_type(2)));

struct Params {
    const float *x, *p, *g_mix, *w_in, *b_f, *conv_w, *w_a, *w_b, *w_out, *g_ffn, *w_rg, *b_rg, *w_re, *b_re, *w_gu, *w_dn, *g_ple, *w_pg, *w_pe, *g_final;
    float* out; unsigned char* ws;
};

__device__ __forceinline__ unsigned f2bf(float f) { unsigned u = __builtin_bit_cast(unsigned, f); return (u + 0x7fffu + ((u >> 16) & 1u)) >> 16; }
__device__ __forceinline__ unsigned pk2(float lo, float hi) { return f2bf(lo) | (f2bf(hi) << 16); }
__device__ __forceinline__ float bf2f(unsigned short b) { return __builtin_bit_cast(float, (unsigned)b << 16); }
__device__ __forceinline__ float bflo(unsigned w) { return __builtin_bit_cast(float, w << 16); }
__device__ __forceinline__ float bfhi(unsigned w) { return __builtin_bit_cast(float, w & 0xffff0000u); }
__device__ __forceinline__ float wave_sum(float v) {
#pragma unroll
    for (int o = 1; o < 64; o <<= 1) v += __shfl_xor(v, o);
    return v;
}
__device__ __forceinline__ float wave_max(float v) {
#pragma unroll
    for (int o = 1; o < 64; o <<= 1) v = fmaxf(v, __shfl_xor(v, o));
    return v;
}
__device__ __forceinline__ float sigmoidf_(float v) { return 1.0f / (1.0f + __expf(-v)); }

__device__ __forceinline__ void thin_cumsum(const Params& P, int gw, int ngw, int lane) {
    const float* logf = (const float*)(P.ws + WS_LOGF); float* cum = (float*)(P.ws + WS_CUM);
    for (int bh = gw; bh < BATCH * NH; bh += ngw) {
        const int b = bh / NH, h = bh % NH;
        const float* src = logf + ((size_t)b * SEQ + lane * 64) * 8 + h;
        double s = 0.0;
        for (int i = 0; i < 64; ++i) s += (double)src[(size_t)i * 8];
        double incl = s;
#pragma unroll
        for (int o = 1; o < 64; o <<= 1) { const double up = __shfl_up(incl, o); if (lane >= o) incl += up; }
        double run = incl - s;
        float* dst = cum + (size_t)bh * SEQ + lane * 64;
        for (int i = 0; i < 64; ++i) { run += (double)src[(size_t)i * 8]; dst[i] = (float)run; }
    }
}
__device__ __forceinline__ void thin_conv(const Params& P, long gt, long ngt) {
    const bf16* Z = (const bf16*)(P.ws + WS_Z); bf16* BG = (bf16*)(P.ws + WS_BG);
    for (long i = gt; i < (long)T * (CW / 8); i += ngt) {
        const int t = (int)(i / (CW / 8)), c = (int)(i % (CW / 8)) * 8, s = t % SEQ;
        const u32x4 z2 = *(const u32x4*)(Z + (size_t)t * CW + c);
        u32x4 z1 = (u32x4){0u, 0u, 0u, 0u}, z0 = (u32x4){0u, 0u, 0u, 0u};
        if (s >= 1) z1 = *(const u32x4*)(Z + (size_t)(t - 1) * CW + c);
        if (s >= 2) z0 = *(const u32x4*)(Z + (size_t)(t - 2) * CW + c);
        const u32x4 b = *(const u32x4*)(BG + (size_t)t * CW + c);
        u32x4 o;
#pragma unroll
        for (int q = 0; q < 4; ++q) {
            const int c0 = c + 2 * q;
            const float lo = bflo(b[q]) * (P.conv_w[c0] * bflo(z0[q]) + P.conv_w[CW + c0] * bflo(z1[q]) + P.conv_w[2 * CW + c0] * bflo(z2[q]));
            const float hi = bfhi(b[q]) * (P.conv_w[c0 + 1] * bfhi(z0[q]) + P.conv_w[CW + c0 + 1] * bfhi(z1[q]) + P.conv_w[2 * CW + c0 + 1] * bfhi(z2[q]));
            o[q] = pk2(lo, hi);
        }
        *(u32x4*)(BG + (size_t)t * CW + c) = o;
    }
}
#define LAS __attribute__((address_space(3)))
#define GAS __attribute__((address_space(1)))
typedef short bf16x8 __attribute__((ext_vector_type(8)));
typedef float f32x2 __attribute__((ext_vector_type(2)));
constexpr int NWAVES = 8;
constexpr int RING_OFF = 0, RING_BYTES = 131072;
constexpr int LDSCTL_OFF = RING_BYTES, MISC_OFF = LDSCTL_OFF + 320;
constexpr int SEGT_OFF = LDSCTL_OFF + 1024;
constexpr int LDS_BYTES = 147456;
constexpr int CW_BAR = 4096;
typedef __bf16 bf16x2_t __attribute__((ext_vector_type(2)));
__device__ __forceinline__ unsigned cvt_pk_bf16(float lo, float hi) { f32x2 v = {lo, hi}; bf16x2_t b = __builtin_convertvector(v, bf16x2_t); return __builtin_bit_cast(unsigned, b); }
typedef int i32x8 __attribute__((ext_vector_type(8)));
typedef unsigned u32x8 __attribute__((ext_vector_type(8)));
__device__ __forceinline__ u32x2 pack8_fp8(f32x4 a, f32x4 b) { u32x2 w; int t = __builtin_amdgcn_cvt_pk_fp8_f32(a.x, a.y, 0, false); t = __builtin_amdgcn_cvt_pk_fp8_f32(a.z, a.w, t, true); w.x = (unsigned)t;
    t = __builtin_amdgcn_cvt_pk_fp8_f32(b.x, b.y, 0, false); t = __builtin_amdgcn_cvt_pk_fp8_f32(b.z, b.w, t, true); w.y = (unsigned)t; return w; }
__device__ __forceinline__ float fast_sigmoid(float v) { return __builtin_amdgcn_rcpf(1.0f + __builtin_amdgcn_exp2f(v * -1.4426950408889634f)); }

#define XB_TMO      128
#define XB_XCNT(j)  (256  + 64 * (j))
#define XB_XSUB(j)  (1280 + 64 * (j))
#define XB_XGEN(j)  (2304 + 64 * (j))
#define XB_TOP      3328
#define XB_TOPGEN   3392
#define XCD_BAR_WORDS 3456
#define XB_SPIN_CAP (1u << 18)
__device__ __forceinline__ unsigned xb_ld(unsigned* p)              { return __hip_atomic_load(p, __ATOMIC_RELAXED, __HIP_MEMORY_SCOPE_AGENT); }
__device__ __forceinline__ unsigned xb_add(unsigned* p, unsigned v) { return __hip_atomic_fetch_add(p, v, __ATOMIC_RELAXED, __HIP_MEMORY_SCOPE_AGENT); }
__device__ __forceinline__ unsigned xb_xcc_id() { return (unsigned)__builtin_amdgcn_s_getreg((3 << 11) | 20) & 0xFu; }
#define XB_SPIN(cond, bar) do { unsigned _sp = 0; while (cond) { __builtin_amdgcn_s_sleep(1); \
    if ((++_sp & 255u) == 0u) { if (xb_ld(&(bar)[XB_TMO])) break; if (_sp > XB_SPIN_CAP) { atomicAdd(&(bar)[XB_TMO], 1u); break; } } } } while (0)
struct XcdBarrier { unsigned* bar; unsigned x; volatile LAS unsigned* st; };
__device__ __forceinline__ XcdBarrier xcd_barrier_post(unsigned* bar, volatile LAS unsigned* st) {
    XcdBarrier b; b.bar = bar; b.x = xb_xcc_id(); b.st = st;
    if (threadIdx.x == 0) (void)xb_add(&bar[XB_XCNT(b.x)], 1u);
    return b;
}
__device__ __forceinline__ void xcd_barrier_complete(unsigned* bar, unsigned x, unsigned& nloc, unsigned& nx) {
    const unsigned G = gridDim.x * gridDim.y * gridDim.z;
    unsigned sum, cnt, mine, sp = 0u;
    for (;;) {
        sum = 0u; cnt = 0u; mine = 0u;
#pragma unroll
        for (unsigned j = 0; j < 16; ++j) { const unsigned c = xb_ld(&bar[XB_XCNT(j)]); sum += c; cnt += (c > 0u) ? 1u : 0u; mine = (j == x) ? c : mine; }
        if (sum == G) break;
        __builtin_amdgcn_s_sleep(1);
        if ((++sp & 255u) == 0u) { if (xb_ld(&bar[XB_TMO])) break; if (sp > XB_SPIN_CAP) { atomicAdd(&bar[XB_TMO], 1u); break; } }
    }
    nloc = mine > 0u ? mine : 1u; nx = cnt > 0u ? cnt : 1u;
}
__device__ __forceinline__ void xcd_barrier(const XcdBarrier& b) {
    asm volatile("s_waitcnt vmcnt(0)" ::: "memory");
    __syncthreads();
    if (threadIdx.x == 0) {
        unsigned* bar = b.bar;
        __builtin_amdgcn_s_waitcnt(0);
        unsigned nloc = b.st[0], nx = b.st[1];
        if (nloc == 0u) { xcd_barrier_complete(bar, b.x, nloc, nx); b.st[0] = nloc; b.st[1] = nx; }
        const unsigned old = xb_add(&bar[XB_XSUB(b.x)], 1u);
        const unsigned gen = old / nloc;
        if (old + 1u == (gen + 1u) * nloc) {
            __builtin_amdgcn_fence(__ATOMIC_RELEASE, "agent");
            asm volatile("s_waitcnt vmcnt(0)" ::: "memory");
            const unsigned og = xb_add(&bar[XB_TOP], 1u);
            const unsigned tg = og / nx;
            if (og + 1u == (tg + 1u) * nx) xb_add(&bar[XB_TOPGEN], 1u);
            else XB_SPIN(xb_ld(&bar[XB_TOPGEN]) == tg, bar);
            __builtin_amdgcn_fence(__ATOMIC_ACQUIRE, "agent");
            xb_add(&bar[XB_XGEN(b.x)], 1u);
            asm volatile("s_waitcnt vmcnt(0)" ::: "memory");
        } else {
            XB_SPIN(xb_ld(&bar[XB_XGEN(b.x)]) == gen, bar);
            __builtin_amdgcn_fence(__ATOMIC_ACQUIRE, "agent");
            asm volatile("s_waitcnt vmcnt(0)" ::: "memory");
        }
    }
    __syncthreads();
}

struct Params;
struct XItem { const float* src; const float* gain; unsigned char* dst; int ldw, K, fp8; };
struct SidePair { XItem a, b; f32x4 va[8], vb[8]; int n; };
__device__ __forceinline__ void side_load(const Params& P, int gw, int NGW, int k, int lane, SidePair& sp);
__device__ __forceinline__ void side_store(int lane, const SidePair& sp);
namespace pg8 {
constexpr int BM = 256, BK = 64, HALF = 128, HTB = HALF * BK * 2, STAGE_BYTES = 8 * HTB, NXCD = 8, WGM = 8;
__host__ __device__ __forceinline__ int lds_byte(int r, int c) { const int st = (r >> 4) * 2 + (c >> 5), rr = r & 15, cc = c & 31, ob = rr * 64 + cc * 2; return st * 1024 + (ob ^ (((ob >> 9) & 1) << 5)); }
__host__ __device__ __forceinline__ void stage_rc(int b, int& R, int& C) { const int st = b / 1024, sb = b % 1024, swz = sb ^ (((sb >> 9) & 1) << 5); R = (st >> 1) * 16 + swz / 64; C = (st & 1) * 32 + (swz % 64) / 2; }
__host__ __device__ __forceinline__ int perm32(int rho) { const int n = rho >> 4, i = rho & 15; return 8 * (i >> 2) + 4 * n + (i & 3); }

struct Unit { int pm, pn, seg, mt, nrow, slot0, ui; const char* a; const char* b; };

struct StaticOrder {
    int nM, nN, nwg, G, c, K; const char* A; const char* Bt;
    __device__ void init(const void* A_, const void* Bt_, int M, int N, int K_, int G_, int c_) { A = (const char*)A_; Bt = (const char*)Bt_; nM = M / BM; nN = N / BM; nwg = nM * nN; G = G_; c = c_; K = K_; }
    __device__ bool next(int i, Unit& u) const {
        const long L = (long)i * G + c; if (L >= nwg) return false;
        int wgid = (int)L; { const int q = nwg / NXCD, r = nwg % NXCD, xcd = wgid % NXCD, off = wgid / NXCD; wgid = (xcd < r ? xcd * (q + 1) : r * (q + 1) + (xcd - r) * q) + off; }
        const int nig = WGM * nN, gid = wgid / nig, fm = gid * WGM, gsz = (nM - fm) < WGM ? (nM - fm) : WGM;
        u.pm = fm + ((wgid % nig) % gsz); u.pn = (wgid % nig) / gsz;
#if defined(REV_PN)
        u.pn = nN - 1 - u.pn;
#endif
        u.seg = 0; u.mt = 0; u.nrow = BM; u.slot0 = 0;
        u.a = A + (size_t)u.pm * BM * K * 2; u.b = Bt + (size_t)u.pn * BM * K * 2; return true;
    }
    __device__ __forceinline__ unsigned arow(const Unit&, int r) const { return (unsigned)r; }
};

template <class Epi, class Sched, bool GATHER, bool FP8 = false, int SCW = 121, int SCA = 127>
__device__ __forceinline__ void gemm_phase(LAS unsigned char* lds, const int K, const Sched& S, const Epi& E) {
    const int tid = threadIdx.x, wid = __builtin_amdgcn_readfirstlane(tid >> 6), lane = tid & 63, wr = wid >> 2, wc = wid & 3, fr = lane & 15, fq = lane >> 4;
    const int nt = K / BK;
    int Rr[2], Cc[2]; unsigned voffB[2];
#pragma unroll
    for (int i = 0; i < 2; ++i) { int R, C; stage_rc(tid * 16 + i * 8192, R, C); const int Rb = Epi::PERM ? ((R & ~31) + perm32(R & 31)) : R; Rr[i] = R; Cc[i] = C; voffB[i] = (unsigned)(Rb * K + C) * 2u; }
    const size_t kstep = (size_t)(BK * 2);
    const size_t hstep = (size_t)HALF * K * 2;
    const unsigned ldsw = (unsigned)wid * 1024u;
    const int aoff = lds_byte(wr * 64 + fr, fq * 8), boff = lds_byte(wc * 32 + fr, fq * 8);
#define PG8_SA(b, h) (((b) * 2 + (h)) * HTB)
#define PG8_SB(b, h) ((4 + (b) * 2 + (h)) * HTB)
#define PG8_LD1(bufoff, gptr, i_) __builtin_amdgcn_global_load_lds((const unsigned*)(gptr), (LAS unsigned*)(lds + (bufoff) + ldsw + (i_) * 8192), 16, 0, 0)
#define PG8_STAGE_B(bufoff, gbase) do { PG8_LD1(bufoff, (const char*)(gbase) + voffB[0], 0); PG8_LD1(bufoff, (const char*)(gbase) + voffB[1], 1); } while (0)
#define PG8_STAGE_A(bufoff, gbase, v0, v1) do { PG8_LD1(bufoff, (const char*)(gbase) + (v0), 0); PG8_LD1(bufoff, (const char*)(gbase) + (v1), 1); } while (0)
#define PG8_LDA(dst, b, h) do { if constexpr (FP8) { _Pragma("unroll") for (int m = 0; m < 4; ++m) dst##8[m] = __builtin_shufflevector(*(const LAS u32x4*)(lds + PG8_SA(b, h) + aoff + m * 2048), *(const LAS u32x4*)(lds + PG8_SA(b, h) + aoff + m * 2048 + 1024), 0, 1, 2, 3, 4, 5, 6, 7); } \
        else { _Pragma("unroll") for (int m = 0; m < 4; ++m) _Pragma("unroll") for (int k = 0; k < 2; ++k) dst[m][k] = *(const LAS bf16x8*)(lds + PG8_SA(b, h) + aoff + m * 2048 + k * 1024); } } while (0)
#define PG8_LDB(dst, b, h) do { if constexpr (FP8) { _Pragma("unroll") for (int n = 0; n < 2; ++n) dst##8[n] = __builtin_shufflevector(*(const LAS u32x4*)(lds + PG8_SB(b, h) + boff + n * 2048), *(const LAS u32x4*)(lds + PG8_SB(b, h) + boff + n * 2048 + 1024), 0, 1, 2, 3, 4, 5, 6, 7); } \
        else { _Pragma("unroll") for (int n = 0; n < 2; ++n) _Pragma("unroll") for (int k = 0; k < 2; ++k) dst[n][k] = *(const LAS bf16x8*)(lds + PG8_SB(b, h) + boff + n * 2048 + k * 1024); } } while (0)
#define PG8_MMA(ai, bj, At, Bt) do { __builtin_amdgcn_s_setprio(1); if constexpr (FP8) { _Pragma("unroll") for (int m = 0; m < 4; ++m) _Pragma("unroll") for (int n = 0; n < 2; ++n) \
        asm volatile("v_mfma_scale_f32_16x16x128_f8f6f4 %0, %1, %2, %0, %3, %4 op_sel_hi:[0,0,0]" : "+v"(acc[ai][bj][m][n]) : "v"(Bt##8[n]), "v"(At##8[m]), "v"(scw), "v"(sca)); } \
        else { _Pragma("unroll") for (int m = 0; m < 4; ++m) _Pragma("unroll") for (int n = 0; n < 2; ++n) _Pragma("unroll") for (int k = 0; k < 2; ++k) \
        acc[ai][bj][m][n] = __builtin_amdgcn_mfma_f32_16x16x32_bf16(Bt[n][k], At[m][k], acc[ai][bj][m][n], 0, 0, 0); } __builtin_amdgcn_s_setprio(0); } while (0)
#define PG8_WAIT_V(n) asm volatile("s_waitcnt vmcnt(" #n ")" ::: "memory")
#define PG8_WAIT_L(n) asm volatile("s_waitcnt lgkmcnt(" #n ")" ::: "memory")
#define PG8_BAR __builtin_amdgcn_s_barrier()
#define PG8_SCHED __builtin_amdgcn_sched_barrier(0)
#define PG8_VOFFA(dst, u) do { _Pragma("unroll") for (int h_ = 0; h_ < 2; ++h_) _Pragma("unroll") for (int i_ = 0; i_ < 2; ++i_) \
        dst[h_][i_] = S.arow(u, h_ * HALF + Rr[i_]) * (unsigned)(K * 2) + (unsigned)(Cc[i_] * 2); } while (0)
    Unit cur, nxt; int ui = 0;
    cur.seg = 0;
    if (!S.next(0, cur)) return;
    cur.ui = 0;
    f32x4 acc[2][2][4][2];
#pragma unroll
    for (int a = 0; a < 2; ++a)
#pragma unroll
        for (int b = 0; b < 2; ++b)
#pragma unroll
            for (int m = 0; m < 4; ++m)
#pragma unroll
                for (int n = 0; n < 2; ++n) acc[a][b][m][n] = (f32x4){0.f, 0.f, 0.f, 0.f};
    bf16x8 At[4][2], B0[2][2], B1[2][2];
    u32x8 At8[4], B08[2], B18[2];
    const int scw = SCW, sca = SCA;
    unsigned voffA[2][2];
    PG8_VOFFA(voffA, cur);
    const char* cA = cur.a; const char* cB = cur.b;
    PG8_STAGE_B(PG8_SB(0, 0), cB); PG8_STAGE_B(PG8_SB(0, 1), cB + hstep); PG8_STAGE_A(PG8_SA(0, 0), cA, voffA[0][0], voffA[0][1]); PG8_STAGE_A(PG8_SA(0, 1), cA, voffA[1][0], voffA[1][1]);
    if (wr == 1) PG8_BAR;
    PG8_WAIT_V(2); PG8_BAR;
    PG8_STAGE_B(PG8_SB(1, 0), cB + kstep); PG8_STAGE_A(PG8_SA(1, 0), cA + kstep, voffA[0][0], voffA[0][1]); PG8_STAGE_B(PG8_SB(1, 1), cB + hstep + kstep);
    PG8_WAIT_V(6); PG8_BAR;
    for (;;) {
        nxt.seg = cur.seg;
        const bool has_next = S.next(ui + 1, nxt);
        const char* nA = has_next ? nxt.a : cA; const char* nB = has_next ? nxt.b : cB;
#pragma unroll 1
        for (int t = 0; t < nt; t += 2) {
            const bool last = (t == nt - 2);
            const char* a1 = cA + (size_t)(t + 1) * kstep;
            const char* a2 = last ? nA : cA + (size_t)(t + 2) * kstep; const char* b2 = last ? nB : cB + (size_t)(t + 2) * kstep;
            const char* a3 = a2 + kstep; const char* b3 = b2 + kstep;
            PG8_LDB(B0, 0, 0); PG8_LDB(B1, 0, 1); PG8_SCHED; PG8_LDA(At, 0, 0); PG8_STAGE_A(PG8_SA(1, 1), a1, voffA[1][0], voffA[1][1]);
            if constexpr (GATHER) { if (last && has_next) { PG8_VOFFA(voffA, nxt); } }
            PG8_WAIT_V(8); PG8_WAIT_L(0); PG8_BAR; PG8_MMA(0, 0, At, B0); PG8_MMA(0, 1, At, B1); PG8_BAR; PG8_SCHED;
            PG8_LDA(At, 0, 1); PG8_STAGE_B(PG8_SB(0, 0), b2); PG8_STAGE_B(PG8_SB(0, 1), b2 + hstep); PG8_STAGE_A(PG8_SA(0, 0), a2, voffA[0][0], voffA[0][1]);
            PG8_WAIT_V(8); PG8_WAIT_L(0); PG8_BAR; PG8_MMA(1, 0, At, B0); PG8_MMA(1, 1, At, B1); PG8_BAR; PG8_SCHED;
            PG8_LDB(B0, 1, 0); PG8_LDB(B1, 1, 1); PG8_SCHED; PG8_LDA(At, 1, 0); PG8_STAGE_A(PG8_SA(0, 1), a2, voffA[1][0], voffA[1][1]);
            PG8_WAIT_V(8); PG8_WAIT_L(0); PG8_BAR; PG8_MMA(0, 0, At, B0); PG8_MMA(0, 1, At, B1); PG8_BAR; PG8_SCHED;
            PG8_LDA(At, 1, 1); PG8_STAGE_B(PG8_SB(1, 0), b3); PG8_STAGE_B(PG8_SB(1, 1), b3 + hstep); PG8_STAGE_A(PG8_SA(1, 0), a3, voffA[0][0], voffA[0][1]);
            PG8_WAIT_V(8); PG8_WAIT_L(0); PG8_BAR; PG8_MMA(1, 0, At, B0); PG8_MMA(1, 1, At, B1); PG8_BAR; PG8_SCHED;
        }
        if (wr == 0) PG8_BAR;
        if constexpr (FP8) asm volatile("s_nop 15\n\ts_nop 15" ::: "memory");
        E(acc, cur, wr, wc, fr, fq);
        if (!has_next) break;
#pragma unroll
        for (int a = 0; a < 2; ++a)
#pragma unroll
            for (int b = 0; b < 2; ++b)
#pragma unroll
                for (int m = 0; m < 4; ++m)
#pragma unroll
                    for (int n = 0; n < 2; ++n) acc[a][b][m][n] = (f32x4){0.f, 0.f, 0.f, 0.f};
        cur = nxt; cA = nA; cB = nB; ++ui; cur.ui = ui;
        if (wr == 1) PG8_BAR;
    }
    PG8_WAIT_V(0);
    PG8_BAR;
#undef PG8_SA
#undef PG8_SB
#undef PG8_LD1
#undef PG8_STAGE_A
#undef PG8_STAGE_B
#undef PG8_LDA
#undef PG8_LDB
#undef PG8_MMA
#undef PG8_WAIT_V
#undef PG8_WAIT_L
#undef PG8_BAR
#undef PG8_SCHED
#undef PG8_VOFFA
}

typedef const f32x4 (&AccRef)[2][2][4][2];
__device__ __forceinline__ u32x4 pack8(f32x4 v0, f32x4 v1) { u32x4 w; w.x = cvt_pk_bf16(v0[0], v0[1]); w.y = cvt_pk_bf16(v0[2], v0[3]); w.z = cvt_pk_bf16(v1[0], v1[1]); w.w = cvt_pk_bf16(v1[2], v1[3]); return w; }
__device__ __forceinline__ f32x4 sig4(f32x4 v) { return (f32x4){fast_sigmoid(v[0]), fast_sigmoid(v[1]), fast_sigmoid(v[2]), fast_sigmoid(v[3])}; }
__device__ __forceinline__ f32x4 bflo4(u32x4 w) { return (f32x4){bflo(w.x), bfhi(w.x), bflo(w.y), bfhi(w.y)}; }
__device__ __forceinline__ f32x4 bfhi4(u32x4 w) { return (f32x4){bflo(w.z), bfhi(w.z), bflo(w.w), bfhi(w.w)}; }
__device__ __forceinline__ unsigned q8x4(f32x4 v) { const unsigned a = (unsigned)(v.x * 255.0f + 0.5f), b = (unsigned)(v.y * 255.0f + 0.5f), c = (unsigned)(v.z * 255.0f + 0.5f), d = (unsigned)(v.w * 255.0f + 0.5f); return a | (b << 8) | (c << 16) | (d << 24); }
__device__ __forceinline__ f32x4 dq8x4(unsigned w) { return (f32x4){(float)(w & 0xffu), (float)((w >> 8) & 0xffu), (float)((w >> 16) & 0xffu), (float)(w >> 24)} * (1.0f / 255.0f); }

struct EpiIn {
    static constexpr bool PERM = true;
    unsigned char* ws; const Params* P; int gw, NGW;
    __device__ __forceinline__ void operator()(AccRef acc, const Unit& u, int wr, int wc, int fr, int fq) const {
        asm volatile("" : "+v"(fr), "+v"(fq));
        const int row0 = u.pm * BM + wr * 64 + fr, cw = wc * 32 + 8 * fq;
        const int pn = u.pn < 8 ? u.pn : u.pn + 4;
        if (pn < 8) {
            float* NQ = (float*)(ws + WS_NQ) + (size_t)(pn >> 2) * (512 * NH * 4);
#pragma unroll
            for (int bj = 0; bj < 2; ++bj)
#pragma unroll
                for (int ai = 0; ai < 2; ++ai) { float mx = 0.f;
#pragma unroll
                    for (int m = 0; m < 4; ++m) { const f32x4 a = acc[ai][bj][m][0], b = acc[ai][bj][m][1];
                        float s = (a.x * a.x + a.y * a.y) + (a.z * a.z + a.w * a.w) + (b.x * b.x + b.y * b.y) + (b.z * b.z + b.w * b.w);
                        s += __shfl_xor(s, 16); s += __shfl_xor(s, 32); mx = fmaxf(mx, s); }
#pragma unroll
                    for (int o = 1; o < 16; o <<= 1) mx = fmaxf(mx, __shfl_xor(mx, o));
                    if (fr == 0 && fq == 0) NQ[((size_t)(u.pm * 4 + ai * 2 + wr) * NH + 2 * (pn & 3) + bj) * 4 + wc] = mx * 1.03f; }
        }
        if (pn < 12 || (pn >= 20 && pn < 24)) {
            bf16* base; if (pn < 12) base = (bf16*)(ws + WS_Q) + (size_t)(pn >> 2) * ((size_t)T * FW) + (pn & 3) * BM; else base = (bf16*)(ws + WS_BG) + (pn - 20) * BM;
#pragma unroll
            for (int ai = 0; ai < 2; ++ai)
#pragma unroll
                for (int m = 0; m < 4; ++m) { bf16* rowp = base + (size_t)(row0 + ai * HALF + m * 16) * FW + cw;
#pragma unroll
                    for (int bj = 0; bj < 2; ++bj) *(u32x4*)(rowp + bj * HALF) = pack8(acc[ai][bj][m][0], acc[ai][bj][m][1]); }
        } else if (pn < 20) {
            bf16* base = (bf16*)(ws + WS_Z) + (pn - 12) * HALF;
#pragma unroll
            for (int ai = 0; ai < 2; ++ai)
#pragma unroll
                for (int m = 0; m < 4; ++m) { bf16* rowp = base + (size_t)(row0 + ai * HALF + m * 16) * CW + cw;
                    *(u32x4*)rowp = pack8(acc[ai][0][m][0] * acc[ai][1][m][0], acc[ai][0][m][1] * acc[ai][1][m][1]); }
        }
        { SidePair sp; side_load(*P, gw, NGW, u.ui, (fq << 4) | fr, sp); side_store((fq << 4) | fr, sp); }
    }
};

struct EpiGate {
    static constexpr bool PERM = true;
    static constexpr int UI0 = 10;
    unsigned char* ws; const Params* P; int gw, NGW;
    __device__ __forceinline__ void operator()(AccRef acc, const Unit& u, int wr, int wc, int fr, int fq) const {
        asm volatile("" : "+v"(fr), "+v"(fq));
        const int row0 = u.pm * BM + wr * 64 + fr, cw = wc * 32 + 8 * fq;
        if (u.pn < 4) {
            bf16* vb = (bf16*)(ws + WS_V) + u.pn * BM;
#pragma unroll
            for (int ai = 0; ai < 2; ++ai)
#pragma unroll
                for (int m = 0; m < 4; ++m) { bf16* rowp = vb + (size_t)(row0 + ai * HALF + m * 16) * FW + cw;
#pragma unroll
                    for (int bj = 0; bj < 2; ++bj) *(u32x4*)(rowp + bj * HALF) = pack8(acc[ai][bj][m][0], acc[ai][bj][m][1]); }
        } else {
        unsigned char* base = ws + WS_GAB + (u.pn - 4) * BM;
#pragma unroll
        for (int ai = 0; ai < 2; ++ai)
#pragma unroll
            for (int m = 0; m < 4; ++m) { unsigned char* rowp = base + (size_t)(row0 + ai * HALF + m * 16) * 4096 + cw;
#pragma unroll
                for (int bj = 0; bj < 2; ++bj) { u32x2 w; w.x = q8x4(sig4(acc[ai][bj][m][0])); w.y = q8x4(sig4(acc[ai][bj][m][1])); *(u32x2*)(rowp + bj * HALF) = w; } }
        }
        { SidePair sp; side_load(*P, gw, NGW, UI0 + u.ui, (fq << 4) | fr, sp); side_store((fq << 4) | fr, sp); }
    }
};

template <int PASS> struct EpiMerge {
    static constexpr bool PERM = true;
    unsigned char* ws;
    __device__ __forceinline__ void operator()(AccRef acc, const Unit& u, int wr, int wc, int fr, int fq) const {
        asm volatile("" : "+v"(fr), "+v"(fq));
        const int row0 = u.pm * BM + wr * 64 + fr, c0 = u.pn * BM + wc * 32 + 8 * fq;
        const unsigned char* G = ws + WS_GAB + PASS * DM; bf16* MG = (bf16*)(ws + WS_MERGED);
#pragma unroll
        for (int ai = 0; ai < 2; ++ai)
#pragma unroll
            for (int m = 0; m < 4; ++m) { const size_t row = (size_t)(row0 + ai * HALF + m * 16);
#pragma unroll
                for (int bj = 0; bj < 2; ++bj) { const u32x2 gv = *(const u32x2*)(G + row * 4096 + c0 + bj * HALF);
                    f32x4 v0 = acc[ai][bj][m][0] * dq8x4(gv.x), v1 = acc[ai][bj][m][1] * dq8x4(gv.y);
                    if (PASS == 1) { const u32x4 tv = *(const u32x4*)(MG + row * DM + c0 + bj * HALF); v0 += bflo4(tv); v1 += bfhi4(tv); }
                    *(u32x4*)(MG + row * DM + c0 + bj * HALF) = pack8(v0, v1); } }
    }
};
struct EpiX1 {
    static constexpr bool PERM = true;
    const bf16* XB; const float* RS; bf16* XRB; unsigned char* X8;
    __device__ __forceinline__ void operator()(AccRef acc, const Unit& u, int wr, int wc, int fr, int fq) const {
        asm volatile("" : "+v"(fr), "+v"(fq));
        const int row0 = u.pm * BM + wr * 64 + fr, c0 = u.pn * BM + wc * 32 + 8 * fq;
#pragma unroll
        for (int ai = 0; ai < 2; ++ai)
#pragma unroll
            for (int m = 0; m < 4; ++m) { const int row = row0 + ai * HALF + m * 16; const size_t off = (size_t)row * DM + c0; const float ri = 1.0f / RS[row];
#pragma unroll
                for (int bj = 0; bj < 2; ++bj) { const u32x4 xv = *(const u32x4*)(XB + off + bj * HALF);
                    const f32x4 v0 = bflo4(xv) * ri + acc[ai][bj][m][0], v1 = bfhi4(xv) * ri + acc[ai][bj][m][1];
                    *(u32x4*)(XRB + off + bj * HALF) = pack8(v0, v1); *(u32x2*)(X8 + off + bj * HALF) = pack8_fp8(v0, v1); }
                if (m == 3) asm volatile("" ::: "memory"); }
    }
};
struct EpiPlain {
    static constexpr bool PERM = true;
    bf16* O; int ldc;
    __device__ __forceinline__ void operator()(AccRef acc, const Unit& u, int wr, int wc, int fr, int fq) const {
        asm volatile("" : "+v"(fr), "+v"(fq));
        const int row0 = u.pm * BM + wr * 64 + fr, c0 = u.pn * BM + wc * 32 + 8 * fq;
#pragma unroll
        for (int ai = 0; ai < 2; ++ai)
#pragma unroll
            for (int m = 0; m < 4; ++m) { bf16* rowp = O + (size_t)(row0 + ai * HALF + m * 16) * ldc + c0;
#pragma unroll
                for (int bj = 0; bj < 2; ++bj) *(u32x4*)(rowp + bj * HALF) = pack8(acc[ai][bj][m][0], acc[ai][bj][m][1]); }
    }
};
struct EpiPle {
    static constexpr bool PERM = true;
    const bf16* XRB; bf16* X3B; const bf16* PP; const float* RS;
    __device__ __forceinline__ void operator()(AccRef acc, const Unit& u, int wr, int wc, int fr, int fq) const {
        asm volatile("" : "+v"(fr), "+v"(fq));
        const int row0 = u.pm * BM + wr * 64 + fr, c0 = u.pn * BM + wc * 32 + 8 * fq;
#pragma unroll
        for (int ai = 0; ai < 2; ++ai)
#pragma unroll
            for (int m = 0; m < 4; ++m) { const int row = row0 + ai * HALF + m * 16; const size_t off = (size_t)row * DM + c0; const float r = RS[row];
#pragma unroll
                for (int bj = 0; bj < 2; ++bj) { const u32x4 pv = *(const u32x4*)(PP + off + bj * HALF), xv = *(const u32x4*)(XRB + off + bj * HALF);
                    *(u32x4*)(X3B + off + bj * HALF) = pack8(bflo4(xv) + sig4(acc[ai][bj][m][0] * r) * bflo4(pv), bfhi4(xv) + sig4(acc[ai][bj][m][1] * r) * bfhi4(pv)); }
                if (m == 3) asm volatile("" ::: "memory"); }
    }
};

struct SegOrder {
    const LAS int* tab;
    int nN, G, c, seg_lo, seg_hi, K, down; const char* A; const char* Bt; const int* TOKL;
    int L0 = 0, Lmax = 0x7fffffff;
    __device__ __forceinline__ int rd(int i) const { return __builtin_amdgcn_readfirstlane(tab[i]); }
    __device__ bool next(int i, Unit& u) const {
        const int m_lo = rd(64 + seg_lo), m_hi = rd(64 + seg_hi);
        const long L = (long)L0 + (long)i * G + c; if (c < 0 || L >= Lmax || L >= (long)(m_hi - m_lo) * nN) return false;
        const int mtile = m_lo + (int)(L / nN); u.pn = (int)(L % nN);
        int s = u.seg > seg_lo ? u.seg : seg_lo; while (s + 1 < seg_hi && rd(64 + s + 1) <= mtile) ++s;
        u.seg = s; u.mt = mtile - rd(64 + s); u.pm = 0; const int left = rd(s) - u.mt * BM; u.nrow = left < BM ? left : BM; u.slot0 = rd(129 + s) + u.mt * BM;
        const int e = s & 31;
        if (down) { u.a = A + (size_t)u.slot0 * K * 2; u.b = Bt + ((size_t)e * DM + (size_t)u.pn * BM) * K * 2; }
        else { u.a = A; u.b = Bt + ((size_t)e * 2 * FF + (size_t)u.pn * BM) * K * 2; }
        return true;
    }
    __device__ __forceinline__ unsigned arow(const Unit& u, int r) const {
        if (down) return (unsigned)r;
        const int rr = r < u.nrow ? r : u.nrow - 1;
        return (unsigned)TOKL[(size_t)u.seg * T + u.mt * BM + rr];
    }
};
struct EpiGU {
    static constexpr bool PERM = true;
    unsigned char* ws;
    __device__ __forceinline__ void operator()(AccRef acc, const Unit& u, int wr, int wc, int fr, int fq) const {
        asm volatile("" : "+v"(fr), "+v"(fq));
        const float2* SC = (const float2*)(ws + WS_SC) + (size_t)u.seg * T + u.mt * BM;
        unsigned char* H = ws + WS_HACT + (size_t)u.slot0 * FF + u.pn * HALF + wc * 32 + 8 * fq;
        float2 sc[2][4];
#pragma unroll
        for (int ai = 0; ai < 2; ++ai)
#pragma unroll
            for (int m = 0; m < 4; ++m) { const int r = ai * HALF + wr * 64 + m * 16 + fr; sc[ai][m] = SC[r < u.nrow ? r : 0]; }
#pragma unroll
        for (int ai = 0; ai < 2; ++ai)
#pragma unroll
            for (int m = 0; m < 4; ++m) { const int r = ai * HALF + wr * 64 + m * 16 + fr; const bool live = r < u.nrow; const float s1 = sc[ai][m].x, s2 = sc[ai][m].y;
                f32x4 g0 = acc[ai][0][m][0] * s1, g1 = acc[ai][0][m][1] * s1; const f32x4 u0 = acc[ai][1][m][0] * s2, u1 = acc[ai][1][m][1] * s2;
                g0 = g0 * sig4(g0) * u0; g1 = g1 * sig4(g1) * u1;
                { const f32x4 lo4 = (f32x4){-448.f, -448.f, -448.f, -448.f}, hi4 = (f32x4){448.f, 448.f, 448.f, 448.f}; g0 = __builtin_elementwise_min(__builtin_elementwise_max(g0, lo4), hi4); g1 = __builtin_elementwise_min(__builtin_elementwise_max(g1, lo4), hi4); }
                if (live) *(u32x2*)(H + (size_t)r * FF) = pack8_fp8(g0, g1); }
    }
};
template <bool LAST> struct EpiDN {
    static constexpr bool PERM = true;
    unsigned char* ws;
    __device__ __forceinline__ void operator()(AccRef acc, const Unit& u, int wr, int wc, int fr, int fq) const {
        asm volatile("" : "+v"(fr), "+v"(fq));
        const int* TOKL = (const int*)(ws + WS_TOKL) + (size_t)u.seg * T + u.mt * BM; bf16* XRB = (bf16*)(ws + WS_X1B); unsigned char* X8 = ws + WS_X2F8;
        const int c0 = u.pn * BM + wc * 32 + 8 * fq;
        int tok[2][4]; u32x4 xv[2][4][2];
#pragma unroll
        for (int ai = 0; ai < 2; ++ai)
#pragma unroll
            for (int m = 0; m < 4; ++m) { const int r = ai * HALF + wr * 64 + m * 16 + fr; tok[ai][m] = TOKL[r < u.nrow ? r : 0]; }
#pragma unroll
        for (int ai = 0; ai < 2; ++ai)
#pragma unroll
            for (int m = 0; m < 4; ++m)
#pragma unroll
                for (int bj = 0; bj < 2; ++bj) xv[ai][m][bj] = *(const u32x4*)(XRB + (size_t)tok[ai][m] * DM + c0 + bj * HALF);
#pragma unroll
        for (int ai = 0; ai < 2; ++ai)
#pragma unroll
            for (int m = 0; m < 4; ++m) { const int r = ai * HALF + wr * 64 + m * 16 + fr; const bool live = r < u.nrow; const size_t off = (size_t)tok[ai][m] * DM + c0;
#pragma unroll
                for (int bj = 0; bj < 2; ++bj) { const f32x4 v0 = bflo4(xv[ai][m][bj]) + acc[ai][bj][m][0], v1 = bfhi4(xv[ai][m][bj]) + acc[ai][bj][m][1];
                    if (live) { *(u32x4*)(XRB + off + bj * HALF) = pack8(v0, v1); if (LAST) *(u32x2*)(X8 + off + bj * HALF) = pack8_fp8(v0, v1); } } }
    }
};
}
using pg8::bflo4; using pg8::bfhi4;

namespace fox {
typedef short s16x4 __attribute__((ext_vector_type(4)));
typedef float f32x16 __attribute__((ext_vector_type(16)));
constexpr int D = 128, LDQ = 1024, NW = 8, QBLK = 32, KVBLK = 64, QB = NW * QBLK;
constexpr float SCALE = 0.08838834764831845f, INVS = 11.313708498984761f, THR = 8.f;
constexpr int SHM_V = KVBLK * D * 2, SHM_K = KVBLK * D * 2;
constexpr int OFF_WS = 2 * SHM_V + 2 * SHM_K, OFF_B = OFF_WS + NW * 64 * 4, LDS_ATT = OFF_B + SEQ * 4;
#define KSWZ(row, colB) ((row) * 256 + ((colB) ^ (((row) & 7) << 4)))
#define SBAR() __builtin_amdgcn_sched_barrier(0)
__device__ __forceinline__ int v_st(int k, int c) { const int kk = (k & ~0xC) | ((k & 4) << 1) | ((k & 8) >> 1); return ((kk >> 3) * 4 + (c >> 5)) * 512 + ((kk & 7) * 32 + (c & 31)) * 2; }
__device__ __forceinline__ int v_rd_base(int lane) { return ((lane & 3) << 3) | (((lane >> 2) & 3) << 6) | (((lane >> 4) & 1) << 5) | (((lane >> 5) & 1) << 8); }
constexpr int v_rd_off(int d0, int ks, int half) { return d0 * 512 + ks * 4096 + half * 2048; }
__device__ __forceinline__ int crow(int r, int hi) { return (r & 3) + 8 * (r >> 2) + 4 * hi; }
__device__ __forceinline__ unsigned cvtpk(float lo, float hi) { return cvt_pk_bf16(lo, hi); }
__device__ __forceinline__ void mask_tile(f32x16& p0, f32x16& p1, int dq) {
    const float NEG = -__builtin_inff();
#pragma unroll
    for (int r = 0; r < 16; ++r) { const int c = (r & 3) + 8 * (r >> 2);
        if (dq - c < 0) p0[r] = NEG;
        if (dq - c - 32 < 0) p1[r] = NEG; }
}
__device__ __forceinline__ void partialSM(f32x16& p0, f32x16& p1, float& m_reg, float& mn, float& alpha) {
    float pmax = p0[0];
#pragma unroll
    for (int r = 1; r < 16; ++r) pmax = fmaxf(pmax, p0[r]);
#pragma unroll
    for (int r = 0; r < 16; ++r) pmax = fmaxf(pmax, p1[r]);
    { auto rr = __builtin_amdgcn_permlane32_swap(__float_as_uint(pmax), __float_as_uint(pmax), false, false);
      pmax = fmaxf(__uint_as_float(rr[0]), __uint_as_float(rr[1])); }
    constexpr float C2 = 1.4426950408889634f * SCALE;
    if (__builtin_expect(__all((pmax - m_reg) * SCALE <= THR), 1)) { mn = m_reg; alpha = 1.f; }
    else { mn = fmaxf(m_reg, pmax); alpha = __builtin_amdgcn_exp2f((m_reg - mn) * C2); m_reg = mn; }
    const float mnL = -mn * C2;
#pragma unroll
    for (int r = 0; r < 16; ++r) p0[r] = fmaf(p0[r], C2, mnL);
#pragma unroll
    for (int r = 0; r < 16; ++r) p1[r] = fmaf(p1[r], C2, mnL);
#pragma unroll
    for (int r = 0; r < 16; ++r) p0[r] = __builtin_amdgcn_exp2f(p0[r]);
}
__device__ __forceinline__ void finishSM(f32x16& p0, f32x16& p1, float alpha, float& l_reg, bf16x8& pa0, bf16x8& pa1, bf16x8& pa2, bf16x8& pa3) {
#pragma unroll
    for (int r = 0; r < 16; ++r) p1[r] = __builtin_amdgcn_exp2f(p1[r]);
    float ps = 0;
#pragma unroll
    for (int r = 0; r < 16; ++r) ps += p0[r];
#pragma unroll
    for (int r = 0; r < 16; ++r) ps += p1[r];
    { auto rr = __builtin_amdgcn_permlane32_swap(__float_as_uint(ps), __float_as_uint(ps), false, false);
      ps = __uint_as_float(rr[0]) + __uint_as_float(rr[1]); }
    l_reg = l_reg * alpha + ps;
#define PK4(P, B_, OUT) do { unsigned a0 = cvtpk(P[B_+0], P[B_+1]), a1 = cvtpk(P[B_+2], P[B_+3]);                          \
        unsigned b0 = cvtpk(P[B_+4], P[B_+5]), b1 = cvtpk(P[B_+6], P[B_+7]);                                             \
        auto r0 = __builtin_amdgcn_permlane32_swap(a0, b0, false, false); auto r1 = __builtin_amdgcn_permlane32_swap(a1, b1, false, false); \
        u32x4 w = {r0[0], r1[0], r0[1], r1[1]}; OUT = __builtin_bit_cast(bf16x8, w); } while (0)
    PK4(p0, 0, pa0); PK4(p0, 8, pa1); PK4(p1, 0, pa2); PK4(p1, 8, pa3);
#undef PK4
}
template <int KB>
__device__ __forceinline__ void qkt(f32x16& p0, f32x16& p1, const char* K_lds, const char* bias_t, int r32, int hi, const bf16x8* qr) {
    const f32x4* bl = (const f32x4*)(bias_t + hi * 16);
#pragma unroll
    for (int q = 0; q < 4; ++q) { const f32x4 b0 = bl[2 * q], b1 = bl[8 + 2 * q];
        p0[4 * q] = b0.x; p0[4 * q + 1] = b0.y; p0[4 * q + 2] = b0.z; p0[4 * q + 3] = b0.w;
        p1[4 * q] = b1.x; p1[4 * q + 1] = b1.y; p1[4 * q + 2] = b1.z; p1[4 * q + 3] = b1.w; }
    const char* kb[4];
#pragma unroll
    for (int dd = 0; dd < 4; ++dd) kb[dd] = K_lds + KB * SHM_K + KSWZ(r32, (dd * 16 + hi * 8) * 2);
#pragma unroll
    for (int d0 = 0; d0 < 8; ++d0) { const char* a = kb[d0 & 3] + (d0 >> 2) * 128;
        bf16x8 b0 = *reinterpret_cast<const bf16x8*>(a);
        bf16x8 b1 = *reinterpret_cast<const bf16x8*>(a + 32 * 256);
        p0 = __builtin_amdgcn_mfma_f32_32x32x16_bf16(b0, qr[d0], p0, 0, 0, 0);
        p1 = __builtin_amdgcn_mfma_f32_32x32x16_bf16(b1, qr[d0], p1, 0, 0, 0); }
}
template <int VB>
__device__ __forceinline__ void pv_tile(f32x16* o, int vb0, bf16x8 pa0, bf16x8 pa1, bf16x8 pa2, bf16x8 pa3) {
#define TRRD(dst, off) asm volatile("ds_read_b64_tr_b16 %0, %1 offset:%2" : "=&v"(dst) : "v"(vb0), "i"(off) : "memory")
#define PV_D0(d0) do { s16x4 l0, l1, l2, l3, h0, h1, h2, h3; constexpr int b_ = VB * SHM_V + v_rd_off(d0, 0, 0);   \
        TRRD(l0, b_); TRRD(h0, b_ + 2048); TRRD(l1, b_ + 4096); TRRD(h1, b_ + 6144); TRRD(l2, b_ + 8192); TRRD(h2, b_ + 10240); TRRD(l3, b_ + 12288); TRRD(h3, b_ + 14336); \
        asm volatile("s_waitcnt lgkmcnt(0)" ::: "memory"); SBAR();   \
        o[d0] = __builtin_amdgcn_mfma_f32_32x32x16_bf16(pa0, (bf16x8){l0[0], l0[1], l0[2], l0[3], h0[0], h0[1], h0[2], h0[3]}, o[d0], 0, 0, 0);   \
        o[d0] = __builtin_amdgcn_mfma_f32_32x32x16_bf16(pa1, (bf16x8){l1[0], l1[1], l1[2], l1[3], h1[0], h1[1], h1[2], h1[3]}, o[d0], 0, 0, 0);   \
        o[d0] = __builtin_amdgcn_mfma_f32_32x32x16_bf16(pa2, (bf16x8){l2[0], l2[1], l2[2], l2[3], h2[0], h2[1], h2[2], h2[3]}, o[d0], 0, 0, 0);   \
        o[d0] = __builtin_amdgcn_mfma_f32_32x32x16_bf16(pa3, (bf16x8){l3[0], l3[1], l3[2], l3[3], h3[0], h3[1], h3[2], h3[3]}, o[d0], 0, 0, 0); } while (0)
    PV_D0(0); PV_D0(1); PV_D0(2); PV_D0(3);
#undef PV_D0
#undef TRRD
}
struct BlockRef { const bf16* K; const float* C; int P0, jlo; float cref;
    __device__ __forceinline__ const bf16* Kp() const { return K; }
    __device__ __forceinline__ const bf16* Vp() const { return K + (WS_V - WS_K) / 2; }
    __device__ __forceinline__ const bf16* Qp() const { return K - (WS_K - WS_Q) / 2 + (size_t)P0 * LDQ; }
    __device__ __forceinline__ bf16* Op() const { return const_cast<bf16*>(Qp()); } };
struct Seam { bf16x8 qr[8]; bf16x8 st_v0, st_v1, st_k0, st_k1; };
__device__ __forceinline__ bf16x8 load8(const bf16* p) { return *reinterpret_cast<const bf16x8*>(p); }
#define ROW(p, k0, rr) ((p) + (size_t)((k0) + (rr)) * LDQ + sc)
#define VMW() asm volatile("s_waitcnt vmcnt(0)" ::: "memory")
#define VMWN(n) asm volatile("s_waitcnt vmcnt(%0)" :: "i"(n) : "memory")
#define SLOAD_H(Kp, Vp, k0) do { S.st_v0 = load8(ROW(Vp, k0, sr)); S.st_v1 = load8(ROW(Vp, k0, 32 + sr));              \
                         S.st_k0 = load8(ROW(Kp, k0, sr)); S.st_k1 = load8(ROW(Kp, k0, 32 + sr)); } while (0)
#define SWRITE_HK(bf) do { *(bf16x8*)(K_lds + (bf) * SHM_K + kws) = S.st_k0; *(bf16x8*)(K_lds + (bf) * SHM_K + kws + 32 * 256) = S.st_k1; } while (0)
#define SWRITE_HV(bf) do { *(bf16x8*)(V_lds + (bf) * SHM_V + vst0) = S.st_v0; *(bf16x8*)(V_lds + (bf) * SHM_V + vst1) = S.st_v1; } while (0)
#define SWRITE_H(bf) do { SWRITE_HV(bf); SWRITE_HK(bf); } while (0)
#define BIAS_FILL(ref_) do { int k_ = (int)threadIdx.x * 4; asm volatile("" : "+v"(k_)); const int kb_ = (ref_).jlo * KVBLK; for (; kb_ + k_ < (ref_).P0 + QB; k_ += NW * 64 * 4) *(f32x4*)(B_lds + k_ * 4) = ((ref_).cref - *(const f32x4*)((ref_).C + kb_ + k_)) * INVS; } while (0)
__device__ __forceinline__ void prime(const BlockRef& cur, char* lds, Seam& S) {
    const int tid = threadIdx.x, wid = __builtin_amdgcn_readfirstlane(tid >> 6), lane = tid & 63, r32 = lane & 31, hi = lane >> 5;
    const int sr = tid >> 4, sc = (tid & 15) * 8, kws = KSWZ(sr, sc * 2); char* K_lds = lds + 2 * SHM_V; char* B_lds = lds + OFF_B;
#pragma unroll
    for (int d0 = 0; d0 < 8; ++d0) S.qr[d0] = load8(cur.Qp() + (size_t)(wid * QBLK + r32) * LDQ + d0 * 16 + hi * 8);
    SLOAD_H(cur.Kp(), cur.Vp(), cur.jlo * KVBLK); BIAS_FILL(cur); VMW(); SWRITE_HK(0);
    __syncthreads();
}
__device__ __forceinline__ BlockRef ref(int k, unsigned char* ws, const char* lds);
__device__ __forceinline__ void block(const BlockRef& cur, BlockRef& nxt, bool& has_nxt, char* lds, Seam& S, unsigned* ctr, volatile int* slot, unsigned char* gws) {
    const int tid = threadIdx.x, wid = __builtin_amdgcn_readfirstlane(tid >> 6), lane = tid & 63, r32 = lane & 31, hi = lane >> 5;
    const int j_lo = cur.jlo, NT = (cur.P0 + QB) / KVBLK - j_lo;
    const int qlo = cur.P0 + wid * QBLK, qm = qlo + r32 - 4 * hi;
    char* V_lds = lds; char* K_lds = lds + 2 * SHM_V; char* B_lds = lds + OFF_B;
    float* ws = (float*)(lds + OFF_WS) + wid * 64; float* li_l = ws, * al_l = ws + 32;
    float m_reg = -1e30f, l_reg = 0; f32x16 o[4] = {};
    const int sr = tid >> 4, sc = (tid & 15) * 8, vst0 = v_st(sr, sc), vst1 = v_st(32 + sr, sc), kws = KSWZ(sr, sc * 2);
    const int vb0 = (int)(uintptr_t)V_lds + v_rd_base(lane);
    const bf16* Kh = cur.Kp(); const bf16* Vh = cur.Vp();
#define RESC(a) do { if (__any((a) < 1.f)) { if (hi == 0) al_l[r32] = (a); asm volatile("s_waitcnt lgkmcnt(0)" ::: "memory");              \
                     for (int d_ = 0; d_ < 4; ++d_) for (int r = 0; r < 16; ++r) o[d_][r] *= al_l[crow(r, hi)]; } } while (0)
#define KBASE(t) ((j_lo + (t)) * KVBLK)
#define MASKT(P0_, P1_, t) do { const int kb_ = KBASE(t); if (kb_ + KVBLK - 1 > qlo) mask_tile(P0_, P1_, qm - kb_); } while (0)
    constexpr int NQL = 8;
#define SEAM_K0() do { VMWN(NQL); SWRITE_HK(0); SBAR(); } while (0)
    f32x16 pA0, pA1, pB0, pB1; float mnA, mnB, alA, alB; bf16x8 pa0, pa1, pa2, pa3;
    SWRITE_HV(0); SBAR();
    SLOAD_H(Kh, Vh, KBASE(1));
    SBAR(); qkt<0>(pA0, pA1, K_lds, B_lds, r32, hi, S.qr);
    MASKT(pA0, pA1, 0); partialSM(pA0, pA1, m_reg, mnA, alA);
    VMW(); SWRITE_H(1);
    __syncthreads();
#define HALF_STEP(PX0, PX1, mnX, alX, PY0, PY1, alY, t, KB, VB, SB) do {                                                      \
        SBAR(); qkt<KB>(PX0, PX1, K_lds, B_lds + (t) * 256, r32, hi, S.qr);                                             \
        finishSM(PY0, PY1, alY, l_reg, pa0, pa1, pa2, pa3); SBAR();                                                           \
        if ((t) + 1 < NT) { SLOAD_H(Kh, Vh, KBASE((t) + 1)); SBAR(); }                                               \
        pv_tile<VB>(o, vb0, pa0, pa1, pa2, pa3); MASKT(PX0, PX1, (t)); partialSM(PX0, PX1, m_reg, mnX, alX);                                        \
        __syncthreads();                                                                                                      \
        if ((t) + 1 < NT) { VMW(); SWRITE_H(SB); }                                                                          \
        RESC(alX); __syncthreads(); } while (0)
    for (int t = 1; t + 1 < NT; t += 2) {
        unsigned tk = 0u; const bool claim = (t + 3 >= NT) && tid == 0;
        if (claim) tk = atomicAdd(ctr, 1u);
        HALF_STEP(pB0, pB1, mnB, alB, pA0, pA1, alA, t, 1, 0, 0);
        if (claim) slot[0] = (int)tk;
        HALF_STEP(pA0, pA1, mnA, alA, pB0, pB1, alB, t + 1, 0, 1, 1);
    }
    { const int kn = __builtin_amdgcn_readfirstlane(slot[0]); has_nxt = kn < BATCH * NH * 16; nxt = has_nxt ? ref(kn, gws, lds) : cur; }
    SBAR(); qkt<1>(pB0, pB1, K_lds, B_lds + (NT - 1) * 256, r32, hi, S.qr); SBAR();
    SLOAD_H(nxt.Kp(), nxt.Vp(), nxt.jlo * KVBLK); SBAR();
#pragma unroll
    for (int d0 = 0; d0 < 8; ++d0) S.qr[d0] = load8(nxt.Qp() + (size_t)(wid * QBLK + r32) * LDQ + d0 * 16 + hi * 8);
    SBAR();
    finishSM(pA0, pA1, alA, l_reg, pa0, pa1, pa2, pa3); SBAR();
    pv_tile<0>(o, vb0, pa0, pa1, pa2, pa3);
    MASKT(pB0, pB1, NT - 1); partialSM(pB0, pB1, m_reg, mnB, alB); __syncthreads(); RESC(alB);
    finishSM(pB0, pB1, alB, l_reg, pa0, pa1, pa2, pa3); SBAR(); pv_tile<1>(o, vb0, pa0, pa1, pa2, pa3);
    SBAR(); SEAM_K0();
    if (hi == 0) li_l[r32] = l_reg; asm volatile("s_waitcnt lgkmcnt(0)" ::: "memory");
    float rli[16];
#pragma unroll
    for (int r = 0; r < 16; ++r) rli[r] = __builtin_amdgcn_rcpf(li_l[crow(r, hi)]);
    bf16* Ow = cur.Op() + (size_t)(wid * QBLK) * LDQ;
#pragma unroll
    for (int r = 0; r < 16; ++r) { const int orow = crow(r, hi);
#pragma unroll
        for (int d0 = 0; d0 < 4; ++d0) { const float v = o[d0][r] * rli[r];
            const float vn = __shfl_xor(v, 1);
            if ((r32 & 1) == 0) *(unsigned*)(Ow + (size_t)orow * LDQ + d0 * 32 + r32) = cvtpk(v, vn); } }
    BIAS_FILL(nxt);
    __syncthreads();
#undef RESC
#undef KBASE
#undef MASKT
#undef SEAM_K0
#undef HALF_STEP
}
#undef ROW
#undef VMW
#undef VMWN
#undef SLOAD_H
#undef SWRITE_HK
#undef SWRITE_HV
#undef SWRITE_H
#undef BIAS_FILL
#undef KSWZ
#undef SBAR
constexpr int ORD_OFF = 86016, CJ_OFF = 88064, CNTS_OFF = 104448, TOT_OFF = 106496, SK_OFF = 108544;
__device__ __forceinline__ void build_order(char* lds, unsigned char* ws) {
    const int tid = threadIdx.x, lane = tid & 63, wid = tid >> 6;
    float* cj = (float*)(lds + CJ_OFF); int* cnt = (int*)(lds + CNTS_OFF); int* tot = (int*)(lds + TOT_OFF); unsigned short* ord = (unsigned short*)(lds + ORD_OFF);
    const float* CUM = (const float*)(ws + WS_CUM); float* sk = (float*)(lds + SK_OFF);
    const float* NQq = (const float*)(ws + WS_NQ); const float* NQk = NQq + 512 * NH * 4;
#pragma unroll
    for (int k = 0; k < 8; ++k) { const int idx = tid + 512 * k, bh_ = idx >> 6, j_ = idx & 63; cj[idx] = CUM[(size_t)bh_ * SEQ + 64 * j_ + 63];
        const f32x4 kp = *(const f32x4*)(NQk + ((size_t)((bh_ / NH) * 64 + j_) * NH + (bh_ % NH)) * 4); sk[idx] = sqrtf((kp.x + kp.y) + (kp.z + kp.w)); }
    cnt[tid] = 0;
    __syncthreads();
    int cls[2], rnk[2], jl[2];
#pragma unroll
    for (int p = 0; p < 2; ++p) {
        const int i = p * 512 + tid, bh = i >> 4, qb = i & 15;
        float q2 = 0.f, kd = 0.f;
#pragma unroll
        for (int g = 0; g < 4; ++g) { const f32x4 qp = *(const f32x4*)(NQq + ((size_t)((bh / NH) * 64 + 4 * qb + g) * NH + (bh % NH)) * 4); q2 = fmaxf(q2, (qp.x + qp.y) + (qp.z + qp.w)); kd = fmaxf(kd, sk[bh * 64 + 4 * qb + g]); }
        const float sq = sqrtf(q2) * SCALE;
        const float lim = CUM[(size_t)bh * SEQ + qb * QB] + sq * kd + 8.4f + 17.0f;
        int lo = 0;
        while (lo < 4 * qb && cj[bh * 64 + lo] >= lim + sq * sk[bh * 64 + lo]) ++lo;
        lo &= ~1;
        const int cl = ((4 * (qb + 1) - lo) >> 1) - 1;
        cls[p] = cl; rnk[p] = 0; jl[p] = lo >> 1;
        unsigned long long rem = __ballot(1);
        while (rem) {
            const int c0 = __builtin_amdgcn_readlane(cl, (int)__builtin_ctzll(rem));
            const unsigned long long m = __ballot(cl == c0);
            if (cl == c0) { rnk[p] = __builtin_popcountll(m & ((1ull << lane) - 1ull)); if ((m & ((1ull << lane) - 1ull)) == 0ull) cnt[(p * 8 + wid) * 32 + c0] = __builtin_popcountll(m); }
            rem &= ~m;
        }
    }
    __syncthreads();
    if (tid < 32) { int t = 0; for (int c = 0; c < 16; ++c) t += cnt[c * 32 + tid]; tot[tid] = t; }
    __syncthreads();
#pragma unroll
    for (int p = 0; p < 2; ++p) {
        const int ch = p * 8 + wid; int base = rnk[p];
        for (int c = cls[p] + 1; c < 32; ++c) base += tot[c];
        for (int c = 0; c < ch; ++c) base += cnt[c * 32 + cls[p]];
        ord[base] = (unsigned short)((p * 512 + tid) | (jl[p] << 10));
    }
    __syncthreads();
}
__device__ __forceinline__ BlockRef ref(int k, unsigned char* ws, const char* lds) {
    const int e = __builtin_amdgcn_readfirstlane((int)((const unsigned short*)(lds + ORD_OFF))[k]);
    const int i = e & 1023, bh = i >> 4, qb = i & 15, b = bh / NH, h = bh % NH;
    BlockRef r; r.K = (const bf16*)(ws + WS_K) + (size_t)b * SEQ * LDQ + h * D; r.C = (const float*)(ws + WS_CUM) + (size_t)bh * SEQ; r.P0 = qb * QB; r.cref = r.C[r.P0];
    r.jlo = (e >> 10) * 2;
    return r;
}
__device__ __forceinline__ void attn_phase(char* lds, unsigned char* ws, volatile int* slot) {
    constexpr int TOTAL = BATCH * NH * 16;
    unsigned* ctr = (unsigned*)(ws + WS_CTL) + CW_ATT;
    build_order(lds, ws);
    if (threadIdx.x == 0) slot[0] = (int)atomicAdd(ctr, 1u);
    __syncthreads();
    const int i0 = __builtin_amdgcn_readfirstlane(slot[0]);
    __syncthreads();
    if (i0 >= TOTAL) return;
    BlockRef cur = ref(i0, ws, lds), nxt = cur; bool has_nxt = false;
    Seam S;
    prime(cur, lds, S);
    for (;;) {
        block(cur, nxt, has_nxt, lds, S, ctr, slot, ws);
        if (!has_nxt) break;
        cur = nxt;
    }
}
}
__device__ __forceinline__ int tid_now() { int t = (int)threadIdx.x; asm volatile("" : "+v"(t)); return t; }
struct Frame {
    LAS unsigned char* lds; volatile LAS unsigned* MISC; unsigned* ctl;
    int tid, lane, wave, vcu, G;
};

__device__ __forceinline__ void xitem_load(const XItem& it, int lane, f32x4 (&v)[8]) {
    const int nq = lane & 7, ko = lane >> 3; const float* s = it.src + (size_t)(8 * ko) * it.ldw + 4 * nq;
#pragma unroll
    for (int j = 0; j < 8; ++j) v[j] = *(const f32x4*)(s + (size_t)j * it.ldw);
}
__device__ __forceinline__ void xitem_store(const XItem& it, int lane, const f32x4 (&v)[8]) {
    const int nq = lane & 7, ko = lane >> 3;
    f32x4 g0 = (f32x4){1.f, 1.f, 1.f, 1.f}, g1 = g0;
    if (it.gain) { g0 = *(const f32x4*)(it.gain + 8 * ko); g1 = *(const f32x4*)(it.gain + 8 * ko + 4); }
    if (it.fp8) { g0 *= 64.0f; g1 *= 64.0f; }
    if (it.fp8) { unsigned char* d = it.dst + (size_t)(4 * nq) * it.K + 8 * ko;
#pragma unroll
        for (int e = 0; e < 4; ++e) *(u32x2*)(d + (size_t)e * it.K) = pack8_fp8((f32x4){v[0][e] * g0.x, v[1][e] * g0.y, v[2][e] * g0.z, v[3][e] * g0.w}, (f32x4){v[4][e] * g1.x, v[5][e] * g1.y, v[6][e] * g1.z, v[7][e] * g1.w});
    } else { bf16* d = (bf16*)it.dst + (size_t)(4 * nq) * it.K + 8 * ko;
#pragma unroll
        for (int e = 0; e < 4; ++e) { u32x4 o; o.x = pk2(v[0][e] * g0.x, v[1][e] * g0.y); o.y = pk2(v[2][e] * g0.z, v[3][e] * g0.w); o.z = pk2(v[4][e] * g1.x, v[5][e] * g1.y); o.w = pk2(v[6][e] * g1.z, v[7][e] * g1.w);
            *(u32x4*)(d + (size_t)e * it.K) = o; } }
}
__device__ __forceinline__ int win_src_col(int n0) {
    if (n0 < 3072) return C_Q + n0;
    if (n0 < 5120) { const int j = (n0 - 3072) >> 8, w = (n0 - 3072) & 255; return w < 128 ? C_U + 128 * j + w : C_CG + 128 * j + (w - 128); }
    if (n0 < 6144) return C_BG + (n0 - 5120);
    return C_GA + (n0 - 6144);
}
constexpr int XI_IN = 32 * 320, XI_SIDE = 16 * 64 + 16 * 64 + 32 * 64 + 32 * 64 + 4 * 64 + 32 * 32 * 32 + 32 * 8 * 64;
__device__ __forceinline__ XItem xitem_of(const Params& P, int r) {
    unsigned char* ws = P.ws;
    constexpr int I_A = 16 * 64, I_B = 16 * 64, I_OUT = 32 * 64, I_PG = 32 * 64, I_PE = 4 * 64, I_GU = 32 * 32 * 32;
    XItem it; it.fp8 = 0; it.gain = nullptr;
    if (r < XI_IN) { const int kb = r / 320, g = r % 320; it.src = P.w_in + (size_t)(64 * kb) * IN_COLS + win_src_col(32 * g); it.ldw = IN_COLS; it.gain = P.g_mix + 64 * kb; it.K = DM; const int n0 = 32 * g;
        if (n0 >= 2048 && n0 < 3072) { it.fp8 = 1; it.dst = ws + WS_WT_IN8 + (size_t)(n0 - 2048) * DM + 64 * kb; }
        else if (n0 >= 6144) { it.fp8 = 1; it.dst = ws + WS_WT_IN8 + (size_t)(1024 + n0 - 6144) * DM + 64 * kb; }
        else it.dst = ws + WS_WT_IN + ((size_t)(n0 < 2048 ? n0 : n0 - 1024) * DM + 64 * kb) * 2;
        return it; } r -= XI_IN;
    if (r < I_A) { const int kb = r / 64, g = r % 64; it.src = P.w_a + (size_t)(64 * kb) * DM + 32 * g; it.ldw = DM; it.K = FW; it.dst = ws + WS_WT_A + ((size_t)(32 * g) * FW + 64 * kb) * 2; return it; } r -= I_A;
    if (r < I_B) { const int kb = r / 64, g = r % 64; it.src = P.w_b + (size_t)(64 * kb) * DM + 32 * g; it.ldw = DM; it.K = CW; it.dst = ws + WS_WT_B + ((size_t)(32 * g) * CW + 64 * kb) * 2; return it; } r -= I_B;
    if (r < I_OUT) { const int kb = r / 64, g = r % 64; it.src = P.w_out + (size_t)(64 * kb) * DM + 32 * g; it.ldw = DM; it.K = DM; it.dst = ws + WS_WT_OUT + ((size_t)(32 * g) * DM + 64 * kb) * 2; return it; } r -= I_OUT;
    if (r < I_PG) { const int kb = r / 64, g = r % 64; it.src = P.w_pg + (size_t)(64 * kb) * DM + 32 * g; it.ldw = DM; it.gain = P.g_ple + 64 * kb; it.K = DM; it.fp8 = 1; it.dst = ws + WS_WT_PG + (size_t)(32 * g) * DM + 64 * kb; return it; } r -= I_PG;
    if (r < I_PE) { const int kb = r / 64, g = r % 64; it.src = P.w_pe + (size_t)(64 * kb) * DM + 32 * g; it.ldw = DM; it.K = PLE; it.dst = ws + WS_WT_PE + ((size_t)(32 * g) * PLE + 64 * kb) * 2; return it; } r -= I_PE;
    if (r < I_GU) { const int e = r / 1024, kb = (r % 1024) / 32, g = r % 32, n0 = 32 * g, j = n0 >> 8, w = n0 & 255; const int sc = w < 128 ? 128 * j + w : FF + 128 * j + (w - 128);
        it.src = P.w_gu + (size_t)e * DM * 2 * FF + (size_t)(64 * kb) * (2 * FF) + sc; it.ldw = 2 * FF; it.gain = P.g_ffn + 64 * kb; it.K = DM; it.fp8 = 1; it.dst = ws + WS_WT_GU + (size_t)e * 2 * FF * DM + (size_t)n0 * DM + 64 * kb; return it; } r -= I_GU;
    { const int e = r / 512, kb = (r % 512) / 64, g = r % 64; it.src = P.w_dn + (size_t)e * FF * DM + (size_t)(64 * kb) * DM + 32 * g; it.ldw = DM; it.K = FF; it.fp8 = 1; it.dst = ws + WS_WT_DN + (size_t)e * DM * FF + (size_t)(32 * g) * FF + 64 * kb; return it; }
}
__device__ __forceinline__ void xitem_pair(const Params& P, int r0, int r1, int lane) {
    const XItem a = xitem_of(P, r0); const XItem b = xitem_of(P, r1 >= 0 ? r1 : r0);
    f32x4 va[8], vb[8];
    xitem_load(a, lane, va); xitem_load(b, lane, vb);
    xitem_store(a, lane, va); if (r1 >= 0) xitem_store(b, lane, vb);
}
__device__ __forceinline__ void p0_weights(const Params& P, const Frame& F) {
    const int lane = tid_now() & 63;
    const int gw = F.vcu * NWAVES + F.wave, NGW = F.G * NWAVES;
    for (int r = gw; r < XI_IN; r += 2 * NGW) xitem_pair(P, r, r + NGW < XI_IN ? r + NGW : -1, lane);
}
__device__ __forceinline__ void side_load(const Params& P, int gw, int NGW, int k, int lane, SidePair& sp) {
    const int r0 = gw + 2 * k * NGW, r1 = r0 + NGW; sp.n = r0 < XI_SIDE ? (r1 < XI_SIDE ? 2 : 1) : 0;
    if (sp.n > 0) { sp.a = xitem_of(P, XI_IN + r0); sp.b = xitem_of(P, XI_IN + (sp.n > 1 ? r1 : r0)); xitem_load(sp.a, lane, sp.va); xitem_load(sp.b, lane, sp.vb); }
}
__device__ __forceinline__ void side_store(int lane, const SidePair& sp) {
    if (sp.n > 0) xitem_store(sp.a, lane, sp.va);
    if (sp.n > 1) xitem_store(sp.b, lane, sp.vb);
}
__device__ __forceinline__ void p0_rowstats(const Params& P, const Frame& F) {
    unsigned char* ws = P.ws; float* rstd1 = (float*)(ws + WS_RSTD1); float* logf = (float*)(ws + WS_LOGF); bf16* XB = (bf16*)(ws + WS_XB);
    const int tid = tid_now(), lane = tid & 63;
    LAS f32x4* wfA = (LAS f32x4*)(F.lds + RING_OFF); LAS f32x4* wfB = wfA + DM;
    for (int k = tid; k < DM; k += NWAVES * 64) { const f32x4* w = (const f32x4*)(P.w_in + (size_t)k * IN_COLS + C_F); const float g = P.g_mix[k];
        const int s = (((k >> 8) * 4 + (k & 3)) << 6) + ((k >> 2) & 63); wfA[s] = w[0] * g; wfB[s] = w[1] * g; }
    __syncthreads();
    const int gw = F.vcu * NWAVES + F.wave, ngw = F.G * NWAVES;
    f32x4 nv[8];
    if (gw < T) { const f32x4* xr = (const f32x4*)(P.x + (size_t)gw * DM) + lane;
#pragma unroll
        for (int j = 0; j < 8; ++j) nv[j] = xr[64 * j]; }
    for (int t = gw; t < T; t += ngw) {
        f32x4 v[8]; float ss = 0.f;
#pragma unroll
        for (int j = 0; j < 8; ++j) v[j] = nv[j];
        if (t + ngw < T) { const f32x4* xr = (const f32x4*)(P.x + (size_t)(t + ngw) * DM) + lane;
#pragma unroll
            for (int j = 0; j < 8; ++j) nv[j] = xr[64 * j]; }
#pragma unroll
        for (int j = 0; j < 8; ++j) ss += (v[j].x * v[j].x + v[j].y * v[j].y) + (v[j].z * v[j].z + v[j].w * v[j].w);
        ss = wave_sum(ss);
        const float rstd = 1.0f / sqrtf(ss * (1.0f / DM) + EPS);
        u32x2* xo = (u32x2*)(XB + (size_t)t * DM) + lane;
#pragma unroll
        for (int j = 0; j < 8; ++j) { u32x2 w; w.x = pk2(v[j].x * rstd, v[j].y * rstd); w.y = pk2(v[j].z * rstd, v[j].w * rstd); xo[64 * j] = w; }
        { unsigned* x8 = (unsigned*)(ws + WS_XB8 + (size_t)t * DM) + lane; const float r8 = rstd * 8.0f;
#pragma unroll
          for (int j = 0; j < 8; ++j) { int q = __builtin_amdgcn_cvt_pk_fp8_f32(v[j].x * r8, v[j].y * r8, 0, false); q = __builtin_amdgcn_cvt_pk_fp8_f32(v[j].z * r8, v[j].w * r8, q, true); x8[64 * j] = (unsigned)q; } }
        f32x4 fa = (f32x4){0.f, 0.f, 0.f, 0.f}, fb = fa;
        int lo = lane; asm volatile("" : "+v"(lo));
#pragma unroll
        for (int j = 0; j < 8; ++j)
#pragma unroll
            for (int e = 0; e < 4; ++e) { const int s = ((j * 4 + e) << 6) + lo; fa += wfA[s] * v[j][e]; fb += wfB[s] * v[j][e]; }
        float r;
        { const bool b0 = lane & 1, b1 = lane & 2, b2 = lane & 4;
          const f32x4 keep = b0 ? fb : fa, send = b0 ? fa : fb;
          const float g0 = keep.x + __shfl_xor(send.x, 1), g1 = keep.y + __shfl_xor(send.y, 1), g2 = keep.z + __shfl_xor(send.z, 1), g3 = keep.w + __shfl_xor(send.w, 1);
          const float h0 = (b1 ? g2 : g0) + __shfl_xor(b1 ? g0 : g2, 2), h1 = (b1 ? g3 : g1) + __shfl_xor(b1 ? g1 : g3, 2);
          r = (b2 ? h1 : h0) + __shfl_xor(b2 ? h0 : h1, 4);
          r += __shfl_xor(r, 8); r += __shfl_xor(r, 16); r += __shfl_xor(r, 32); }
        if (lane < 8) { const int o = ((lane & 1) << 2) | (lane & 2) | ((lane >> 2) & 1);
            const float a = r * rstd + P.b_f[o]; logf[(size_t)t * 8 + o] = fminf(a, 0.f) - log1pf(__expf(-fabsf(a)));
            if (lane == 0) rstd1[t] = rstd; }
    }
    __syncthreads();
}
__device__ __forceinline__ void p0_pcast(const Params& P, const Frame& F) {
    const long gt = (long)F.vcu * (NWAVES * 64) + tid_now(), ngt = (long)F.G * NWAVES * 64;
    bf16* PB = (bf16*)(P.ws + WS_PB);
    for (long i = gt; i < (long)T * PLE / 8; i += ngt) { const f32x4 a = *(const f32x4*)(P.p + i * 8), b = *(const f32x4*)(P.p + i * 8 + 4);
        u32x4 o; o.x = pk2(a.x, a.y); o.y = pk2(a.z, a.w); o.z = pk2(b.x, b.y); o.w = pk2(b.z, b.w); *(u32x4*)(PB + i * 8) = o; }
}


__device__ __forceinline__ void p0_router_weights(const Params& P, const Frame& F) {
    const int gt = F.vcu * (NWAVES * 64) + tid_now(), ngt = F.G * NWAVES * 64;
    bf16* WRH = (bf16*)(P.ws + WS_WRH); bf16* WRL = (bf16*)(P.ws + WS_WRL);
    for (int i = gt; i < 48 * DM; i += ngt) { const int n = i / DM, k = i % DM;
        float v = 0.f; if (n < NE) v = P.w_re[(size_t)k * NE + n]; else if (n < NE + NGRP) v = P.w_rg[(size_t)k * NGRP + (n - NE)];
        v *= P.g_ffn[k]; const unsigned h = f2bf(v); const float lo = v - bf2f((unsigned short)h);
        WRH[i] = (bf16)h; WRL[i] = (bf16)f2bf(lo); }
}
__device__ __forceinline__ void router_mfma(const Params& P, const Frame& F) {
    unsigned char* ws = P.ws; const int tid = tid_now(), lane = tid & 63, r16 = lane & 15, kq = lane >> 4;
    const int gw = F.vcu * NWAVES + F.wave, NGW = F.G * NWAVES;
    const bf16* WRH = (const bf16*)(ws + WS_WRH); const bf16* WRL = (const bf16*)(ws + WS_WRL);
    int* EID = (int*)(ws + WS_EID); float* WTS = (float*)(ws + WS_WTS); int* POS = (int*)(ws + WS_POS); int* TOKL = (int*)(ws + WS_TOKL); float* RSTD2 = (float*)(ws + WS_RSTD2);
    unsigned* CNT = F.ctl + CW_CNT;
    LAS float* L = (LAS float*)(F.lds + RING_OFF + F.wave * 8192);
    LAS int* lcnt = (LAS int*)(F.lds + RING_OFF + 65536); LAS int* gbase = lcnt + 64;
    (void)gw; (void)NGW;
    for (int task0 = F.vcu * 4; task0 < T / 32; task0 += F.G * 4) {
        const int task = task0 + F.wave; const bool active = F.wave < 4;
        if (tid < 64) lcnt[tid] = 0;
        __syncthreads();
        int t = 0, s0 = 0, s1 = 0, lp0 = 0, lp1 = 0; float rstd = 0.f, wa = 0.f, wb = 0.f;
        if (active) {
        const bf16* xr = (const bf16*)(ws + WS_X1B) + (size_t)(task * 32 + r16) * DM + 8 * kq;
        const bf16* wh = WRH + (size_t)r16 * DM + 8 * kq; const bf16* wl = WRL + (size_t)r16 * DM + 8 * kq;
        f32x4 acc[2][3]; float ss0 = 0.f, ss1 = 0.f;
#pragma unroll
        for (int g = 0; g < 2; ++g)
#pragma unroll
            for (int nb = 0; nb < 3; ++nb) acc[g][nb] = (f32x4){0.f, 0.f, 0.f, 0.f};
#pragma unroll 1
        for (int ks0 = 0; ks0 < DM / 32; ks0 += 4) {
            u32x4 xa[4][2]; bf16x8 bh[4][3], bl[4][3];
#pragma unroll
            for (int j = 0; j < 4; ++j) { xa[j][0] = *(const u32x4*)(xr + (ks0 + j) * 32); xa[j][1] = *(const u32x4*)(xr + (size_t)16 * DM + (ks0 + j) * 32);
#pragma unroll
                for (int nb = 0; nb < 3; ++nb) { bh[j][nb] = *(const bf16x8*)(wh + (size_t)nb * 16 * DM + (ks0 + j) * 32); bl[j][nb] = *(const bf16x8*)(wl + (size_t)nb * 16 * DM + (ks0 + j) * 32); } }
#pragma unroll
            for (int j = 0; j < 4; ++j) {
                { const f32x4 a0 = bflo4(xa[j][0]), a1 = bfhi4(xa[j][0]); ss0 += (a0.x * a0.x + a0.y * a0.y) + (a0.z * a0.z + a0.w * a0.w) + (a1.x * a1.x + a1.y * a1.y) + (a1.z * a1.z + a1.w * a1.w); }
                { const f32x4 a0 = bflo4(xa[j][1]), a1 = bfhi4(xa[j][1]); ss1 += (a0.x * a0.x + a0.y * a0.y) + (a0.z * a0.z + a0.w * a0.w) + (a1.x * a1.x + a1.y * a1.y) + (a1.z * a1.z + a1.w * a1.w); }
#pragma unroll
                for (int g = 0; g < 2; ++g) { const bf16x8 ah = __builtin_bit_cast(bf16x8, xa[j][g]);
#pragma unroll
                    for (int nb = 0; nb < 3; ++nb) { acc[g][nb] = __builtin_amdgcn_mfma_f32_16x16x32_bf16(ah, bh[j][nb], acc[g][nb], 0, 0, 0); acc[g][nb] = __builtin_amdgcn_mfma_f32_16x16x32_bf16(ah, bl[j][nb], acc[g][nb], 0, 0, 0); } }
            }
        }
        ss0 += __shfl_xor(ss0, 16); ss0 += __shfl_xor(ss0, 32); ss1 += __shfl_xor(ss1, 16); ss1 += __shfl_xor(ss1, 32);
#pragma unroll
        for (int g = 0; g < 2; ++g)
#pragma unroll
            for (int nb = 0; nb < 3; ++nb)
#pragma unroll
                for (int j = 0; j < 4; ++j) L[(16 * g + 4 * kq + j) * 48 + nb * 16 + r16] = acc[g][nb][j];
        asm volatile("s_waitcnt lgkmcnt(0)" ::: "memory");
        const float ss = (lane & 16) ? ss1 : ss0;
        if (lane < 32) {
            t = task * 32 + lane; const LAS float* lg = L + lane * 48;
            rstd = 1.0f / sqrtf(ss * (1.0f / DM) + EPS);
            float gl[4];
#pragma unroll
            for (int i = 0; i < 4; ++i) gl[i] = lg[32 + i] * rstd + P.b_rg[i];
            int grp = 0; float gm = gl[0];
#pragma unroll
            for (int i = 1; i < 4; ++i) if (gl[i] > gm) { gm = gl[i]; grp = i; }
            float gsum = 0.f;
#pragma unroll
            for (int i = 0; i < 4; ++i) gsum += __expf(gl[i] - gm);
            const float p_grp = 1.0f / gsum;
            float es[8];
#pragma unroll
            for (int i = 0; i < 8; ++i) es[i] = lg[grp * 8 + i] * rstd + P.b_re[grp * 8 + i];
            int i1 = 0; float l1 = es[0];
#pragma unroll
            for (int i = 1; i < 8; ++i) if (es[i] > l1) { l1 = es[i]; i1 = i; }
            int i2 = -1; float l2 = -3.0e38f;
#pragma unroll
            for (int i = 0; i < 8; ++i) if (i != i1 && es[i] > l2) { l2 = es[i]; i2 = i; }
            const float w1 = 1.0f / (1.0f + __expf(l2 - l1)), w2 = 1.0f - w1;
            s0 = grp * EPG + i1; s1 = NE + grp * EPG + i2; wa = p_grp * w1; wb = p_grp * w2;
            lp0 = __hip_atomic_fetch_add(lcnt + s0, 1, __ATOMIC_RELAXED, __HIP_MEMORY_SCOPE_WORKGROUP); lp1 = __hip_atomic_fetch_add(lcnt + s1, 1, __ATOMIC_RELAXED, __HIP_MEMORY_SCOPE_WORKGROUP);
        }
        }
        __syncthreads();
        if (tid < 64) { const int c = lcnt[tid]; gbase[tid] = c > 0 ? (int)atomicAdd(&CNT[tid * CNT_STRIDE], (unsigned)c) : 0; }
        __syncthreads();
        if (active && lane < 32) {
            const int p0 = gbase[s0] + lp0, p1 = gbase[s1] + lp1;
            RSTD2[t] = rstd; EID[2 * t] = s0; EID[2 * t + 1] = s1 - NE; WTS[2 * t] = wa; WTS[2 * t + 1] = wb; POS[2 * t] = p0; POS[2 * t + 1] = p1;
            TOKL[(size_t)s0 * T + p0] = t; TOKL[(size_t)s1 * T + p1] = t;
            float2* SC = (float2*)(ws + WS_SC); SC[(size_t)s0 * T + p0] = make_float2(rstd, rstd * wa * 8.0f); SC[(size_t)s1 * T + p1] = make_float2(rstd, rstd * wb * 8.0f);
        }
        __syncthreads();
    }
}

__device__ __forceinline__ void thin_rstd_bf16(const bf16* X, float* RSTD, int gw, int ngw, int lane) {
    for (int t = gw; t < T; t += ngw) { const u32x4* xr = (const u32x4*)(X + (size_t)t * DM) + lane; float ss = 0.f;
#pragma unroll
        for (int j = 0; j < 4; ++j) { const u32x4 w = xr[64 * j]; const f32x4 a = bflo4(w), b = bfhi4(w); ss += (a.x * a.x + a.y * a.y) + (a.z * a.z + a.w * a.w) + (b.x * b.x + b.y * b.y) + (b.z * b.z + b.w * b.w); }
        ss = wave_sum(ss);
        if (lane == 0) RSTD[t] = 1.0f / sqrtf(ss * (1.0f / DM) + EPS); }
}
__device__ __forceinline__ void thin_rstd_fp8(const unsigned char* X, float* RSTD, int gw, int ngw, int lane) {
    for (int t = gw; t < T; t += ngw) { const u32x4* xr = (const u32x4*)(X + (size_t)t * DM) + lane; float ss = 0.f;
#pragma unroll
        for (int j = 0; j < 2; ++j) { const u32x4 w = xr[64 * j];
#pragma unroll
            for (int q = 0; q < 4; ++q) { const auto a = __builtin_amdgcn_cvt_pk_f32_fp8((int)w[q], false), b = __builtin_amdgcn_cvt_pk_f32_fp8((int)w[q], true); ss += (a[0] * a[0] + a[1] * a[1]) + (b[0] * b[0] + b[1] * b[1]); } }
        ss = wave_sum(ss);
        if (lane == 0) RSTD[t] = 1.0f / sqrtf(ss * (1.0f / DM) + EPS); }
}
__device__ __forceinline__ void thin_final_bf16(const Params& P, const bf16* X, int gw, int ngw, int lane) {
    for (int t = gw; t < T; t += ngw) { const u32x4* xr = (const u32x4*)(X + (size_t)t * DM) + lane; u32x4 w[4]; float ss = 0.f;
#pragma unroll
        for (int j = 0; j < 4; ++j) { w[j] = xr[64 * j]; const f32x4 a = bflo4(w[j]), b = bfhi4(w[j]); ss += (a.x * a.x + a.y * a.y) + (a.z * a.z + a.w * a.w) + (b.x * b.x + b.y * b.y) + (b.z * b.z + b.w * b.w); }
        ss = wave_sum(ss);
        const float rstd = 1.0f / sqrtf(ss * (1.0f / DM) + EPS);
        f32x4* o = (f32x4*)(P.out + (size_t)t * DM); const f32x4* g = (const f32x4*)P.g_final;
#pragma unroll
        for (int j = 0; j < 4; ++j) { const int c = 2 * (lane + 64 * j); __builtin_nontemporal_store(bflo4(w[j]) * rstd * g[c], &o[c]); __builtin_nontemporal_store(bfhi4(w[j]) * rstd * g[c + 1], &o[c + 1]); } }
}

struct MegaArgs { Params P; int ph_lo, ph_hi; };
constexpr int NPHASE = 12;
__global__ void __launch_bounds__(NWAVES * 64, 2) mega_fwd(MegaArgs args) {
    extern __shared__ __attribute__((aligned(16))) unsigned char lds_raw[];
    const Params& P = args.P;
    Frame F;
    F.lds = (LAS unsigned char*)lds_raw;
    F.MISC = (volatile LAS unsigned*)(F.lds + MISC_OFF);
    F.tid = threadIdx.x; F.lane = F.tid & 63; F.wave = __builtin_amdgcn_readfirstlane(F.tid >> 6);
    F.G = gridDim.x; { const int bx = blockIdx.x; F.vcu = (F.G % 8 == 0) ? (bx % 8) * (F.G / 8) + bx / 8 : bx; }
    F.ctl = (unsigned*)(P.ws + WS_CTL);
    for (int u = F.tid; u < (LDS_BYTES - LDSCTL_OFF) / 4; u += NWAVES * 64) ((LAS unsigned*)(F.lds + LDSCTL_OFF))[u] = 0u;
    __syncthreads();
    const int lo = args.ph_lo, hi = args.ph_hi;
    XcdBarrier bar; bar.bar = F.ctl + CW_BAR; bar.x = 0; bar.st = nullptr;
    if (hi - lo > 1) bar = xcd_barrier_post(F.ctl + CW_BAR, F.MISC + 8);
#define IN(k) (lo <= (k) && (k) < hi)
#if defined(PROBE_SET)
#define STAMP(k) do { if (blockIdx.x == 0 && threadIdx.x == 0) ((unsigned long long*)(P.ws + WS_CTL + 512 * 1024))[k] = __builtin_amdgcn_s_memrealtime(); } while (0)
#else
#define STAMP(k) do { } while (0)
#endif
#define SEAM(k) do { STAMP(16 + (k)); if (IN(k) && IN((k) + 1)) xcd_barrier(bar); STAMP((k) + 1); } while (0)
    STAMP(0);
    const int gw = F.vcu * NWAVES + F.wave, NGW = F.G * NWAVES;
    unsigned char* ws = P.ws;

    if (IN(0)) { p0_rowstats(P, F); p0_weights(P, F); p0_pcast(P, F); p0_router_weights(P, F); }
    SEAM(0);
    if (IN(1)) {
        thin_cumsum(P, gw, NGW, tid_now() & 63);
#if defined(LDS_NAN_CHECK)
        for (int u = F.tid; u < RING_BYTES / 4; u += NWAVES * 64) ((LAS unsigned*)(F.lds + RING_OFF))[u] = 0x7FC07FC0u;
        __syncthreads();
#endif
        { pg8::StaticOrder S; S.init(ws + WS_XB, ws + WS_WT_IN, T, 5120, DM, F.G, (int)blockIdx.x);
          pg8::EpiIn E{ws, &P, gw, NGW};
          pg8::gemm_phase<pg8::EpiIn, pg8::StaticOrder, false>(F.lds + RING_OFF, DM, S, E); }
        { pg8::StaticOrder S; S.init(ws + WS_XB8, ws + WS_WT_IN8, T, 5120, DM / 2, F.G, (int)blockIdx.x);
          pg8::EpiGate E{ws, &P, gw, NGW};
          pg8::gemm_phase<pg8::EpiGate, pg8::StaticOrder, false, true, 121, 124>(F.lds + RING_OFF, DM / 2, S, E); }
    }
    SEAM(1);
    if (IN(2)) { thin_conv(P, (long)F.vcu * (NWAVES * 64) + tid_now(), (long)F.G * NWAVES * 64);
        fox::attn_phase((char*)lds_raw, ws, (volatile int*)((char*)lds_raw + MISC_OFF + 64));
    }
    SEAM(2);
    if (IN(3)) {
        { pg8::StaticOrder S; S.init(ws + WS_Q, ws + WS_WT_A, T, DM, FW, F.G, (int)blockIdx.x); pg8::EpiMerge<0> E{ws};
          pg8::gemm_phase<pg8::EpiMerge<0>, pg8::StaticOrder, false>(F.lds + RING_OFF, FW, S, E); }
        asm volatile("s_waitcnt vmcnt(0)" ::: "memory"); __syncthreads();
        { pg8::StaticOrder S; S.init(ws + WS_BG, ws + WS_WT_B, T, DM, CW, F.G, (int)blockIdx.x); pg8::EpiMerge<1> E{ws};
          pg8::gemm_phase<pg8::EpiMerge<1>, pg8::StaticOrder, false>(F.lds + RING_OFF, CW, S, E); }
    }
    SEAM(3);
    if (IN(4)) {
        { pg8::StaticOrder S; S.init(ws + WS_MERGED, ws + WS_WT_OUT, T, DM, DM, F.G, (int)blockIdx.x); pg8::EpiX1 E{(const bf16*)(ws + WS_XB), (const float*)(ws + WS_RSTD1), (bf16*)(ws + WS_X1B), ws + WS_X1F8};
          pg8::gemm_phase<pg8::EpiX1, pg8::StaticOrder, false>(F.lds + RING_OFF, DM, S, E); }
        { pg8::StaticOrder S; S.init(ws + WS_PB, ws + WS_WT_PE, T, DM, PLE, F.G, (int)blockIdx.x); pg8::EpiPlain E{(bf16*)(ws + WS_PP), DM};
          pg8::gemm_phase<pg8::EpiPlain, pg8::StaticOrder, false>(F.lds + RING_OFF, PLE, S, E); }
    }
    SEAM(4);
    if (IN(5)) { router_mfma(P, F); }
    SEAM(5);
    LAS int* segt = (LAS int*)(F.lds + SEGT_OFF);
    if (IN(6) || IN(7) || IN(8)) {
        if (tid_now() == 0) { const unsigned* CNT = F.ctl + CW_CNT; int mt = 0, sb = 0;
            for (int s = 0; s < NSEG; ++s) { const int c = (int)__hip_atomic_load(CNT + s * CNT_STRIDE, __ATOMIC_RELAXED, __HIP_MEMORY_SCOPE_AGENT); segt[s] = c; segt[64 + s] = mt; segt[129 + s] = sb; const int n = (c + 255) >> 8; mt += n; sb += n << 8; }
            segt[64 + NSEG] = mt; segt[129 + NSEG] = sb; }
        __syncthreads();
    }
    if (IN(6)) {
        pg8::SegOrder S; S.tab = segt; S.nN = 2 * FF / 256; S.G = F.G; S.c = F.vcu; S.seg_lo = 0; S.seg_hi = NSEG; S.K = DM / 2; S.down = 0; S.A = (const char*)(ws + WS_X1F8); S.Bt = (const char*)(ws + WS_WT_GU); S.TOKL = (const int*)(ws + WS_TOKL);
        S.Lmax = 4 * F.G;
        pg8::EpiGU E{ws};
        pg8::gemm_phase<pg8::EpiGU, pg8::SegOrder, true, true>(F.lds + RING_OFF, DM / 2, S, E);
    }
    SEAM(6);
    if (IN(7)) {
        { pg8::SegOrder S; S.tab = segt; S.nN = 2 * FF / 256; S.G = F.G; S.c = F.G - 1 - F.vcu; S.seg_lo = 0; S.seg_hi = NSEG; S.K = DM / 2; S.down = 0; S.A = (const char*)(ws + WS_X1F8); S.Bt = (const char*)(ws + WS_WT_GU); S.TOKL = (const int*)(ws + WS_TOKL);
          S.L0 = 4 * F.G;
          pg8::EpiGU E{ws};
          pg8::gemm_phase<pg8::EpiGU, pg8::SegOrder, true, true>(F.lds + RING_OFF, DM / 2, S, E); }
        asm volatile("s_waitcnt vmcnt(0)" ::: "memory"); __syncthreads();
        pg8::SegOrder S; S.tab = segt; S.nN = DM / 256; S.G = F.G; S.c = F.vcu; S.seg_lo = 0; S.seg_hi = NE; S.K = FF / 2; S.down = 1; S.A = (const char*)(ws + WS_HACT); S.Bt = (const char*)(ws + WS_WT_DN); S.TOKL = (const int*)(ws + WS_TOKL);
        pg8::EpiDN<false> E{ws};
        pg8::gemm_phase<pg8::EpiDN<false>, pg8::SegOrder, false, true, 121, 124>(F.lds + RING_OFF, FF / 2, S, E);
    }
    SEAM(7);
    if (IN(8)) {
        pg8::SegOrder S; S.tab = segt; S.nN = DM / 256; S.G = F.G; S.c = F.vcu; S.seg_lo = NE; S.seg_hi = NSEG; S.K = FF / 2; S.down = 1; S.A = (const char*)(ws + WS_HACT); S.Bt = (const char*)(ws + WS_WT_DN); S.TOKL = (const int*)(ws + WS_TOKL);
        pg8::EpiDN<true> E{ws};
        pg8::gemm_phase<pg8::EpiDN<true>, pg8::SegOrder, false, true, 121, 124>(F.lds + RING_OFF, FF / 2, S, E);
    }
    SEAM(8);
    if (IN(9)) { thin_rstd_fp8(ws + WS_X2F8, (float*)(ws + WS_RSTD3), gw, NGW, tid_now() & 63); }
    SEAM(9);
    if (IN(10)) {
        pg8::EpiPle E{(const bf16*)(ws + WS_X1B), (bf16*)(ws + WS_X2B), (const bf16*)(ws + WS_PP), (const float*)(ws + WS_RSTD3)};
        pg8::StaticOrder S; S.init(ws + WS_X2F8, ws + WS_WT_PG, T, DM, DM / 2, F.G, (int)blockIdx.x);
        pg8::gemm_phase<pg8::EpiPle, pg8::StaticOrder, false, true>(F.lds + RING_OFF, DM / 2, S, E);
    }
    SEAM(10);
    if (IN(11)) { thin_final_bf16(P, (const bf16*)(ws + WS_X2B), gw, NGW, tid_now() & 63); }
    STAMP(12);
#undef IN
#undef SEAM
}
#if defined(PROBE_SET)
#ifndef PROBE_SCALE
#define PROBE_SCALE 0.1f
#endif
#ifndef PROBE_OFF
#define PROBE_OFF 0.f
#endif
__global__ void k_probe(Params P, int set) {
    const unsigned long long* st = (const unsigned long long*)(P.ws + WS_CTL + 512 * 1024);
    float us = 0.f;
    for (int k = 0; k < 12; ++k) if ((set >> k) & 1) us += (float)(st[k + 1] - st[k]) * 0.01f;
    for (int k = 0; k < 11; ++k) if ((set >> (16 + k)) & 1) us += (float)(st[k + 1] - st[16 + k]) * 0.01f;
    if (threadIdx.x == 0 && blockIdx.x == 0) P.out[0] += (us - PROBE_OFF) * PROBE_SCALE;
}
#endif
static void launch_mega(const Params& P, int lo, int hi, hipStream_t stream) {
    static bool attr_done = false;
    if (!attr_done) { attr_done = true;
        if (hipFuncSetAttribute((const void*)mega_fwd, hipFuncAttributeMaxDynamicSharedMemorySize, LDS_BYTES) != hipSuccess) fprintf(stderr, "kernel_launch: hipFuncSetAttribute failed\n");
        (void)hipGetLastError(); }
    if (lo >= hi) return;
    MegaArgs a; memset(&a, 0, sizeof(a)); a.P = P; a.ph_lo = lo; a.ph_hi = hi;
    hipLaunchKernelGGL(mega_fwd, dim3(256), dim3(NWAVES * 64), LDS_BYTES, stream, a);
    const hipError_t le = hipPeekAtLastError();
    if (le != hipSuccess) fprintf(stderr, "kernel_launch: mega launch [%d,%d) failed: %s\n", lo, hi, hipGetErrorName(le));
}
extern "C" void kernel_launch(void* const* d_in, const int* in_sizes, int n_in, void* d_out, int out_size, void* d_ws, size_t ws_size, hipStream_t stream) {
    if (n_in != 20 || in_sizes[0] != T * DM || out_size != T * DM || ws_size < WS_END) {
        fprintf(stderr, "kernel_launch: unexpected shapes (n_in %d, in0 %d, out %d, ws %zu; need ws >= %zu); nothing launched\n", n_in, n_in > 0 ? in_sizes[0] : -1, out_size, ws_size, (size_t)WS_END); return; }
    Params P; memset(&P, 0, sizeof(P));
    const float** pp = (const float**)&P;
    for (int i = 0; i < 20; ++i) pp[i] = (const float*)d_in[i];
    P.out = (float*)d_out; P.ws = (unsigned char*)d_ws;
    unsigned char* ws = P.ws;
    (void)hipMemsetAsync(ws + WS_CTL, 0, 1 * MiB, stream);
    launch_mega(P, 0, NPHASE, stream);
#if defined(PROBE_SET)
    k_probe<<<1, 64, 0, stream>>>(P, PROBE_SET);
#endif
}
```

```cpp
#include <hip/hip_runtime.h>
#include <cstdio>
#include <cstdint>
#include <cstring>

constexpr int BATCH = 8, SEQ = 4096, DM = 2048, T = BATCH * SEQ;
constexpr int NH = 8, HD = 128, FW = 1024, CW = 1024, PLE = 256, NGRP = 4, EPG = 8, NE = 32, FF = 512;
constexpr int IN_COLS = 3 * FW + NH + 3 * CW + 2 * DM;
constexpr int C_Q = 0, C_K = 1024, C_V = 2048, C_F = 3072, C_U = 3080, C_BG = 4104, C_CG = 5128, C_GA = 6152;
constexpr float EPS = 1e-6f;
constexpr int NSEG = 64;

constexpr size_t MiB = 1u << 20;
constexpr size_t WS_CTL = 0;
constexpr size_t WS_RSTD1 = 1 * MiB;
constexpr size_t WS_LOGF = 2 * MiB;
constexpr size_t WS_CUM = 3 * MiB;
constexpr size_t WS_NQ = 6 * MiB;
constexpr size_t WS_RSTD2 = 4 * MiB, WS_RSTD3 = 5 * MiB;
constexpr size_t WS_EID = 7 * MiB;
constexpr size_t WS_WTS = 7 * MiB + 512 * 1024;
constexpr size_t WS_POS = 8 * MiB;
constexpr size_t WS_SEGB = 8 * MiB + 512 * 1024;
constexpr size_t WS_TOKL = 9 * MiB;
constexpr size_t WS_WRH = 17 * MiB, WS_WRL = 17 * MiB + 256 * 1024;
constexpr size_t WS_WT_IN = 20 * MiB, WS_WT_A = 60 * MiB, WS_WT_B = 64 * MiB, WS_WT_OUT = 68 * MiB, WS_WT_PG = 76 * MiB, WS_WT_PE = 84 * MiB;
constexpr size_t WS_PB = 86 * MiB;
constexpr size_t WS_WT_GU = 104 * MiB, WS_WT_DN = 232 * MiB;
constexpr size_t WS_WT_IN8 = WS_WT_IN + (size_t)6144 * 2048 * 2;
constexpr size_t WS_SC = 264 * MiB;
constexpr size_t WS_XB8 = 168 * MiB;
constexpr size_t WS_XB = 296 * MiB;
constexpr size_t WS_Q = 424 * MiB, WS_K = 488 * MiB, WS_V = 552 * MiB;
constexpr size_t WS_Z = 616 * MiB, WS_BG = 680 * MiB;
constexpr size_t WS_GAB = 744 * MiB;
constexpr size_t WS_MERGED = 552 * MiB;
constexpr size_t WS_X1B = 424 * MiB;
constexpr size_t WS_HACT = 552 * MiB;
constexpr size_t WS_X2B = 744 * MiB;
constexpr size_t WS_PP = 872 * MiB;
constexpr size_t WS_X2F8 = 632 * MiB;
constexpr size_t WS_X1F8 = 680 * MiB;
constexpr size_t WS_END = 1000 * MiB;
constexpr int CW_CNT = 16384, CNT_STRIDE = 64;
constexpr int CW_N2 = 2048;
constexpr int CW_ATT = 3072;

typedef unsigned short bf16;
typedef float f32x4 __attribute__((ext_vector_type(4)));
typedef unsigned u32x4 __attribute__((ext_vector_type(4)));
typedef unsigned u32x2 __attribute__((ext_vector_type(2)));

struct Params {
    const float *x, *p, *g_mix, *w_in, *b_f, *conv_w, *w_a, *w_b, *w_out, *g_ffn, *w_rg, *b_rg, *w_re, *b_re, *w_gu, *w_dn, *g_ple, *w_pg, *w_pe, *g_final;
    float* out; unsigned char* ws;
};

__device__ __forceinline__ unsigned f2bf(float f) { unsigned u = __builtin_bit_cast(unsigned, f); return (u + 0x7fffu + ((u >> 16) & 1u)) >> 16; }
__device__ __forceinline__ unsigned pk2(float lo, float hi) { return f2bf(lo) | (f2bf(hi) << 16); }
__device__ __forceinline__ float bf2f(unsigned short b) { return __builtin_bit_cast(float, (unsigned)b << 16); }
__device__ __forceinline__ float bflo(unsigned w) { return __builtin_bit_cast(float, w << 16); }
__device__ __forceinline__ float bfhi(unsigned w) { return __builtin_bit_cast(float, w & 0xffff0000u); }
__device__ __forceinline__ float wave_sum(float v) {
#pragma unroll
    for (int o = 1; o < 64; o <<= 1) v += __shfl_xor(v, o);
    return v;
}
__device__ __forceinline__ float wave_max(float v) {
#pragma unroll
    for (int o = 1; o < 64; o <<= 1) v = fmaxf(v, __shfl_xor(v, o));
    return v;
}
__device__ __forceinline__ float sigmoidf_(float v) { return 1.0f / (1.0f + __expf(-v)); }

__device__ __forceinline__ void thin_cumsum(const Params& P, int gw, int ngw, int lane) {
    const float* logf = (const float*)(P.ws + WS_LOGF); float* cum = (float*)(P.ws + WS_CUM);
    for (int bh = gw; bh < BATCH * NH; bh += ngw) {
        const int b = bh / NH, h = bh % NH;
        const float* src = logf + ((size_t)b * SEQ + lane * 64) * 8 + h;
        double s = 0.0;
        for (int i = 0; i < 64; ++i) s += (double)src[(size_t)i * 8];
        double incl = s;
#pragma unroll
        for (int o = 1; o < 64; o <<= 1) { const double up = __shfl_up(incl, o); if (lane >= o) incl += up; }
        double run = incl - s;
        float* dst = cum + (size_t)bh * SEQ + lane * 64;
        for (int i = 0; i < 64; ++i) { run += (double)src[(size_t)i * 8]; dst[i] = (float)run; }
    }
}
__device__ __forceinline__ void thin_conv(const Params& P, long gt, long ngt) {
    const bf16* Z = (const bf16*)(P.ws + WS_Z); bf16* BG = (bf16*)(P.ws + WS_BG);
    for (long i0 = gt; i0 < (long)T * (CW / 8); i0 += 2 * ngt) {
        int tt[2], cc[2]; u32x4 z2[2], z1[2], z0[2], bb[2];
#pragma unroll
        for (int r = 0; r < 2; ++r) { const long i = i0 + r * ngt; const int t = (int)(i / (CW / 8)), c = (int)(i % (CW / 8)) * 8, s = t % SEQ; tt[r] = t; cc[r] = c;
            z2[r] = *(const u32x4*)(Z + (size_t)t * CW + c); z1[r] = (u32x4){0u, 0u, 0u, 0u}; z0[r] = (u32x4){0u, 0u, 0u, 0u};
            if (s >= 1) z1[r] = *(const u32x4*)(Z + (size_t)(t - 1) * CW + c);
            if (s >= 2) z0[r] = *(const u32x4*)(Z + (size_t)(t - 2) * CW + c);
            bb[r] = *(const u32x4*)(BG + (size_t)t * CW + c); }
#pragma unroll
        for (int r = 0; r < 2; ++r) { const int c = cc[r]; u32x4 o;
#pragma unroll
            for (int q = 0; q < 4; ++q) {
                const int c0 = c + 2 * q;
                const float lo = bflo(bb[r][q]) * (P.conv_w[c0] * bflo(z0[r][q]) + P.conv_w[CW + c0] * bflo(z1[r][q]) + P.conv_w[2 * CW + c0] * bflo(z2[r][q]));
                const float hi = bfhi(bb[r][q]) * (P.conv_w[c0 + 1] * bfhi(z0[r][q]) + P.conv_w[CW + c0 + 1] * bfhi(z1[r][q]) + P.conv_w[2 * CW + c0 + 1] * bfhi(z2[r][q]));
                o[q] = pk2(lo, hi);
            }
            *(u32x4*)(BG + (size_t)tt[r] * CW + c) = o; }
    }
}
#define LAS __attribute__((address_space(3)))
#define GAS __attribute__((address_space(1)))
typedef short bf16x8 __attribute__((ext_vector_type(8)));
typedef float f32x2 __attribute__((ext_vector_type(2)));
constexpr int NWAVES = 8;
constexpr int RING_OFF = 0, RING_BYTES = 131072;
constexpr int LDSCTL_OFF = RING_BYTES, MISC_OFF = LDSCTL_OFF + 320;
constexpr int SEGT_OFF = LDSCTL_OFF + 1024;
constexpr int LDS_BYTES = 147456;
constexpr int CW_BAR = 4096;
typedef __bf16 bf16x2_t __attribute__((ext_vector_type(2)));
__device__ __forceinline__ unsigned cvt_pk_bf16(float lo, float hi) { f32x2 v = {lo, hi}; bf16x2_t b = __builtin_convertvector(v, bf16x2_t); return __builtin_bit_cast(unsigned, b); }
typedef int i32x8 __attribute__((ext_vector_type(8)));
typedef unsigned u32x8 __attribute__((ext_vector_type(8)));
__device__ __forceinline__ u32x2 pack8_fp8(f32x4 a, f32x4 b) { u32x2 w; int t = __builtin_amdgcn_cvt_pk_fp8_f32(a.x, a.y, 0, false); t = __builtin_amdgcn_cvt_pk_fp8_f32(a.z, a.w, t, true); w.x = (unsigned)t;
    t = __builtin_amdgcn_cvt_pk_fp8_f32(b.x, b.y, 0, false); t = __builtin_amdgcn_cvt_pk_fp8_f32(b.z, b.w, t, true); w.y = (unsigned)t; return w; }
__device__ __forceinline__ float fast_sigmoid(float v) { return __builtin_amdgcn_rcpf(1.0f + __builtin_amdgcn_exp2f(v * -1.4426950408889634f)); }

#define XB_TMO      128
#define XB_XCNT(j)  (256  + 64 * (j))
#define XB_XSUB(j)  (1280 + 64 * (j))
#define XB_XGEN(j)  (2304 + 64 * (j))
#define XB_TOP      3328
#define XB_TOPGEN   3392
#define XCD_BAR_WORDS 3456
#define XB_SPIN_CAP (1u << 18)
__device__ __forceinline__ unsigned xb_ld(unsigned* p)              { return __hip_atomic_load(p, __ATOMIC_RELAXED, __HIP_MEMORY_SCOPE_AGENT); }
__device__ __forceinline__ unsigned xb_add(unsigned* p, unsigned v) { return __hip_atomic_fetch_add(p, v, __ATOMIC_RELAXED, __HIP_MEMORY_SCOPE_AGENT); }
__device__ __forceinline__ unsigned xb_xcc_id() { return (unsigned)__builtin_amdgcn_s_getreg((3 << 11) | 20) & 0xFu; }
#define XB_SPIN(cond, bar) do { unsigned _sp = 0; while (cond) { __builtin_amdgcn_s_sleep(1); \
    if ((++_sp & 255u) == 0u) { if (xb_ld(&(bar)[XB_TMO])) break; if (_sp > XB_SPIN_CAP) { atomicAdd(&(bar)[XB_TMO], 1u); break; } } } } while (0)
struct XcdBarrier { unsigned* bar; unsigned x; volatile LAS unsigned* st; };
__device__ __forceinline__ XcdBarrier xcd_barrier_post(unsigned* bar, volatile LAS unsigned* st) {
    XcdBarrier b; b.bar = bar; b.x = xb_xcc_id(); b.st = st;
    if (threadIdx.x == 0) (void)xb_add(&bar[XB_XCNT(b.x)], 1u);
    return b;
}
__device__ __forceinline__ void xcd_barrier_complete(unsigned* bar, unsigned x, unsigned& nloc, unsigned& nx) {
    const unsigned G = gridDim.x * gridDim.y * gridDim.z;
    unsigned sum, cnt, mine, sp = 0u;
    for (;;) {
        sum = 0u; cnt = 0u; mine = 0u;
#pragma unroll
        for (unsigned j = 0; j < 16; ++j) { const unsigned c = xb_ld(&bar[XB_XCNT(j)]); sum += c; cnt += (c > 0u) ? 1u : 0u; mine = (j == x) ? c : mine; }
        if (sum == G) break;
        __builtin_amdgcn_s_sleep(1);
        if ((++sp & 255u) == 0u) { if (xb_ld(&bar[XB_TMO])) break; if (sp > XB_SPIN_CAP) { atomicAdd(&bar[XB_TMO], 1u); break; } }
    }
    nloc = mine > 0u ? mine : 1u; nx = cnt > 0u ? cnt : 1u;
}
__device__ __forceinline__ void xcd_barrier(const XcdBarrier& b) {
    asm volatile("s_waitcnt vmcnt(0)" ::: "memory");
    __syncthreads();
    if (threadIdx.x == 0) {
        unsigned* bar = b.bar;
        __builtin_amdgcn_s_waitcnt(0);
        unsigned nloc = b.st[0], nx = b.st[1];
        if (nloc == 0u) { xcd_barrier_complete(bar, b.x, nloc, nx); b.st[0] = nloc; b.st[1] = nx; }
        const unsigned old = xb_add(&bar[XB_XSUB(b.x)], 1u);
        const unsigned gen = old / nloc;
        if (old + 1u == (gen + 1u) * nloc) {
            __builtin_amdgcn_fence(__ATOMIC_RELEASE, "agent");
            asm volatile("s_waitcnt vmcnt(0)" ::: "memory");
            const unsigned og = xb_add(&bar[XB_TOP], 1u);
            const unsigned tg = og / nx;
            if (og + 1u == (tg + 1u) * nx) xb_add(&bar[XB_TOPGEN], 1u);
            else XB_SPIN(xb_ld(&bar[XB_TOPGEN]) == tg, bar);
            __builtin_amdgcn_fence(__ATOMIC_ACQUIRE, "agent");
            xb_add(&bar[XB_XGEN(b.x)], 1u);
            asm volatile("s_waitcnt vmcnt(0)" ::: "memory");
        } else {
            XB_SPIN(xb_ld(&bar[XB_XGEN(b.x)]) == gen, bar);
            __builtin_amdgcn_fence(__ATOMIC_ACQUIRE, "agent");
            asm volatile("s_waitcnt vmcnt(0)" ::: "memory");
        }
    }
    __syncthreads();
}

struct Params;
struct XItem { const float* src; const float* gain; unsigned char* dst; int ldw, K, fp8; };
struct SidePair { XItem a, b; f32x4 va[8], vb[8]; int n; };
__device__ __forceinline__ void side_load(const Params& P, int gw, int NGW, int k, int lane, SidePair& sp);
__device__ __forceinline__ void side_store(int lane, const SidePair& sp);
namespace pg8 {
constexpr int BM = 256, BK = 64, HALF = 128, HTB = HALF * BK * 2, STAGE_BYTES = 8 * HTB, NXCD = 8, WGM = 8;
__host__ __device__ __forceinline__ int lds_byte(int r, int c) { const int st = (r >> 4) * 2 + (c >> 5), rr = r & 15, cc = c & 31, ob = rr * 64 + cc * 2; return st * 1024 + (ob ^ (((ob >> 9) & 1) << 5)); }
__host__ __device__ __forceinline__ void stage_rc(int b, int& R, int& C) { const int st = b / 1024, sb = b % 1024, swz = sb ^ (((sb >> 9) & 1) << 5); R = (st >> 1) * 16 + swz / 64; C = (st & 1) * 32 + (swz % 64) / 2; }
__host__ __device__ __forceinline__ int perm32(int rho) { const int n = rho >> 4, i = rho & 15; return 8 * (i >> 2) + 4 * n + (i & 3); }

struct Unit { int pm, pn, seg, mt, nrow, slot0, ui; const char* a; const char* b; };

struct StaticOrder {
    int nM, nN, nwg, G, c, K; const char* A; const char* Bt;
    __device__ void init(const void* A_, const void* Bt_, int M, int N, int K_, int G_, int c_) { A = (const char*)A_; Bt = (const char*)Bt_; nM = M / BM; nN = N / BM; nwg = nM * nN; G = G_; c = c_; K = K_; }
    __device__ bool next(int i, Unit& u) const {
        const long L = (long)i * G + c; if (L >= nwg) return false;
        int wgid = (int)L; { const int q = nwg / NXCD, r = nwg % NXCD, xcd = wgid % NXCD, off = wgid / NXCD; wgid = (xcd < r ? xcd * (q + 1) : r * (q + 1) + (xcd - r) * q) + off; }
        const int nig = WGM * nN, gid = wgid / nig, fm = gid * WGM, gsz = (nM - fm) < WGM ? (nM - fm) : WGM;
        u.pm = fm + ((wgid % nig) % gsz); u.pn = (wgid % nig) / gsz;
#if defined(REV_PN)
        u.pn = nN - 1 - u.pn;
#endif
        u.seg = 0; u.mt = 0; u.nrow = BM; u.slot0 = 0;
        u.a = A + (size_t)u.pm * BM * K * 2; u.b = Bt + (size_t)u.pn * BM * K * 2; return true;
    }
    __device__ __forceinline__ unsigned arow(const Unit&, int r) const { return (unsigned)r; }
};

template <class Epi, class Sched, bool GATHER, bool FP8 = false, int SCW = 121, int SCA = 127>
__device__ __forceinline__ void gemm_phase(LAS unsigned char* lds, const int K, const Sched& S, const Epi& E) {
    const int tid = threadIdx.x, wid = __builtin_amdgcn_readfirstlane(tid >> 6), lane = tid & 63, wr = wid >> 2, wc = wid & 3, fr = lane & 15, fq = lane >> 4;
    const int nt = K / BK;
    int Rr[2], Cc[2]; unsigned voffB[2];
#pragma unroll
    for (int i = 0; i < 2; ++i) { int R, C; stage_rc(tid * 16 + i * 8192, R, C); const int Rb = Epi::PERM ? ((R & ~31) + perm32(R & 31)) : R; Rr[i] = R; Cc[i] = C; voffB[i] = (unsigned)(Rb * K + C) * 2u; }
    const size_t kstep = (size_t)(BK * 2);
    const size_t hstep = (size_t)HALF * K * 2;
    const unsigned ldsw = (unsigned)wid * 1024u;
    const int aoff = lds_byte(wr * 64 + fr, fq * 8), boff = lds_byte(wc * 32 + fr, fq * 8);
#define PG8_SA(b, h) (((b) * 2 + (h)) * HTB)
#define PG8_SB(b, h) ((4 + (b) * 2 + (h)) * HTB)
#define PG8_LD1(bufoff, gptr, i_) __builtin_amdgcn_global_load_lds((const unsigned*)(gptr), (LAS unsigned*)(lds + (bufoff) + ldsw + (i_) * 8192), 16, 0, 0)
#define PG8_STAGE_B(bufoff, gbase) do { PG8_LD1(bufoff, (const char*)(gbase) + voffB[0], 0); PG8_LD1(bufoff, (const char*)(gbase) + voffB[1], 1); } while (0)
#define PG8_STAGE_A(bufoff, gbase, v0, v1) do { PG8_LD1(bufoff, (const char*)(gbase) + (v0), 0); PG8_LD1(bufoff, (const char*)(gbase) + (v1), 1); } while (0)
#define PG8_LDA(dst, b, h) do { if constexpr (FP8) { _Pragma("unroll") for (int m = 0; m < 4; ++m) dst##8[m] = __builtin_shufflevector(*(const LAS u32x4*)(lds + PG8_SA(b, h) + aoff + m * 2048), *(const LAS u32x4*)(lds + PG8_SA(b, h) + aoff + m * 2048 + 1024), 0, 1, 2, 3, 4, 5, 6, 7); } \
        else { _Pragma("unroll") for (int m = 0; m < 4; ++m) _Pragma("unroll") for (int k = 0; k < 2; ++k) dst[m][k] = *(const LAS bf16x8*)(lds + PG8_SA(b, h) + aoff + m * 2048 + k * 1024); } } while (0)
#define PG8_LDB(dst, b, h) do { if constexpr (FP8) { _Pragma("unroll") for (int n = 0; n < 2; ++n) dst##8[n] = __builtin_shufflevector(*(const LAS u32x4*)(lds + PG8_SB(b, h) + boff + n * 2048), *(const LAS u32x4*)(lds + PG8_SB(b, h) + boff + n * 2048 + 1024), 0, 1, 2, 3, 4, 5, 6, 7); } \
        else { _Pragma("unroll") for (int n = 0; n < 2; ++n) _Pragma("unroll") for (int k = 0; k < 2; ++k) dst[n][k] = *(const LAS bf16x8*)(lds + PG8_SB(b, h) + boff + n * 2048 + k * 1024); } } while (0)
#define PG8_MMA(ai, bj, At, Bt) do { __builtin_amdgcn_s_setprio(1); if constexpr (FP8) { _Pragma("unroll") for (int m = 0; m < 4; ++m) _Pragma("unroll") for (int n = 0; n < 2; ++n) \
        asm volatile("v_mfma_scale_f32_16x16x128_f8f6f4 %0, %1, %2, %0, %3, %4 op_sel_hi:[0,0,0]" : "+v"(acc[ai][bj][m][n]) : "v"(Bt##8[n]), "v"(At##8[m]), "v"(scw), "v"(sca)); } \
        else { _Pragma("unroll") for (int m = 0; m < 4; ++m) _Pragma("unroll") for (int n = 0; n < 2; ++n) _Pragma("unroll") for (int k = 0; k < 2; ++k) \
        acc[ai][bj][m][n] = __builtin_amdgcn_mfma_f32_16x16x32_bf16(Bt[n][k], At[m][k], acc[ai][bj][m][n], 0, 0, 0); } __builtin_amdgcn_s_setprio(0); } while (0)
#define PG8_WAIT_V(n) asm volatile("s_waitcnt vmcnt(" #n ")" ::: "memory")
#define PG8_WAIT_L(n) asm volatile("s_waitcnt lgkmcnt(" #n ")" ::: "memory")
#define PG8_BAR __builtin_amdgcn_s_barrier()
#define PG8_SCHED __builtin_amdgcn_sched_barrier(0)
#define PG8_VOFFA(dst, u) do { _Pragma("unroll") for (int h_ = 0; h_ < 2; ++h_) _Pragma("unroll") for (int i_ = 0; i_ < 2; ++i_) \
        dst[h_][i_] = S.arow(u, h_ * HALF + Rr[i_]) * (unsigned)(K * 2) + (unsigned)(Cc[i_] * 2); } while (0)
    Unit cur, nxt; int ui = 0;
    cur.seg = 0;
    if (!S.next(0, cur)) return;
    cur.ui = 0;
    f32x4 acc[2][2][4][2];
#pragma unroll
    for (int a = 0; a < 2; ++a)
#pragma unroll
        for (int b = 0; b < 2; ++b)
#pragma unroll
            for (int m = 0; m < 4; ++m)
#pragma unroll
                for (int n = 0; n < 2; ++n) acc[a][b][m][n] = (f32x4){0.f, 0.f, 0.f, 0.f};
    bf16x8 At[4][2], B0[2][2], B1[2][2];
    u32x8 At8[4], B08[2], B18[2];
    const int scw = SCW, sca = SCA;
    unsigned voffA[2][2];
    PG8_VOFFA(voffA, cur);
    const char* cA = cur.a; const char* cB = cur.b;
    PG8_STAGE_B(PG8_SB(0, 0), cB); PG8_STAGE_B(PG8_SB(0, 1), cB + hstep); PG8_STAGE_A(PG8_SA(0, 0), cA, voffA[0][0], voffA[0][1]); PG8_STAGE_A(PG8_SA(0, 1), cA, voffA[1][0], voffA[1][1]);
    if (wr == 1) PG8_BAR;
    PG8_WAIT_V(2); PG8_BAR;
    PG8_STAGE_B(PG8_SB(1, 0), cB + kstep); PG8_STAGE_A(PG8_SA(1, 0), cA + kstep, voffA[0][0], voffA[0][1]); PG8_STAGE_B(PG8_SB(1, 1), cB + hstep + kstep);
    PG8_WAIT_V(6); PG8_BAR;
    for (;;) {
        nxt.seg = cur.seg;
        const bool has_next = S.next(ui + 1, nxt);
        const char* nA = has_next ? nxt.a : cA; const char* nB = has_next ? nxt.b : cB;
#pragma unroll 1
        for (int t = 0; t < nt; t += 2) {
            const bool last = (t == nt - 2);
            const char* a1 = cA + (size_t)(t + 1) * kstep;
            const char* a2 = last ? nA : cA + (size_t)(t + 2) * kstep; const char* b2 = last ? nB : cB + (size_t)(t + 2) * kstep;
            const char* a3 = a2 + kstep; const char* b3 = b2 + kstep;
            PG8_LDB(B0, 0, 0); PG8_LDB(B1, 0, 1); PG8_SCHED; PG8_LDA(At, 0, 0); PG8_STAGE_A(PG8_SA(1, 1), a1, voffA[1][0], voffA[1][1]);
            if constexpr (GATHER) { if (last && has_next) { PG8_VOFFA(voffA, nxt); } }
            PG8_WAIT_V(8); PG8_WAIT_L(0); PG8_BAR; PG8_MMA(0, 0, At, B0); PG8_MMA(0, 1, At, B1); PG8_BAR; PG8_SCHED;
            PG8_LDA(At, 0, 1); PG8_STAGE_B(PG8_SB(0, 0), b2); PG8_STAGE_B(PG8_SB(0, 1), b2 + hstep); PG8_STAGE_A(PG8_SA(0, 0), a2, voffA[0][0], voffA[0][1]);
            PG8_WAIT_V(8); PG8_WAIT_L(0); PG8_BAR; PG8_MMA(1, 0, At, B0); PG8_MMA(1, 1, At, B1); PG8_BAR; PG8_SCHED;
            PG8_LDB(B0, 1, 0); PG8_LDB(B1, 1, 1); PG8_SCHED; PG8_LDA(At, 1, 0); PG8_STAGE_A(PG8_SA(0, 1), a2, voffA[1][0], voffA[1][1]);
            PG8_WAIT_V(8); PG8_WAIT_L(0); PG8_BAR; PG8_MMA(0, 0, At, B0); PG8_MMA(0, 1, At, B1); PG8_BAR; PG8_SCHED;
            PG8_LDA(At, 1, 1); PG8_STAGE_B(PG8_SB(1, 0), b3); PG8_STAGE_B(PG8_SB(1, 1), b3 + hstep); PG8_STAGE_A(PG8_SA(1, 0), a3, voffA[0][0], voffA[0][1]);
            PG8_WAIT_V(8); PG8_WAIT_L(0); PG8_BAR; PG8_MMA(1, 0, At, B0); PG8_MMA(1, 1, At, B1); PG8_BAR; PG8_SCHED;
        }
        if (wr == 0) PG8_BAR;
        if constexpr (FP8) asm volatile("s_nop 15\n\ts_nop 15" ::: "memory");
        E(acc, cur, wr, wc, fr, fq);
        if (!has_next) break;
#pragma unroll
        for (int a = 0; a < 2; ++a)
#pragma unroll
            for (int b = 0; b < 2; ++b)
#pragma unroll
                for (int m = 0; m < 4; ++m)
#pragma unroll
                    for (int n = 0; n < 2; ++n) acc[a][b][m][n] = (f32x4){0.f, 0.f, 0.f, 0.f};
        cur = nxt; cA = nA; cB = nB; ++ui; cur.ui = ui;
        if (wr == 1) PG8_BAR;
    }
    PG8_WAIT_V(0);
    PG8_BAR;
#undef PG8_SA
#undef PG8_SB
#undef PG8_LD1
#undef PG8_STAGE_A
#undef PG8_STAGE_B
#undef PG8_LDA
#undef PG8_LDB
#undef PG8_MMA
#undef PG8_WAIT_V
#undef PG8_WAIT_L
#undef PG8_BAR
#undef PG8_SCHED
#undef PG8_VOFFA
}

typedef const f32x4 (&AccRef)[2][2][4][2];
__device__ __forceinline__ u32x4 pack8(f32x4 v0, f32x4 v1) { u32x4 w; w.x = cvt_pk_bf16(v0[0], v0[1]); w.y = cvt_pk_bf16(v0[2], v0[3]); w.z = cvt_pk_bf16(v1[0], v1[1]); w.w = cvt_pk_bf16(v1[2], v1[3]); return w; }
__device__ __forceinline__ f32x4 sig4(f32x4 v) { return (f32x4){fast_sigmoid(v[0]), fast_sigmoid(v[1]), fast_sigmoid(v[2]), fast_sigmoid(v[3])}; }
__device__ __forceinline__ f32x4 bflo4(u32x4 w) { return (f32x4){bflo(w.x), bfhi(w.x), bflo(w.y), bfhi(w.y)}; }
__device__ __forceinline__ f32x4 bfhi4(u32x4 w) { return (f32x4){bflo(w.z), bfhi(w.z), bflo(w.w), bfhi(w.w)}; }
__device__ __forceinline__ unsigned q8x4(f32x4 v) { const unsigned a = (unsigned)(v.x * 255.0f + 0.5f), b = (unsigned)(v.y * 255.0f + 0.5f), c = (unsigned)(v.z * 255.0f + 0.5f), d = (unsigned)(v.w * 255.0f + 0.5f); return a | (b << 8) | (c << 16) | (d << 24); }
__device__ __forceinline__ f32x4 dq8x4(unsigned w) { return (f32x4){(float)(w & 0xffu), (float)((w >> 8) & 0xffu), (float)((w >> 16) & 0xffu), (float)(w >> 24)} * (1.0f / 255.0f); }

struct EpiIn {
    static constexpr bool PERM = true;
    unsigned char* ws; const Params* P; int gw, NGW;
    __device__ __forceinline__ void operator()(AccRef acc, const Unit& u, int wr, int wc, int fr, int fq) const {
        asm volatile("" : "+v"(fr), "+v"(fq));
        const int row0 = u.pm * BM + wr * 64 + fr, cw = wc * 32 + 8 * fq;
        const int pn = u.pn < 8 ? u.pn : u.pn + 4;
        if (pn < 8) {
            float* NQ = (float*)(ws + WS_NQ) + (size_t)(pn >> 2) * (512 * NH * 4);
#pragma unroll
            for (int bj = 0; bj < 2; ++bj)
#pragma unroll
                for (int ai = 0; ai < 2; ++ai) { float mx = 0.f;
#pragma unroll
                    for (int m = 0; m < 4; ++m) { const f32x4 a = acc[ai][bj][m][0], b = acc[ai][bj][m][1];
                        float s = (a.x * a.x + a.y * a.y) + (a.z * a.z + a.w * a.w) + (b.x * b.x + b.y * b.y) + (b.z * b.z + b.w * b.w);
                        s += __shfl_xor(s, 16); s += __shfl_xor(s, 32); mx = fmaxf(mx, s); }
#pragma unroll
                    for (int o = 1; o < 16; o <<= 1) mx = fmaxf(mx, __shfl_xor(mx, o));
                    if (fr == 0 && fq == 0) NQ[((size_t)(u.pm * 4 + ai * 2 + wr) * NH + 2 * (pn & 3) + bj) * 4 + wc] = mx * 1.03f; }
        }
        if (pn < 12 || (pn >= 20 && pn < 24)) {
            bf16* base; if (pn < 12) base = (bf16*)(ws + WS_Q) + (size_t)(pn >> 2) * ((size_t)T * FW) + (pn & 3) * BM; else base = (bf16*)(ws + WS_BG) + (pn - 20) * BM;
#pragma unroll
            for (int ai = 0; ai < 2; ++ai)
#pragma unroll
                for (int m = 0; m < 4; ++m) { bf16* rowp = base + (size_t)(row0 + ai * HALF + m * 16) * FW + cw;
#pragma unroll
                    for (int bj = 0; bj < 2; ++bj) *(u32x4*)(rowp + bj * HALF) = pack8(acc[ai][bj][m][0], acc[ai][bj][m][1]); }
        } else if (pn < 20) {
            bf16* base = (bf16*)(ws + WS_Z) + (pn - 12) * HALF;
#pragma unroll
            for (int ai = 0; ai < 2; ++ai)
#pragma unroll
                for (int m = 0; m < 4; ++m) { bf16* rowp = base + (size_t)(row0 + ai * HALF + m * 16) * CW + cw;
                    *(u32x4*)rowp = pack8(acc[ai][0][m][0] * acc[ai][1][m][0], acc[ai][0][m][1] * acc[ai][1][m][1]); }
        }
        { SidePair sp; side_load(*P, gw, NGW, u.ui, (fq << 4) | fr, sp); side_store((fq << 4) | fr, sp); }
    }
};

struct EpiGate {
    static constexpr bool PERM = true;
    static constexpr int UI0 = 10;
    unsigned char* ws; const Params* P; int gw, NGW;
    __device__ __forceinline__ void operator()(AccRef acc, const Unit& u, int wr, int wc, int fr, int fq) const {
        asm volatile("" : "+v"(fr), "+v"(fq));
        const int row0 = u.pm * BM + wr * 64 + fr, cw = wc * 32 + 8 * fq;
        if (u.pn < 4) {
            bf16* vb = (bf16*)(ws + WS_V) + u.pn * BM;
#pragma unroll
            for (int ai = 0; ai < 2; ++ai)
#pragma unroll
                for (int m = 0; m < 4; ++m) { bf16* rowp = vb + (size_t)(row0 + ai * HALF + m * 16) * FW + cw;
#pragma unroll
                    for (int bj = 0; bj < 2; ++bj) *(u32x4*)(rowp + bj * HALF) = pack8(acc[ai][bj][m][0], acc[ai][bj][m][1]); }
        } else {
        unsigned char* base = ws + WS_GAB + (u.pn - 4) * BM;
#pragma unroll
        for (int ai = 0; ai < 2; ++ai)
#pragma unroll
            for (int m = 0; m < 4; ++m) { unsigned char* rowp = base + (size_t)(row0 + ai * HALF + m * 16) * 4096 + cw;
#pragma unroll
                for (int bj = 0; bj < 2; ++bj) { u32x2 w; w.x = q8x4(sig4(acc[ai][bj][m][0])); w.y = q8x4(sig4(acc[ai][bj][m][1])); *(u32x2*)(rowp + bj * HALF) = w; } }
        }
        { SidePair sp; side_load(*P, gw, NGW, UI0 + u.ui, (fq << 4) | fr, sp); side_store((fq << 4) | fr, sp); }
    }
};

template <int PASS> struct EpiMerge {
    static constexpr bool PERM = true;
    unsigned char* ws;
    __device__ __forceinline__ void operator()(AccRef acc, const Unit& u, int wr, int wc, int fr, int fq) const {
        asm volatile("" : "+v"(fr), "+v"(fq));
        const int row0 = u.pm * BM + wr * 64 + fr, c0 = u.pn * BM + wc * 32 + 8 * fq;
        const unsigned char* G = ws + WS_GAB + PASS * DM; bf16* MG = (bf16*)(ws + WS_MERGED);
#pragma unroll
        for (int ai = 0; ai < 2; ++ai)
#pragma unroll
            for (int m = 0; m < 4; ++m) { const size_t row = (size_t)(row0 + ai * HALF + m * 16);
#pragma unroll
                for (int bj = 0; bj < 2; ++bj) { const u32x2 gv = *(const u32x2*)(G + row * 4096 + c0 + bj * HALF);
                    f32x4 v0 = acc[ai][bj][m][0] * dq8x4(gv.x), v1 = acc[ai][bj][m][1] * dq8x4(gv.y);
                    if (PASS == 1) { const u32x4 tv = *(const u32x4*)(MG + row * DM + c0 + bj * HALF); v0 += bflo4(tv); v1 += bfhi4(tv); }
                    *(u32x4*)(MG + row * DM + c0 + bj * HALF) = pack8(v0, v1); } }
    }
};
struct EpiX1 {
    static constexpr bool PERM = true;
    const bf16* XB; const float* RS; bf16* XRB; unsigned char* X8;
    __device__ __forceinline__ void operator()(AccRef acc, const Unit& u, int wr, int wc, int fr, int fq) const {
        asm volatile("" : "+v"(fr), "+v"(fq));
        const int row0 = u.pm * BM + wr * 64 + fr, c0 = u.pn * BM + wc * 32 + 8 * fq;
#pragma unroll
        for (int ai = 0; ai < 2; ++ai)
#pragma unroll
            for (int m = 0; m < 4; ++m) { const int row = row0 + ai * HALF + m * 16; const size_t off = (size_t)row * DM + c0; const float ri = 1.0f / RS[row];
#pragma unroll
                for (int bj = 0; bj < 2; ++bj) { const u32x4 xv = *(const u32x4*)(XB + off + bj * HALF);
                    const f32x4 v0 = bflo4(xv) * ri + acc[ai][bj][m][0], v1 = bfhi4(xv) * ri + acc[ai][bj][m][1];
                    *(u32x4*)(XRB + off + bj * HALF) = pack8(v0, v1); *(u32x2*)(X8 + off + bj * HALF) = pack8_fp8(v0, v1); }
                if (m == 3) asm volatile("" ::: "memory"); }
    }
};
struct EpiPlain {
    static constexpr bool PERM = true;
    bf16* O; int ldc;
    __device__ __forceinline__ void operator()(AccRef acc, const Unit& u, int wr, int wc, int fr, int fq) const {
        asm volatile("" : "+v"(fr), "+v"(fq));
        const int row0 = u.pm * BM + wr * 64 + fr, c0 = u.pn * BM + wc * 32 + 8 * fq;
#pragma unroll
        for (int ai = 0; ai < 2; ++ai)
#pragma unroll
            for (int m = 0; m < 4; ++m) { bf16* rowp = O + (size_t)(row0 + ai * HALF + m * 16) * ldc + c0;
#pragma unroll
                for (int bj = 0; bj < 2; ++bj) *(u32x4*)(rowp + bj * HALF) = pack8(acc[ai][bj][m][0], acc[ai][bj][m][1]); }
    }
};
struct EpiPle {
    static constexpr bool PERM = true;
    const bf16* XRB; bf16* X3B; const bf16* PP; const float* RS;
    __device__ __forceinline__ void operator()(AccRef acc, const Unit& u, int wr, int wc, int fr, int fq) const {
        asm volatile("" : "+v"(fr), "+v"(fq));
        const int row0 = u.pm * BM + wr * 64 + fr, c0 = u.pn * BM + wc * 32 + 8 * fq;
#pragma unroll
        for (int ai = 0; ai < 2; ++ai)
#pragma unroll
            for (int m = 0; m < 4; ++m) { const int row = row0 + ai * HALF + m * 16; const size_t off = (size_t)row * DM + c0; const float r = RS[row];
#pragma unroll
                for (int bj = 0; bj < 2; ++bj) { const u32x4 pv = *(const u32x4*)(PP + off + bj * HALF), xv = *(const u32x4*)(XRB + off + bj * HALF);
                    *(u32x4*)(X3B + off + bj * HALF) = pack8(bflo4(xv) + sig4(acc[ai][bj][m][0] * r) * bflo4(pv), bfhi4(xv) + sig4(acc[ai][bj][m][1] * r) * bfhi4(pv)); }
                if (m == 3) asm volatile("" ::: "memory"); }
    }
};

struct SegOrder {
    const LAS int* tab;
    int nN, G, c, seg_lo, seg_hi, K, down; const char* A; const char* Bt; const int* TOKL;
    int L0 = 0, Lmax = 0x7fffffff;
    __device__ __forceinline__ int rd(int i) const { return __builtin_amdgcn_readfirstlane(tab[i]); }
    __device__ bool next(int i, Unit& u) const {
        const int m_lo = rd(64 + seg_lo), m_hi = rd(64 + seg_hi);
        const long L = (long)L0 + (long)i * G + c; if (c < 0 || L >= Lmax || L >= (long)(m_hi - m_lo) * nN) return false;
        const int mtile = m_lo + (int)(L / nN); u.pn = (int)(L % nN);
        int s = u.seg > seg_lo ? u.seg : seg_lo; while (s + 1 < seg_hi && rd(64 + s + 1) <= mtile) ++s;
        u.seg = s; u.mt = mtile - rd(64 + s); u.pm = 0; const int left = rd(s) - u.mt * BM; u.nrow = left < BM ? left : BM; u.slot0 = rd(129 + s) + u.mt * BM;
        const int e = s & 31;
        if (down) { u.a = A + (size_t)u.slot0 * K * 2; u.b = Bt + ((size_t)e * DM + (size_t)u.pn * BM) * K * 2; }
        else { u.a = A; u.b = Bt + ((size_t)e * 2 * FF + (size_t)u.pn * BM) * K * 2; }
        return true;
    }
    __device__ __forceinline__ unsigned arow(const Unit& u, int r) const {
        if (down) return (unsigned)r;
        const int rr = r < u.nrow ? r : u.nrow - 1;
        return (unsigned)TOKL[(size_t)u.seg * T + u.mt * BM + rr];
    }
};
struct EpiGU {
    static constexpr bool PERM = true;
    unsigned char* ws;
    __device__ __forceinline__ void operator()(AccRef acc, const Unit& u, int wr, int wc, int fr, int fq) const {
        asm volatile("" : "+v"(fr), "+v"(fq));
        const float2* SC = (const float2*)(ws + WS_SC) + (size_t)u.seg * T + u.mt * BM;
        unsigned char* H = ws + WS_HACT + (size_t)u.slot0 * FF + u.pn * HALF + wc * 32 + 8 * fq;
        float2 sc[2][4];
#pragma unroll
        for (int ai = 0; ai < 2; ++ai)
#pragma unroll
            for (int m = 0; m < 4; ++m) { const int r = ai * HALF + wr * 64 + m * 16 + fr; sc[ai][m] = SC[r < u.nrow ? r : 0]; }
#pragma unroll
        for (int ai = 0; ai < 2; ++ai)
#pragma unroll
            for (int m = 0; m < 4; ++m) { const int r = ai * HALF + wr * 64 + m * 16 + fr; const bool live = r < u.nrow; const float s1 = sc[ai][m].x, s2 = sc[ai][m].y;
                f32x4 g0 = acc[ai][0][m][0] * s1, g1 = acc[ai][0][m][1] * s1; const f32x4 u0 = acc[ai][1][m][0] * s2, u1 = acc[ai][1][m][1] * s2;
                g0 = g0 * sig4(g0) * u0; g1 = g1 * sig4(g1) * u1;
                { const f32x4 lo4 = (f32x4){-448.f, -448.f, -448.f, -448.f}, hi4 = (f32x4){448.f, 448.f, 448.f, 448.f}; g0 = __builtin_elementwise_min(__builtin_elementwise_max(g0, lo4), hi4); g1 = __builtin_elementwise_min(__builtin_elementwise_max(g1, lo4), hi4); }
                if (live) *(u32x2*)(H + (size_t)r * FF) = pack8_fp8(g0, g1); }
    }
};
template <bool LAST> struct EpiDN {
    static constexpr bool PERM = true;
    unsigned char* ws;
    __device__ __forceinline__ void operator()(AccRef acc, const Unit& u, int wr, int wc, int fr, int fq) const {
        asm volatile("" : "+v"(fr), "+v"(fq));
        const int* TOKL = (const int*)(ws + WS_TOKL) + (size_t)u.seg * T + u.mt * BM; bf16* XRB = (bf16*)(ws + WS_X1B); unsigned char* X8 = ws + WS_X2F8;
        const int c0 = u.pn * BM + wc * 32 + 8 * fq;
        int tok[2][4]; u32x4 xv[2][4][2];
#pragma unroll
        for (int ai = 0; ai < 2; ++ai)
#pragma unroll
            for (int m = 0; m < 4; ++m) { const int r = ai * HALF + wr * 64 + m * 16 + fr; tok[ai][m] = TOKL[r < u.nrow ? r : 0]; }
#pragma unroll
        for (int ai = 0; ai < 2; ++ai)
#pragma unroll
            for (int m = 0; m < 4; ++m)
#pragma unroll
                for (int bj = 0; bj < 2; ++bj) xv[ai][m][bj] = *(const u32x4*)(XRB + (size_t)tok[ai][m] * DM + c0 + bj * HALF);
#pragma unroll
        for (int ai = 0; ai < 2; ++ai)
#pragma unroll
            for (int m = 0; m < 4; ++m) { const int r = ai * HALF + wr * 64 + m * 16 + fr; const bool live = r < u.nrow; const size_t off = (size_t)tok[ai][m] * DM + c0;
#pragma unroll
                for (int bj = 0; bj < 2; ++bj) { const f32x4 v0 = bflo4(xv[ai][m][bj]) + acc[ai][bj][m][0], v1 = bfhi4(xv[ai][m][bj]) + acc[ai][bj][m][1];
                    if (live) { *(u32x4*)(XRB + off + bj * HALF) = pack8(v0, v1); if (LAST) *(u32x2*)(X8 + off + bj * HALF) = pack8_fp8(v0, v1); } } }
    }
};
}
using pg8::bflo4; using pg8::bfhi4;

namespace fox {
typedef short s16x4 __attribute__((ext_vector_type(4)));
typedef float f32x16 __attribute__((ext_vector_type(16)));
constexpr int D = 128, LDQ = 1024, NW = 8, QBLK = 32, KVBLK = 64, QB = NW * QBLK;
constexpr float SCALE = 0.08838834764831845f, INVS = 11.313708498984761f, THR = 8.f;
constexpr int SHM_V = KVBLK * D * 2, SHM_K = KVBLK * D * 2;
constexpr int OFF_WS = 2 * SHM_V + 2 * SHM_K, OFF_B = OFF_WS + NW * 64 * 4, LDS_ATT = OFF_B + SEQ * 4;
#define KSWZ(row, colB) ((row) * 256 + ((colB) ^ (((row) & 7) << 4)))
#define SBAR() __builtin_amdgcn_sched_barrier(0)
__device__ __forceinline__ int v_st(int k, int c) { const int kk = (k & ~0xC) | ((k & 4) << 1) | ((k & 8) >> 1); return ((kk >> 3) * 4 + (c >> 5)) * 512 + ((kk & 7) * 32 + (c & 31)) * 2; }
__device__ __forceinline__ int v_rd_base(int lane) { return ((lane & 3) << 3) | (((lane >> 2) & 3) << 6) | (((lane >> 4) & 1) << 5) | (((lane >> 5) & 1) << 8); }
constexpr int v_rd_off(int d0, int ks, int half) { return d0 * 512 + ks * 4096 + half * 2048; }
__device__ __forceinline__ int crow(int r, int hi) { return (r & 3) + 8 * (r >> 2) + 4 * hi; }
__device__ __forceinline__ unsigned cvtpk(float lo, float hi) { return cvt_pk_bf16(lo, hi); }
__device__ __forceinline__ void mask_tile(f32x16& p0, f32x16& p1, int dq) {
    const float NEG = -__builtin_inff();
#pragma unroll
    for (int r = 0; r < 16; ++r) { const int c = (r & 3) + 8 * (r >> 2);
        if (dq - c < 0) p0[r] = NEG;
        if (dq - c - 32 < 0) p1[r] = NEG; }
}
__device__ __forceinline__ void partialSM(f32x16& p0, f32x16& p1, float& m_reg, float& mn, float& alpha) {
    float pmax = p0[0];
#pragma unroll
    for (int r = 1; r < 16; ++r) pmax = fmaxf(pmax, p0[r]);
#pragma unroll
    for (int r = 0; r < 16; ++r) pmax = fmaxf(pmax, p1[r]);
    { auto rr = __builtin_amdgcn_permlane32_swap(__float_as_uint(pmax), __float_as_uint(pmax), false, false);
      pmax = fmaxf(__uint_as_float(rr[0]), __uint_as_float(rr[1])); }
    constexpr float C2 = 1.4426950408889634f * SCALE;
    if (__builtin_expect(__all((pmax - m_reg) * SCALE <= THR), 1)) { mn = m_reg; alpha = 1.f; }
    else { mn = fmaxf(m_reg, pmax); alpha = __builtin_amdgcn_exp2f((m_reg - mn) * C2); m_reg = mn; }
    const float mnL = -mn * C2;
#pragma unroll
    for (int r = 0; r < 16; ++r) p0[r] = fmaf(p0[r], C2, mnL);
#pragma unroll
    for (int r = 0; r < 16; ++r) p1[r] = fmaf(p1[r], C2, mnL);
#pragma unroll
    for (int r = 0; r < 16; ++r) p0[r] = __builtin_amdgcn_exp2f(p0[r]);
}
__device__ __forceinline__ void finishSM(f32x16& p0, f32x16& p1, float alpha, float& l_reg, bf16x8& pa0, bf16x8& pa1, bf16x8& pa2, bf16x8& pa3) {
#pragma unroll
    for (int r = 0; r < 16; ++r) p1[r] = __builtin_amdgcn_exp2f(p1[r]);
    float ps = 0;
#pragma unroll
    for (int r = 0; r < 16; ++r) ps += p0[r];
#pragma unroll
    for (int r = 0; r < 16; ++r) ps += p1[r];
    { auto rr = __builtin_amdgcn_permlane32_swap(__float_as_uint(ps), __float_as_uint(ps), false, false);
      ps = __uint_as_float(rr[0]) + __uint_as_float(rr[1]); }
    l_reg = l_reg * alpha + ps;
#define PK4(P, B_, OUT) do { unsigned a0 = cvtpk(P[B_+0], P[B_+1]), a1 = cvtpk(P[B_+2], P[B_+3]);                          \
        unsigned b0 = cvtpk(P[B_+4], P[B_+5]), b1 = cvtpk(P[B_+6], P[B_+7]);                                             \
        auto r0 = __builtin_amdgcn_permlane32_swap(a0, b0, false, false); auto r1 = __builtin_amdgcn_permlane32_swap(a1, b1, false, false); \
        u32x4 w = {r0[0], r1[0], r0[1], r1[1]}; OUT = __builtin_bit_cast(bf16x8, w); } while (0)
    PK4(p0, 0, pa0); PK4(p0, 8, pa1); PK4(p1, 0, pa2); PK4(p1, 8, pa3);
#undef PK4
}
template <int KB>
__device__ __forceinline__ void qkt(f32x16& p0, f32x16& p1, const char* K_lds, const char* bias_t, int r32, int hi, const bf16x8* qr) {
    const f32x4* bl = (const f32x4*)(bias_t + hi * 16);
#pragma unroll
    for (int q = 0; q < 4; ++q) { const f32x4 b0 = bl[2 * q], b1 = bl[8 + 2 * q];
        p0[4 * q] = b0.x; p0[4 * q + 1] = b0.y; p0[4 * q + 2] = b0.z; p0[4 * q + 3] = b0.w;
        p1[4 * q] = b1.x; p1[4 * q + 1] = b1.y; p1[4 * q + 2] = b1.z; p1[4 * q + 3] = b1.w; }
    const char* kb[4];
#pragma unroll
    for (int dd = 0; dd < 4; ++dd) kb[dd] = K_lds + KB * SHM_K + KSWZ(r32, (dd * 16 + hi * 8) * 2);
#pragma unroll
    for (int d0 = 0; d0 < 8; ++d0) { const char* a = kb[d0 & 3] + (d0 >> 2) * 128;
        bf16x8 b0 = *reinterpret_cast<const bf16x8*>(a);
        bf16x8 b1 = *reinterpret_cast<const bf16x8*>(a + 32 * 256);
        p0 = __builtin_amdgcn_mfma_f32_32x32x16_bf16(b0, qr[d0], p0, 0, 0, 0);
        p1 = __builtin_amdgcn_mfma_f32_32x32x16_bf16(b1, qr[d0], p1, 0, 0, 0); }
}
template <int VB>
__device__ __forceinline__ void pv_tile(f32x16* o, int vb0, bf16x8 pa0, bf16x8 pa1, bf16x8 pa2, bf16x8 pa3) {
#define TRRD(dst, off) asm volatile("ds_read_b64_tr_b16 %0, %1 offset:%2" : "=&v"(dst) : "v"(vb0), "i"(off) : "memory")
#define PV_D0(d0) do { s16x4 l0, l1, l2, l3, h0, h1, h2, h3; constexpr int b_ = VB * SHM_V + v_rd_off(d0, 0, 0);   \
        TRRD(l0, b_); TRRD(h0, b_ + 2048); TRRD(l1, b_ + 4096); TRRD(h1, b_ + 6144); TRRD(l2, b_ + 8192); TRRD(h2, b_ + 10240); TRRD(l3, b_ + 12288); TRRD(h3, b_ + 14336); \
        asm volatile("s_waitcnt lgkmcnt(0)" ::: "memory"); SBAR();   \
        o[d0] = __builtin_amdgcn_mfma_f32_32x32x16_bf16(pa0, (bf16x8){l0[0], l0[1], l0[2], l0[3], h0[0], h0[1], h0[2], h0[3]}, o[d0], 0, 0, 0);   \
        o[d0] = __builtin_amdgcn_mfma_f32_32x32x16_bf16(pa1, (bf16x8){l1[0], l1[1], l1[2], l1[3], h1[0], h1[1], h1[2], h1[3]}, o[d0], 0, 0, 0);   \
        o[d0] = __builtin_amdgcn_mfma_f32_32x32x16_bf16(pa2, (bf16x8){l2[0], l2[1], l2[2], l2[3], h2[0], h2[1], h2[2], h2[3]}, o[d0], 0, 0, 0);   \
        o[d0] = __builtin_amdgcn_mfma_f32_32x32x16_bf16(pa3, (bf16x8){l3[0], l3[1], l3[2], l3[3], h3[0], h3[1], h3[2], h3[3]}, o[d0], 0, 0, 0); } while (0)
    PV_D0(0); PV_D0(1); PV_D0(2); PV_D0(3);
#undef PV_D0
#undef TRRD
}
struct BlockRef { const bf16* K; const float* C; int P0, jlo; float cref;
    __device__ __forceinline__ const bf16* Kp() const { return K; }
    __device__ __forceinline__ const bf16* Vp() const { return K + (WS_V - WS_K) / 2; }
    __device__ __forceinline__ const bf16* Qp() const { return K - (WS_K - WS_Q) / 2 + (size_t)P0 * LDQ; }
    __device__ __forceinline__ bf16* Op() const { return const_cast<bf16*>(Qp()); } };
struct Seam { bf16x8 qr[8]; bf16x8 st_v0, st_v1, st_k0, st_k1; };
__device__ __forceinline__ bf16x8 load8(const bf16* p) { return *reinterpret_cast<const bf16x8*>(p); }
#define ROW(p, k0, rr) ((p) + (size_t)((k0) + (rr)) * LDQ + sc)
#define VMW() asm volatile("s_waitcnt vmcnt(0)" ::: "memory")
#define VMWN(n) asm volatile("s_waitcnt vmcnt(%0)" :: "i"(n) : "memory")
#define SLOAD_H(Kp, Vp, k0) do { S.st_v0 = load8(ROW(Vp, k0, sr)); S.st_v1 = load8(ROW(Vp, k0, 32 + sr));              \
                         S.st_k0 = load8(ROW(Kp, k0, sr)); S.st_k1 = load8(ROW(Kp, k0, 32 + sr)); } while (0)
#define SWRITE_HK(bf) do { *(bf16x8*)(K_lds + (bf) * SHM_K + kws) = S.st_k0; *(bf16x8*)(K_lds + (bf) * SHM_K + kws + 32 * 256) = S.st_k1; } while (0)
#define SWRITE_HV(bf) do { *(bf16x8*)(V_lds + (bf) * SHM_V + vst0) = S.st_v0; *(bf16x8*)(V_lds + (bf) * SHM_V + vst1) = S.st_v1; } while (0)
#define SWRITE_H(bf) do { SWRITE_HV(bf); SWRITE_HK(bf); } while (0)
#define BIAS_FILL(ref_) do { int k_ = (int)threadIdx.x * 4; asm volatile("" : "+v"(k_)); const int kb_ = (ref_).jlo * KVBLK; for (; kb_ + k_ < (ref_).P0 + QB; k_ += NW * 64 * 4) *(f32x4*)(B_lds + k_ * 4) = ((ref_).cref - *(const f32x4*)((ref_).C + kb_ + k_)) * INVS; } while (0)
__device__ __forceinline__ void prime(const BlockRef& cur, char* lds, Seam& S) {
    const int tid = threadIdx.x, wid = __builtin_amdgcn_readfirstlane(tid >> 6), lane = tid & 63, r32 = lane & 31, hi = lane >> 5;
    const int sr = tid >> 4, sc = (tid & 15) * 8, kws = KSWZ(sr, sc * 2); char* K_lds = lds + 2 * SHM_V; char* B_lds = lds + OFF_B;
#pragma unroll
    for (int d0 = 0; d0 < 8; ++d0) S.qr[d0] = load8(cur.Qp() + (size_t)(wid * QBLK + r32) * LDQ + d0 * 16 + hi * 8);
    SLOAD_H(cur.Kp(), cur.Vp(), cur.jlo * KVBLK); BIAS_FILL(cur); VMW(); SWRITE_HK(0);
    __syncthreads();
}
__device__ __forceinline__ BlockRef ref(int k, unsigned char* ws, const char* lds);
__device__ __forceinline__ void block(const BlockRef& cur, BlockRef& nxt, bool& has_nxt, char* lds, Seam& S, unsigned* ctr, volatile int* slot, unsigned char* gws) {
    const int tid = threadIdx.x, wid = __builtin_amdgcn_readfirstlane(tid >> 6), lane = tid & 63, r32 = lane & 31, hi = lane >> 5;
    const int j_lo = cur.jlo, NT = (cur.P0 + QB) / KVBLK - j_lo;
    const int qlo = cur.P0 + wid * QBLK, qm = qlo + r32 - 4 * hi;
    char* V_lds = lds; char* K_lds = lds + 2 * SHM_V; char* B_lds = lds + OFF_B;
    float* ws = (float*)(lds + OFF_WS) + wid * 64; float* li_l = ws, * al_l = ws + 32;
    float m_reg = -1e30f, l_reg = 0; f32x16 o[4] = {};
    const int sr = tid >> 4, sc = (tid & 15) * 8, vst0 = v_st(sr, sc), vst1 = v_st(32 + sr, sc), kws = KSWZ(sr, sc * 2);
    const int vb0 = (int)(uintptr_t)V_lds + v_rd_base(lane);
    const bf16* Kh = cur.Kp(); const bf16* Vh = cur.Vp();
#define RESC(a) do { if (__any((a) < 1.f)) { if (hi == 0) al_l[r32] = (a); asm volatile("s_waitcnt lgkmcnt(0)" ::: "memory");              \
                     for (int d_ = 0; d_ < 4; ++d_) for (int r = 0; r < 16; ++r) o[d_][r] *= al_l[crow(r, hi)]; } } while (0)
#define KBASE(t) ((j_lo + (t)) * KVBLK)
#define MASKT(P0_, P1_, t) do { const int kb_ = KBASE(t); if (kb_ + KVBLK - 1 > qlo) mask_tile(P0_, P1_, qm - kb_); } while (0)
    constexpr int NQL = 8;
#define SEAM_K0() do { VMWN(NQL); SWRITE_HK(0); SBAR(); } while (0)
    f32x16 pA0, pA1, pB0, pB1; float mnA, mnB, alA, alB; bf16x8 pa0, pa1, pa2, pa3;
    SWRITE_HV(0); SBAR();
    SLOAD_H(Kh, Vh, KBASE(1));
    SBAR(); qkt<0>(pA0, pA1, K_lds, B_lds, r32, hi, S.qr);
    MASKT(pA0, pA1, 0); partialSM(pA0, pA1, m_reg, mnA, alA);
    VMW(); SWRITE_H(1);
    __syncthreads();
#define HALF_STEP(PX0, PX1, mnX, alX, PY0, PY1, alY, t, KB, VB, SB) do {                                                      \
        SBAR(); qkt<KB>(PX0, PX1, K_lds, B_lds + (t) * 256, r32, hi, S.qr);                                             \
        finishSM(PY0, PY1, alY, l_reg, pa0, pa1, pa2, pa3); SBAR();                                                           \
        if ((t) + 1 < NT) { SLOAD_H(Kh, Vh, KBASE((t) + 1)); SBAR(); }                                               \
        pv_tile<VB>(o, vb0, pa0, pa1, pa2, pa3); MASKT(PX0, PX1, (t)); partialSM(PX0, PX1, m_reg, mnX, alX);                                        \
        __syncthreads();                                                                                                      \
        if ((t) + 1 < NT) { VMW(); SWRITE_H(SB); }                                                                          \
        RESC(alX); __syncthreads(); } while (0)
    for (int t = 1; t + 1 < NT; t += 2) {
        unsigned tk = 0u; const bool claim = (t + 3 >= NT) && tid == 0;
        if (claim) tk = atomicAdd(ctr, 1u);
        HALF_STEP(pB0, pB1, mnB, alB, pA0, pA1, alA, t, 1, 0, 0);
        if (claim) slot[0] = (int)tk;
        HALF_STEP(pA0, pA1, mnA, alA, pB0, pB1, alB, t + 1, 0, 1, 1);
    }
    { const int kn = __builtin_amdgcn_readfirstlane(slot[0]); has_nxt = kn < BATCH * NH * 16; nxt = has_nxt ? ref(kn, gws, lds) : cur; }
    SBAR(); qkt<1>(pB0, pB1, K_lds, B_lds + (NT - 1) * 256, r32, hi, S.qr); SBAR();
    SLOAD_H(nxt.Kp(), nxt.Vp(), nxt.jlo * KVBLK); SBAR();
#pragma unroll
    for (int d0 = 0; d0 < 8; ++d0) S.qr[d0] = load8(nxt.Qp() + (size_t)(wid * QBLK + r32) * LDQ + d0 * 16 + hi * 8);
    SBAR();
    finishSM(pA0, pA1, alA, l_reg, pa0, pa1, pa2, pa3); SBAR();
    pv_tile<0>(o, vb0, pa0, pa1, pa2, pa3);
    MASKT(pB0, pB1, NT - 1); partialSM(pB0, pB1, m_reg, mnB, alB); __syncthreads(); RESC(alB);
    finishSM(pB0, pB1, alB, l_reg, pa0, pa1, pa2, pa3); SBAR(); pv_tile<1>(o, vb0, pa0, pa1, pa2, pa3);
    SBAR(); SEAM_K0();
    if (hi == 0) li_l[r32] = l_reg; asm volatile("s_waitcnt lgkmcnt(0)" ::: "memory");
    float rli[16];
#pragma unroll
    for (int r = 0; r < 16; ++r) rli[r] = __builtin_amdgcn_rcpf(li_l[crow(r, hi)]);
    bf16* Ow = cur.Op() + (size_t)(wid * QBLK) * LDQ;
#pragma unroll
    for (int r = 0; r < 16; ++r) { const int orow = crow(r, hi);
#pragma unroll
        for (int d0 = 0; d0 < 4; ++d0) { const float v = o[d0][r] * rli[r];
            const float vn = __shfl_xor(v, 1);
            if ((r32 & 1) == 0) *(unsigned*)(Ow + (size_t)orow * LDQ + d0 * 32 + r32) = cvtpk(v, vn); } }
    BIAS_FILL(nxt);
    __syncthreads();
#undef RESC
#undef KBASE
#undef MASKT
#undef SEAM_K0
#undef HALF_STEP
}
#undef ROW
#undef VMW
#undef VMWN
#undef SLOAD_H
#undef SWRITE_HK
#undef SWRITE_HV
#undef SWRITE_H
#undef BIAS_FILL
#undef KSWZ
#undef SBAR
constexpr int ORD_OFF = 86016, CJ_OFF = 88064, CNTS_OFF = 104448, TOT_OFF = 106496, SK_OFF = 108544;
__device__ __forceinline__ void build_order(char* lds, unsigned char* ws) {
    const int tid = threadIdx.x, lane = tid & 63, wid = tid >> 6;
    float* cj = (float*)(lds + CJ_OFF); int* cnt = (int*)(lds + CNTS_OFF); int* tot = (int*)(lds + TOT_OFF); unsigned short* ord = (unsigned short*)(lds + ORD_OFF);
    const float* CUM = (const float*)(ws + WS_CUM); float* sk = (float*)(lds + SK_OFF);
    const float* NQq = (const float*)(ws + WS_NQ); const float* NQk = NQq + 512 * NH * 4;
#pragma unroll
    for (int k = 0; k < 8; ++k) { const int idx = tid + 512 * k, bh_ = idx >> 6, j_ = idx & 63; cj[idx] = CUM[(size_t)bh_ * SEQ + 64 * j_ + 63];
        const f32x4 kp = *(const f32x4*)(NQk + ((size_t)((bh_ / NH) * 64 + j_) * NH + (bh_ % NH)) * 4); sk[idx] = sqrtf((kp.x + kp.y) + (kp.z + kp.w)); }
    cnt[tid] = 0;
    __syncthreads();
    int cls[2], rnk[2], jl[2];
#pragma unroll
    for (int p = 0; p < 2; ++p) {
        const int i = p * 512 + tid, bh = i >> 4, qb = i & 15;
        float q2 = 0.f, kd = 0.f;
#pragma unroll
        for (int g = 0; g < 4; ++g) { const f32x4 qp = *(const f32x4*)(NQq + ((size_t)((bh / NH) * 64 + 4 * qb + g) * NH + (bh % NH)) * 4); q2 = fmaxf(q2, (qp.x + qp.y) + (qp.z + qp.w)); kd = fmaxf(kd, sk[bh * 64 + 4 * qb + g]); }
        const float sq = sqrtf(q2) * SCALE;
        const float lim = CUM[(size_t)bh * SEQ + qb * QB] + sq * kd + 8.4f + 17.0f;
        int lo = 0;
        while (lo < 4 * qb && cj[bh * 64 + lo] >= lim + sq * sk[bh * 64 + lo]) ++lo;
        lo &= ~1;
        const int cl = ((4 * (qb + 1) - lo) >> 1) - 1;
        cls[p] = cl; rnk[p] = 0; jl[p] = lo >> 1;
        unsigned long long rem = __ballot(1);
        while (rem) {
            const int c0 = __builtin_amdgcn_readlane(cl, (int)__builtin_ctzll(rem));
            const unsigned long long m = __ballot(cl == c0);
            if (cl == c0) { rnk[p] = __builtin_popcountll(m & ((1ull << lane) - 1ull)); if ((m & ((1ull << lane) - 1ull)) == 0ull) cnt[(p * 8 + wid) * 32 + c0] = __builtin_popcountll(m); }
            rem &= ~m;
        }
    }
    __syncthreads();
    if (tid < 32) { int t = 0; for (int c = 0; c < 16; ++c) t += cnt[c * 32 + tid]; tot[tid] = t; }
    __syncthreads();
#pragma unroll
    for (int p = 0; p < 2; ++p) {
        const int ch = p * 8 + wid; int base = rnk[p];
        for (int c = cls[p] + 1; c < 32; ++c) base += tot[c];
        for (int c = 0; c < ch; ++c) base += cnt[c * 32 + cls[p]];
        ord[base] = (unsigned short)((p * 512 + tid) | (jl[p] << 10));
    }
    __syncthreads();
}
__device__ __forceinline__ BlockRef ref(int k, unsigned char* ws, const char* lds) {
    const int e = __builtin_amdgcn_readfirstlane((int)((const unsigned short*)(lds + ORD_OFF))[k]);
    const int i = e & 1023, bh = i >> 4, qb = i & 15, b = bh / NH, h = bh % NH;
    BlockRef r; r.K = (const bf16*)(ws + WS_K) + (size_t)b * SEQ * LDQ + h * D; r.C = (const float*)(ws + WS_CUM) + (size_t)bh * SEQ; r.P0 = qb * QB; r.cref = r.C[r.P0];
    r.jlo = (e >> 10) * 2;
    return r;
}
__device__ __forceinline__ void attn_phase(char* lds, unsigned char* ws, volatile int* slot) {
    constexpr int TOTAL = BATCH * NH * 16;
    unsigned* ctr = (unsigned*)(ws + WS_CTL) + CW_ATT;
    build_order(lds, ws);
    if (threadIdx.x == 0) slot[0] = (int)atomicAdd(ctr, 1u);
    __syncthreads();
    const int i0 = __builtin_amdgcn_readfirstlane(slot[0]);
    __syncthreads();
    if (i0 >= TOTAL) return;
    BlockRef cur = ref(i0, ws, lds), nxt = cur; bool has_nxt = false;
    Seam S;
    prime(cur, lds, S);
    for (;;) {
        block(cur, nxt, has_nxt, lds, S, ctr, slot, ws);
        if (!has_nxt) break;
        cur = nxt;
    }
}
}
__device__ __forceinline__ int tid_now() { int t = (int)threadIdx.x; asm volatile("" : "+v"(t)); return t; }
struct Frame {
    LAS unsigned char* lds; volatile LAS unsigned* MISC; unsigned* ctl;
    int tid, lane, wave, vcu, G;
};

__device__ __forceinline__ void xitem_load(const XItem& it, int lane, f32x4 (&v)[8]) {
    const int nq = lane & 7, ko = lane >> 3; const float* s = it.src + (size_t)(8 * ko) * it.ldw + 4 * nq;
#pragma unroll
    for (int j = 0; j < 8; ++j) v[j] = *(const f32x4*)(s + (size_t)j * it.ldw);
}
__device__ __forceinline__ void xitem_store(const XItem& it, int lane, const f32x4 (&v)[8]) {
    const int nq = lane & 7, ko = lane >> 3;
    f32x4 g0 = (f32x4){1.f, 1.f, 1.f, 1.f}, g1 = g0;
    if (it.gain) { g0 = *(const f32x4*)(it.gain + 8 * ko); g1 = *(const f32x4*)(it.gain + 8 * ko + 4); }
    if (it.fp8) { g0 *= 64.0f; g1 *= 64.0f; }
    if (it.fp8) { unsigned char* d = it.dst + (size_t)(4 * nq) * it.K + 8 * ko;
#pragma unroll
        for (int e = 0; e < 4; ++e) *(u32x2*)(d + (size_t)e * it.K) = pack8_fp8((f32x4){v[0][e] * g0.x, v[1][e] * g0.y, v[2][e] * g0.z, v[3][e] * g0.w}, (f32x4){v[4][e] * g1.x, v[5][e] * g1.y, v[6][e] * g1.z, v[7][e] * g1.w});
    } else { bf16* d = (bf16*)it.dst + (size_t)(4 * nq) * it.K + 8 * ko;
#pragma unroll
        for (int e = 0; e < 4; ++e) { u32x4 o; o.x = pk2(v[0][e] * g0.x, v[1][e] * g0.y); o.y = pk2(v[2][e] * g0.z, v[3][e] * g0.w); o.z = pk2(v[4][e] * g1.x, v[5][e] * g1.y); o.w = pk2(v[6][e] * g1.z, v[7][e] * g1.w);
            *(u32x4*)(d + (size_t)e * it.K) = o; } }
}
__device__ __forceinline__ int win_src_col(int n0) {
    if (n0 < 3072) return C_Q + n0;
    if (n0 < 5120) { const int j = (n0 - 3072) >> 8, w = (n0 - 3072) & 255; return w < 128 ? C_U + 128 * j + w : C_CG + 128 * j + (w - 128); }
    if (n0 < 6144) return C_BG + (n0 - 5120);
    return C_GA + (n0 - 6144);
}
constexpr int XI_IN = 32 * 320, XI_SIDE = 16 * 64 + 16 * 64 + 32 * 64 + 32 * 64 + 4 * 64 + 32 * 32 * 32 + 32 * 8 * 64;
__device__ __forceinline__ XItem xitem_of(const Params& P, int r) {
    unsigned char* ws = P.ws;
    constexpr int I_A = 16 * 64, I_B = 16 * 64, I_OUT = 32 * 64, I_PG = 32 * 64, I_PE = 4 * 64, I_GU = 32 * 32 * 32;
    XItem it; it.fp8 = 0; it.gain = nullptr;
    if (r < XI_IN) { const int kb = r / 320, g = r % 320; it.src = P.w_in + (size_t)(64 * kb) * IN_COLS + win_src_col(32 * g); it.ldw = IN_COLS; it.gain = P.g_mix + 64 * kb; it.K = DM; const int n0 = 32 * g;
        if (n0 >= 2048 && n0 < 3072) { it.fp8 = 1; it.dst = ws + WS_WT_IN8 + (size_t)(n0 - 2048) * DM + 64 * kb; }
        else if (n0 >= 6144) { it.fp8 = 1; it.dst = ws + WS_WT_IN8 + (size_t)(1024 + n0 - 6144) * DM + 64 * kb; }
        else it.dst = ws + WS_WT_IN + ((size_t)(n0 < 2048 ? n0 : n0 - 1024) * DM + 64 * kb) * 2;
        return it; } r -= XI_IN;
    if (r < I_A) { const int kb = r / 64, g = r % 64; it.src = P.w_a + (size_t)(64 * kb) * DM + 32 * g; it.ldw = DM; it.K = FW; it.dst = ws + WS_WT_A + ((size_t)(32 * g) * FW + 64 * kb) * 2; return it; } r -= I_A;
    if (r < I_B) { const int kb = r / 64, g = r % 64; it.src = P.w_b + (size_t)(64 * kb) * DM + 32 * g; it.ldw = DM; it.K = CW; it.dst = ws + WS_WT_B + ((size_t)(32 * g) * CW + 64 * kb) * 2; return it; } r -= I_B;
    if (r < I_OUT) { const int kb = r / 64, g = r % 64; it.src = P.w_out + (size_t)(64 * kb) * DM + 32 * g; it.ldw = DM; it.K = DM; it.dst = ws + WS_WT_OUT + ((size_t)(32 * g) * DM + 64 * kb) * 2; return it; } r -= I_OUT;
    if (r < I_PG) { const int kb = r / 64, g = r % 64; it.src = P.w_pg + (size_t)(64 * kb) * DM + 32 * g; it.ldw = DM; it.gain = P.g_ple + 64 * kb; it.K = DM; it.fp8 = 1; it.dst = ws + WS_WT_PG + (size_t)(32 * g) * DM + 64 * kb; return it; } r -= I_PG;
    if (r < I_PE) { const int kb = r / 64, g = r % 64; it.src = P.w_pe + (size_t)(64 * kb) * DM + 32 * g; it.ldw = DM; it.K = PLE; it.dst = ws + WS_WT_PE + ((size_t)(32 * g) * PLE + 64 * kb) * 2; return it; } r -= I_PE;
    if (r < I_GU) { const int e = r / 1024, kb = (r % 1024) / 32, g = r % 32, n0 = 32 * g, j = n0 >> 8, w = n0 & 255; const int sc = w < 128 ? 128 * j + w : FF + 128 * j + (w - 128);
        it.src = P.w_gu + (size_t)e * DM * 2 * FF + (size_t)(64 * kb) * (2 * FF) + sc; it.ldw = 2 * FF; it.gain = P.g_ffn + 64 * kb; it.K = DM; it.fp8 = 1; it.dst = ws + WS_WT_GU + (size_t)e * 2 * FF * DM + (size_t)n0 * DM + 64 * kb; return it; } r -= I_GU;
    { const int e = r / 512, kb = (r % 512) / 64, g = r % 64; it.src = P.w_dn + (size_t)e * FF * DM + (size_t)(64 * kb) * DM + 32 * g; it.ldw = DM; it.K = FF; it.fp8 = 1; it.dst = ws + WS_WT_DN + (size_t)e * DM * FF + (size_t)(32 * g) * FF + 64 * kb; return it; }
}
__device__ __forceinline__ void xitem_pair(const Params& P, int r0, int r1, int lane) {
    const XItem a = xitem_of(P, r0); const XItem b = xitem_of(P, r1 >= 0 ? r1 : r0);
    f32x4 va[8], vb[8];
    xitem_load(a, lane, va); xitem_load(b, lane, vb);
    xitem_store(a, lane, va); if (r1 >= 0) xitem_store(b, lane, vb);
}
__device__ __forceinline__ void p0_weights(const Params& P, const Frame& F) {
    const int lane = tid_now() & 63;
    const int gw = F.vcu * NWAVES + F.wave, NGW = F.G * NWAVES;
    for (int r = gw; r < XI_IN; r += 2 * NGW) xitem_pair(P, r, r + NGW < XI_IN ? r + NGW : -1, lane);
}
__device__ __forceinline__ void side_load(const Params& P, int gw, int NGW, int k, int lane, SidePair& sp) {
    const int r0 = gw + 2 * k * NGW, r1 = r0 + NGW; sp.n = r0 < XI_SIDE ? (r1 < XI_SIDE ? 2 : 1) : 0;
    if (sp.n > 0) { sp.a = xitem_of(P, XI_IN + r0); sp.b = xitem_of(P, XI_IN + (sp.n > 1 ? r1 : r0)); xitem_load(sp.a, lane, sp.va); xitem_load(sp.b, lane, sp.vb); }
}
__device__ __forceinline__ void side_store(int lane, const SidePair& sp) {
    if (sp.n > 0) xitem_store(sp.a, lane, sp.va);
    if (sp.n > 1) xitem_store(sp.b, lane, sp.vb);
}
__device__ __forceinline__ void p0_rowstats(const Params& P, const Frame& F) {
    unsigned char* ws = P.ws; float* rstd1 = (float*)(ws + WS_RSTD1); float* logf = (float*)(ws + WS_LOGF); bf16* XB = (bf16*)(ws + WS_XB);
    const int tid = tid_now(), lane = tid & 63;
    LAS f32x4* wfA = (LAS f32x4*)(F.lds + RING_OFF); LAS f32x4* wfB = wfA + DM;
    for (int k = tid; k < DM; k += NWAVES * 64) { const f32x4* w = (const f32x4*)(P.w_in + (size_t)k * IN_COLS + C_F); const float g = P.g_mix[k];
        const int s = (((k >> 8) * 4 + (k & 3)) << 6) + ((k >> 2) & 63); wfA[s] = w[0] * g; wfB[s] = w[1] * g; }
    __syncthreads();
    const int gw = F.vcu * NWAVES + F.wave, ngw = F.G * NWAVES;
    f32x4 nv[8];
    if (gw < T) { const f32x4* xr = (const f32x4*)(P.x + (size_t)gw * DM) + lane;
#pragma unroll
        for (int j = 0; j < 8; ++j) nv[j] = xr[64 * j]; }
    for (int t = gw; t < T; t += ngw) {
        f32x4 v[8]; float ss = 0.f;
#pragma unroll
        for (int j = 0; j < 8; ++j) v[j] = nv[j];
        if (t + ngw < T) { const f32x4* xr = (const f32x4*)(P.x + (size_t)(t + ngw) * DM) + lane;
#pragma unroll
            for (int j = 0; j < 8; ++j) nv[j] = xr[64 * j]; }
#pragma unroll
        for (int j = 0; j < 8; ++j) ss += (v[j].x * v[j].x + v[j].y * v[j].y) + (v[j].z * v[j].z + v[j].w * v[j].w);
        ss = wave_sum(ss);
        const float rstd = 1.0f / sqrtf(ss * (1.0f / DM) + EPS);
        u32x2* xo = (u32x2*)(XB + (size_t)t * DM) + lane;
#pragma unroll
        for (int j = 0; j < 8; ++j) { u32x2 w; w.x = pk2(v[j].x * rstd, v[j].y * rstd); w.y = pk2(v[j].z * rstd, v[j].w * rstd); xo[64 * j] = w; }
        { unsigned* x8 = (unsigned*)(ws + WS_XB8 + (size_t)t * DM) + lane; const float r8 = rstd * 8.0f;
#pragma unroll
          for (int j = 0; j < 8; ++j) { int q = __builtin_amdgcn_cvt_pk_fp8_f32(v[j].x * r8, v[j].y * r8, 0, false); q = __builtin_amdgcn_cvt_pk_fp8_f32(v[j].z * r8, v[j].w * r8, q, true); x8[64 * j] = (unsigned)q; } }
        f32x4 fa = (f32x4){0.f, 0.f, 0.f, 0.f}, fb = fa;
        int lo = lane; asm volatile("" : "+v"(lo));
#pragma unroll
        for (int j = 0; j < 8; ++j)
#pragma unroll
            for (int e = 0; e < 4; ++e) { const int s = ((j * 4 + e) << 6) + lo; fa += wfA[s] * v[j][e]; fb += wfB[s] * v[j][e]; }
        float r;
        { const bool b0 = lane & 1, b1 = lane & 2, b2 = lane & 4;
          const f32x4 keep = b0 ? fb : fa, send = b0 ? fa : fb;
          const float g0 = keep.x + __shfl_xor(send.x, 1), g1 = keep.y + __shfl_xor(send.y, 1), g2 = keep.z + __shfl_xor(send.z, 1), g3 = keep.w + __shfl_xor(send.w, 1);
          const float h0 = (b1 ? g2 : g0) + __shfl_xor(b1 ? g0 : g2, 2), h1 = (b1 ? g3 : g1) + __shfl_xor(b1 ? g1 : g3, 2);
          r = (b2 ? h1 : h0) + __shfl_xor(b2 ? h0 : h1, 4);
          r += __shfl_xor(r, 8); r += __shfl_xor(r, 16); r += __shfl_xor(r, 32); }
        if (lane < 8) { const int o = ((lane & 1) << 2) | (lane & 2) | ((lane >> 2) & 1);
            const float a = r * rstd + P.b_f[o]; logf[(size_t)t * 8 + o] = fminf(a, 0.f) - log1pf(__expf(-fabsf(a)));
            if (lane == 0) rstd1[t] = rstd; }
    }
    __syncthreads();
}
__device__ __forceinline__ void p0_pcast(const Params& P, const Frame& F) {
    const long gt = (long)F.vcu * (NWAVES * 64) + tid_now(), ngt = (long)F.G * NWAVES * 64;
    bf16* PB = (bf16*)(P.ws + WS_PB);
    for (long i = gt; i < (long)T * PLE / 8; i += ngt) { const f32x4 a = *(const f32x4*)(P.p + i * 8), b = *(const f32x4*)(P.p + i * 8 + 4);
        u32x4 o; o.x = pk2(a.x, a.y); o.y = pk2(a.z, a.w); o.z = pk2(b.x, b.y); o.w = pk2(b.z, b.w); *(u32x4*)(PB + i * 8) = o; }
}


__device__ __forceinline__ void p0_router_weights(const Params& P, const Frame& F) {
    const int gt = F.vcu * (NWAVES * 64) + tid_now(), ngt = F.G * NWAVES * 64;
    bf16* WRH = (bf16*)(P.ws + WS_WRH); bf16* WRL = (bf16*)(P.ws + WS_WRL);
    for (int i = gt; i < 48 * DM; i += ngt) { const int n = i / DM, k = i % DM;
        float v = 0.f; if (n < NE) v = P.w_re[(size_t)k * NE + n]; else if (n < NE + NGRP) v = P.w_rg[(size_t)k * NGRP + (n - NE)];
        v *= P.g_ffn[k]; const unsigned h = f2bf(v); const float lo = v - bf2f((unsigned short)h);
        WRH[i] = (bf16)h; WRL[i] = (bf16)f2bf(lo); }
}
__device__ __forceinline__ void router_mfma(const Params& P, const Frame& F) {
    unsigned char* ws = P.ws; const int tid = tid_now(), lane = tid & 63, r16 = lane & 15, kq = lane >> 4;
    const int gw = F.vcu * NWAVES + F.wave, NGW = F.G * NWAVES;
    const bf16* WRH = (const bf16*)(ws + WS_WRH); const bf16* WRL = (const bf16*)(ws + WS_WRL);
    int* EID = (int*)(ws + WS_EID); float* WTS = (float*)(ws + WS_WTS); int* POS = (int*)(ws + WS_POS); int* TOKL = (int*)(ws + WS_TOKL); float* RSTD2 = (float*)(ws + WS_RSTD2);
    unsigned* CNT = F.ctl + CW_CNT;
    LAS float* L = (LAS float*)(F.lds + RING_OFF + F.wave * 8192);
    LAS int* lcnt = (LAS int*)(F.lds + RING_OFF + 65536); LAS int* gbase = lcnt + 64;
    (void)gw; (void)NGW;
    for (int task0 = F.vcu * 4; task0 < T / 32; task0 += F.G * 4) {
        const int task = task0 + F.wave; const bool active = F.wave < 4;
        if (tid < 64) lcnt[tid] = 0;
        __syncthreads();
        int t = 0, s0 = 0, s1 = 0, lp0 = 0, lp1 = 0; float rstd = 0.f, wa = 0.f, wb = 0.f;
        if (active) {
        const bf16* xr = (const bf16*)(ws + WS_X1B) + (size_t)(task * 32 + r16) * DM + 8 * kq;
        const bf16* wh = WRH + (size_t)r16 * DM + 8 * kq; const bf16* wl = WRL + (size_t)r16 * DM + 8 * kq;
        f32x4 acc[2][3]; float ss0 = 0.f, ss1 = 0.f;
#pragma unroll
        for (int g = 0; g < 2; ++g)
#pragma unroll
            for (int nb = 0; nb < 3; ++nb) acc[g][nb] = (f32x4){0.f, 0.f, 0.f, 0.f};
#pragma unroll 1
        for (int ks0 = 0; ks0 < DM / 32; ks0 += 4) {
            u32x4 xa[4][2]; bf16x8 bh[4][3], bl[4][3];
#pragma unroll
            for (int j = 0; j < 4; ++j) { xa[j][0] = *(const u32x4*)(xr + (ks0 + j) * 32); xa[j][1] = *(const u32x4*)(xr + (size_t)16 * DM + (ks0 + j) * 32);
#pragma unroll
                for (int nb = 0; nb < 3; ++nb) { bh[j][nb] = *(const bf16x8*)(wh + (size_t)nb * 16 * DM + (ks0 + j) * 32); bl[j][nb] = *(const bf16x8*)(wl + (size_t)nb * 16 * DM + (ks0 + j) * 32); } }
#pragma unroll
            for (int j = 0; j < 4; ++j) {
                { const f32x4 a0 = bflo4(xa[j][0]), a1 = bfhi4(xa[j][0]); ss0 += (a0.x * a0.x + a0.y * a0.y) + (a0.z * a0.z + a0.w * a0.w) + (a1.x * a1.x + a1.y * a1.y) + (a1.z * a1.z + a1.w * a1.w); }
                { const f32x4 a0 = bflo4(xa[j][1]), a1 = bfhi4(xa[j][1]); ss1 += (a0.x * a0.x + a0.y * a0.y) + (a0.z * a0.z + a0.w * a0.w) + (a1.x * a1.x + a1.y * a1.y) + (a1.z * a1.z + a1.w * a1.w); }
#pragma unroll
                for (int g = 0; g < 2; ++g) { const bf16x8 ah = __builtin_bit_cast(bf16x8, xa[j][g]);
#pragma unroll
                    for (int nb = 0; nb < 3; ++nb) { acc[g][nb] = __builtin_amdgcn_mfma_f32_16x16x32_bf16(ah, bh[j][nb], acc[g][nb], 0, 0, 0); acc[g][nb] = __builtin_amdgcn_mfma_f32_16x16x32_bf16(ah, bl[j][nb], acc[g][nb], 0, 0, 0); } }
            }
        }
        ss0 += __shfl_xor(ss0, 16); ss0 += __shfl_xor(ss0, 32); ss1 += __shfl_xor(ss1, 16); ss1 += __shfl_xor(ss1, 32);
#pragma unroll
        for (int g = 0; g < 2; ++g)
#pragma unroll
            for (int nb = 0; nb < 3; ++nb)
#pragma unroll
                for (int j = 0; j < 4; ++j) L[(16 * g + 4 * kq + j) * 48 + nb * 16 + r16] = acc[g][nb][j];
        asm volatile("s_waitcnt lgkmcnt(0)" ::: "memory");
        const float ss = (lane & 16) ? ss1 : ss0;
        if (lane < 32) {
            t = task * 32 + lane; const LAS float* lg = L + lane * 48;
            rstd = 1.0f / sqrtf(ss * (1.0f / DM) + EPS);
            float gl[4];
#pragma unroll
            for (int i = 0; i < 4; ++i) gl[i] = lg[32 + i] * rstd + P.b_rg[i];
            int grp = 0; float gm = gl[0];
#pragma unroll
            for (int i = 1; i < 4; ++i) if (gl[i] > gm) { gm = gl[i]; grp = i; }
            float gsum = 0.f;
#pragma unroll
            for (int i = 0; i < 4; ++i) gsum += __expf(gl[i] - gm);
            const float p_grp = 1.0f / gsum;
            float es[8];
#pragma unroll
            for (int i = 0; i < 8; ++i) es[i] = lg[grp * 8 + i] * rstd + P.b_re[grp * 8 + i];
            int i1 = 0; float l1 = es[0];
#pragma unroll
            for (int i = 1; i < 8; ++i) if (es[i] > l1) { l1 = es[i]; i1 = i; }
            int i2 = -1; float l2 = -3.0e38f;
#pragma unroll
            for (int i = 0; i < 8; ++i) if (i != i1 && es[i] > l2) { l2 = es[i]; i2 = i; }
            const float w1 = 1.0f / (1.0f + __expf(l2 - l1)), w2 = 1.0f - w1;
            s0 = grp * EPG + i1; s1 = NE + grp * EPG + i2; wa = p_grp * w1; wb = p_grp * w2;
            lp0 = __hip_atomic_fetch_add(lcnt + s0, 1, __ATOMIC_RELAXED, __HIP_MEMORY_SCOPE_WORKGROUP); lp1 = __hip_atomic_fetch_add(lcnt + s1, 1, __ATOMIC_RELAXED, __HIP_MEMORY_SCOPE_WORKGROUP);
        }
        }
        __syncthreads();
        if (tid < 64) { const int c = lcnt[tid]; gbase[tid] = c > 0 ? (int)atomicAdd(&CNT[tid * CNT_STRIDE], (unsigned)c) : 0; }
        __syncthreads();
        if (active && lane < 32) {
            const int p0 = gbase[s0] + lp0, p1 = gbase[s1] + lp1;
            RSTD2[t] = rstd; EID[2 * t] = s0; EID[2 * t + 1] = s1 - NE; WTS[2 * t] = wa; WTS[2 * t + 1] = wb; POS[2 * t] = p0; POS[2 * t + 1] = p1;
            TOKL[(size_t)s0 * T + p0] = t; TOKL[(size_t)s1 * T + p1] = t;
            float2* SC = (float2*)(ws + WS_SC); SC[(size_t)s0 * T + p0] = make_float2(rstd, rstd * wa * 8.0f); SC[(size_t)s1 * T + p1] = make_float2(rstd, rstd * wb * 8.0f);
        }
        __syncthreads();
    }
}

__device__ __forceinline__ void thin_rstd_bf16(const bf16* X, float* RSTD, int gw, int ngw, int lane) {
    for (int t = gw; t < T; t += ngw) { const u32x4* xr = (const u32x4*)(X + (size_t)t * DM) + lane; float ss = 0.f;
#pragma unroll
        for (int j = 0; j < 4; ++j) { const u32x4 w = xr[64 * j]; const f32x4 a = bflo4(w), b = bfhi4(w); ss += (a.x * a.x + a.y * a.y) + (a.z * a.z + a.w * a.w) + (b.x * b.x + b.y * b.y) + (b.z * b.z + b.w * b.w); }
        ss = wave_sum(ss);
        if (lane == 0) RSTD[t] = 1.0f / sqrtf(ss * (1.0f / DM) + EPS); }
}
__device__ __forceinline__ void thin_rstd_fp8(const unsigned char* X, float* RSTD, int gw, int ngw, int lane) {
    for (int t = gw; t < T; t += 4 * ngw) {
        u32x4 w[4][2];
#pragma unroll
        for (int r = 0; r < 4; ++r) { const u32x4* xr = (const u32x4*)(X + (size_t)(t + r * ngw) * DM) + lane; w[r][0] = xr[0]; w[r][1] = xr[64]; }
#pragma unroll
        for (int r = 0; r < 4; ++r) { float ss = 0.f;
#pragma unroll
            for (int j = 0; j < 2; ++j)
#pragma unroll
                for (int q = 0; q < 4; ++q) { const auto a = __builtin_amdgcn_cvt_pk_f32_fp8((int)w[r][j][q], false), b = __builtin_amdgcn_cvt_pk_f32_fp8((int)w[r][j][q], true); ss += (a[0] * a[0] + a[1] * a[1]) + (b[0] * b[0] + b[1] * b[1]); }
            ss = wave_sum(ss);
            if (lane == 0) RSTD[t + r * ngw] = 1.0f / sqrtf(ss * (1.0f / DM) + EPS); } }
}
__device__ __forceinline__ void thin_final_bf16(const Params& P, const bf16* X, int gw, int ngw, int lane) {
    u32x4 nw[2][4];
#pragma unroll
    for (int r = 0; r < 2; ++r) { const u32x4* xr = (const u32x4*)(X + (size_t)(gw + r * ngw) * DM) + lane;
#pragma unroll
        for (int j = 0; j < 4; ++j) nw[r][j] = xr[64 * j]; }
    for (int t = gw; t < T; t += 2 * ngw) { u32x4 w[2][4];
#pragma unroll
        for (int r = 0; r < 2; ++r)
#pragma unroll
            for (int j = 0; j < 4; ++j) w[r][j] = nw[r][j];
        if (t + 2 * ngw < T) {
#pragma unroll
            for (int r = 0; r < 2; ++r) { const u32x4* xr = (const u32x4*)(X + (size_t)(t + (2 + r) * ngw) * DM) + lane;
#pragma unroll
                for (int j = 0; j < 4; ++j) nw[r][j] = xr[64 * j]; } }
#pragma unroll
        for (int r = 0; r < 2; ++r) { float ss = 0.f;
#pragma unroll
            for (int j = 0; j < 4; ++j) { const f32x4 a = bflo4(w[r][j]), b = bfhi4(w[r][j]); ss += (a.x * a.x + a.y * a.y) + (a.z * a.z + a.w * a.w) + (b.x * b.x + b.y * b.y) + (b.z * b.z + b.w * b.w); }
            ss = wave_sum(ss);
            const float rstd = 1.0f / sqrtf(ss * (1.0f / DM) + EPS);
            f32x4* o = (f32x4*)(P.out + (size_t)(t + r * ngw) * DM); const f32x4* g = (const f32x4*)P.g_final;
#pragma unroll
            for (int j = 0; j < 4; ++j) { const int c = 2 * (lane + 64 * j); o[c] = bflo4(w[r][j]) * rstd * g[c]; o[c + 1] = bfhi4(w[r][j]) * rstd * g[c + 1]; } } }
}

struct MegaArgs { Params P; int ph_lo, ph_hi; };
constexpr int NPHASE = 12;
__global__ void __launch_bounds__(NWAVES * 64, 2) mega_fwd(MegaArgs args) {
    extern __shared__ __attribute__((aligned(16))) unsigned char lds_raw[];
    const Params& P = args.P;
    Frame F;
    F.lds = (LAS unsigned char*)lds_raw;
    F.MISC = (volatile LAS unsigned*)(F.lds + MISC_OFF);
    F.tid = threadIdx.x; F.lane = F.tid & 63; F.wave = __builtin_amdgcn_readfirstlane(F.tid >> 6);
    F.G = gridDim.x; { const int bx = blockIdx.x; F.vcu = (F.G % 8 == 0) ? (bx % 8) * (F.G / 8) + bx / 8 : bx; }
    F.ctl = (unsigned*)(P.ws + WS_CTL);
    for (int u = F.tid; u < (LDS_BYTES - LDSCTL_OFF) / 4; u += NWAVES * 64) ((LAS unsigned*)(F.lds + LDSCTL_OFF))[u] = 0u;
    __syncthreads();
    const int lo = args.ph_lo, hi = args.ph_hi;
    XcdBarrier bar; bar.bar = F.ctl + CW_BAR; bar.x = 0; bar.st = nullptr;
    if (hi - lo > 1) bar = xcd_barrier_post(F.ctl + CW_BAR, F.MISC + 8);
#define IN(k) (lo <= (k) && (k) < hi)
#if defined(PROBE_SET)
#define STAMP(k) do { if (blockIdx.x == 0 && threadIdx.x == 0) ((unsigned long long*)(P.ws + WS_CTL + 512 * 1024))[k] = __builtin_amdgcn_s_memrealtime(); } while (0)
#else
#define STAMP(k) do { } while (0)
#endif
#define SEAM(k) do { STAMP(16 + (k)); if (IN(k) && IN((k) + 1)) xcd_barrier(bar); STAMP((k) + 1); } while (0)
    STAMP(0);
    const int gw = F.vcu * NWAVES + F.wave, NGW = F.G * NWAVES;
    unsigned char* ws = P.ws;

    if (IN(0)) { p0_rowstats(P, F); p0_weights(P, F); p0_pcast(P, F); p0_router_weights(P, F); }
    SEAM(0);
    if (IN(1)) {
        thin_cumsum(P, gw, NGW, tid_now() & 63);
#if defined(LDS_NAN_CHECK)
        for (int u = F.tid; u < RING_BYTES / 4; u += NWAVES * 64) ((LAS unsigned*)(F.lds + RING_OFF))[u] = 0x7FC07FC0u;
        __syncthreads();
#endif
        { pg8::StaticOrder S; S.init(ws + WS_XB, ws + WS_WT_IN, T, 5120, DM, F.G, (int)blockIdx.x);
          pg8::EpiIn E{ws, &P, gw, NGW};
          pg8::gemm_phase<pg8::EpiIn, pg8::StaticOrder, false>(F.lds + RING_OFF, DM, S, E); }
        { pg8::StaticOrder S; S.init(ws + WS_XB8, ws + WS_WT_IN8, T, 5120, DM / 2, F.G, (int)blockIdx.x);
          pg8::EpiGate E{ws, &P, gw, NGW};
          pg8::gemm_phase<pg8::EpiGate, pg8::StaticOrder, false, true, 121, 124>(F.lds + RING_OFF, DM / 2, S, E); }
    }
    SEAM(1);
    if (IN(2)) { thin_conv(P, (long)F.vcu * (NWAVES * 64) + tid_now(), (long)F.G * NWAVES * 64);
        fox::attn_phase((char*)lds_raw, ws, (volatile int*)((char*)lds_raw + MISC_OFF + 64));
    }
    SEAM(2);
    if (IN(3)) {
        { pg8::StaticOrder S; S.init(ws + WS_Q, ws + WS_WT_A, T, DM, FW, F.G, (int)blockIdx.x); pg8::EpiMerge<0> E{ws};
          pg8::gemm_phase<pg8::EpiMerge<0>, pg8::StaticOrder, false>(F.lds + RING_OFF, FW, S, E); }
        asm volatile("s_waitcnt vmcnt(0)" ::: "memory"); __syncthreads();
        { pg8::StaticOrder S; S.init(ws + WS_BG, ws + WS_WT_B, T, DM, CW, F.G, (int)blockIdx.x); pg8::EpiMerge<1> E{ws};
          pg8::gemm_phase<pg8::EpiMerge<1>, pg8::StaticOrder, false>(F.lds + RING_OFF, CW, S, E); }
    }
    SEAM(3);
    if (IN(4)) {
        { pg8::StaticOrder S; S.init(ws + WS_MERGED, ws + WS_WT_OUT, T, DM, DM, F.G, (int)blockIdx.x); pg8::EpiX1 E{(const bf16*)(ws + WS_XB), (const float*)(ws + WS_RSTD1), (bf16*)(ws + WS_X1B), ws + WS_X1F8};
          pg8::gemm_phase<pg8::EpiX1, pg8::StaticOrder, false>(F.lds + RING_OFF, DM, S, E); }
        { pg8::StaticOrder S; S.init(ws + WS_PB, ws + WS_WT_PE, T, DM, PLE, F.G, (int)blockIdx.x); pg8::EpiPlain E{(bf16*)(ws + WS_PP), DM};
          pg8::gemm_phase<pg8::EpiPlain, pg8::StaticOrder, false>(F.lds + RING_OFF, PLE, S, E); }
    }
    SEAM(4);
    if (IN(5)) { router_mfma(P, F); }
    SEAM(5);
    LAS int* segt = (LAS int*)(F.lds + SEGT_OFF);
    if (IN(6) || IN(7) || IN(8)) {
        if (tid_now() == 0) { const unsigned* CNT = F.ctl + CW_CNT; int mt = 0, sb = 0;
            for (int s = 0; s < NSEG; ++s) { const int c = (int)__hip_atomic_load(CNT + s * CNT_STRIDE, __ATOMIC_RELAXED, __HIP_MEMORY_SCOPE_AGENT); segt[s] = c; segt[64 + s] = mt; segt[129 + s] = sb; const int n = (c + 255) >> 8; mt += n; sb += n << 8; }
            segt[64 + NSEG] = mt; segt[129 + NSEG] = sb; }
        __syncthreads();
    }
    if (IN(6)) {
        pg8::SegOrder S; S.tab = segt; S.nN = 2 * FF / 256; S.G = F.G; S.c = F.vcu; S.seg_lo = 0; S.seg_hi = NSEG; S.K = DM / 2; S.down = 0; S.A = (const char*)(ws + WS_X1F8); S.Bt = (const char*)(ws + WS_WT_GU); S.TOKL = (const int*)(ws + WS_TOKL);
        S.Lmax = 4 * F.G;
        pg8::EpiGU E{ws};
        pg8::gemm_phase<pg8::EpiGU, pg8::SegOrder, true, true>(F.lds + RING_OFF, DM / 2, S, E);
    }
    SEAM(6);
    if (IN(7)) {
        { pg8::SegOrder S; S.tab = segt; S.nN = 2 * FF / 256; S.G = F.G; S.c = F.G - 1 - F.vcu; S.seg_lo = 0; S.seg_hi = NSEG; S.K = DM / 2; S.down = 0; S.A = (const char*)(ws + WS_X1F8); S.Bt = (const char*)(ws + WS_WT_GU); S.TOKL = (const int*)(ws + WS_TOKL);
          S.L0 = 4 * F.G;
          pg8::EpiGU E{ws};
          pg8::gemm_phase<pg8::EpiGU, pg8::SegOrder, true, true>(F.lds + RING_OFF, DM / 2, S, E); }
        asm volatile("s_waitcnt vmcnt(0)" ::: "memory"); __syncthreads();
        pg8::SegOrder S; S.tab = segt; S.nN = DM / 256; S.G = F.G; S.c = F.vcu; S.seg_lo = 0; S.seg_hi = NE; S.K = FF / 2; S.down = 1; S.A = (const char*)(ws + WS_HACT); S.Bt = (const char*)(ws + WS_WT_DN); S.TOKL = (const int*)(ws + WS_TOKL);
        pg8::EpiDN<false> E{ws};
        pg8::gemm_phase<pg8::EpiDN<false>, pg8::SegOrder, false, true, 121, 124>(F.lds + RING_OFF, FF / 2, S, E);
    }
    SEAM(7);
    if (IN(8)) {
        pg8::SegOrder S; S.tab = segt; S.nN = DM / 256; S.G = F.G; S.c = F.vcu; S.seg_lo = NE; S.seg_hi = NSEG; S.K = FF / 2; S.down = 1; S.A = (const char*)(ws + WS_HACT); S.Bt = (const char*)(ws + WS_WT_DN); S.TOKL = (const int*)(ws + WS_TOKL);
        pg8::EpiDN<true> E{ws};
        pg8::gemm_phase<pg8::EpiDN<true>, pg8::SegOrder, false, true, 121, 124>(F.lds + RING_OFF, FF / 2, S, E);
    }
    SEAM(8);
    if (IN(9)) { thin_rstd_fp8(ws + WS_X2F8, (float*)(ws + WS_RSTD3), gw, NGW, tid_now() & 63); }
    SEAM(9);
    if (IN(10)) {
        pg8::EpiPle E{(const bf16*)(ws + WS_X1B), (bf16*)(ws + WS_X2B), (const bf16*)(ws + WS_PP), (const float*)(ws + WS_RSTD3)};
        pg8::StaticOrder S; S.init(ws + WS_X2F8, ws + WS_WT_PG, T, DM, DM / 2, F.G, (int)blockIdx.x);
        pg8::gemm_phase<pg8::EpiPle, pg8::StaticOrder, false, true>(F.lds + RING_OFF, DM / 2, S, E);
    }
    SEAM(10);
    if (IN(11)) { thin_final_bf16(P, (const bf16*)(ws + WS_X2B), gw, NGW, tid_now() & 63); }
    STAMP(12);
#undef IN
#undef SEAM
}
#if defined(PROBE_SET)
#ifndef PROBE_SCALE
#define PROBE_SCALE 0.1f
#endif
#ifndef PROBE_OFF
#define PROBE_OFF 0.f
#endif
__global__ void k_probe(Params P, int set) {
    const unsigned long long* st = (const unsigned long long*)(P.ws + WS_CTL + 512 * 1024);
    float us = 0.f;
    for (int k = 0; k < 12; ++k) if ((set >> k) & 1) us += (float)(st[k + 1] - st[k]) * 0.01f;
    for (int k = 0; k < 11; ++k) if ((set >> (16 + k)) & 1) us += (float)(st[k + 1] - st[16 + k]) * 0.01f;
    if (threadIdx.x == 0 && blockIdx.x == 0) P.out[0] += (us - PROBE_OFF) * PROBE_SCALE;
}
#endif
static void launch_mega(const Params& P, int lo, int hi, hipStream_t stream) {
    static bool attr_done = false;
    if (!attr_done) { attr_done = true;
        if (hipFuncSetAttribute((const void*)mega_fwd, hipFuncAttributeMaxDynamicSharedMemorySize, LDS_BYTES) != hipSuccess) fprintf(stderr, "kernel_launch: hipFuncSetAttribute failed\n");
        (void)hipGetLastError(); }
    if (lo >= hi) return;
    MegaArgs a; memset(&a, 0, sizeof(a)); a.P = P; a.ph_lo = lo; a.ph_hi = hi;
    hipLaunchKernelGGL(mega_fwd, dim3(256), dim3(NWAVES * 64), LDS_BYTES, stream, a);
    const hipError_t le = hipPeekAtLastError();
    if (le != hipSuccess) fprintf(stderr, "kernel_launch: mega launch [%d,%d) failed: %s\n", lo, hi, hipGetErrorName(le));
}
extern "C" void kernel_launch(void* const* d_in, const int* in_sizes, int n_in, void* d_out, int out_size, void* d_ws, size_t ws_size, hipStream_t stream) {
    if (n_in != 20 || in_sizes[0] != T * DM || out_size != T * DM || ws_size < WS_END) {
        fprintf(stderr, "kernel_launch: unexpected shapes (n_in %d, in0 %d, out %d, ws %zu; need ws >= %zu); nothing launched\n", n_in, n_in > 0 ? in_sizes[0] : -1, out_size, ws_size, (size_t)WS_END); return; }
    Params P; memset(&P, 0, sizeof(P));
    const float** pp = (const float**)&P;
    for (int i = 0; i < 20; ++i) pp[i] = (const float*)d_in[i];
    P.out = (float*)d_out; P.ws = (unsigned char*)d_ws;
    unsigned char* ws = P.ws;
    (void)hipMemsetAsync(ws + WS_CTL, 0, 1 * MiB, stream);
    launch_mega(P, 0, NPHASE, stream);
#if defined(PROBE_SET)
    k_probe<<<1, 64, 0, stream>>>(P, PROBE_SET);
#endif
}
```

```cpp
#include <hip/hip_runtime.h>
#include <cstdio>
#include <cstdint>
#include <cstring>

constexpr int BATCH = 8, SEQ = 4096, DM = 2048, T = BATCH * SEQ;
constexpr int NH = 8, HD = 128, FW = 1024, CW = 1024, PLE = 256, NGRP = 4, EPG = 8, NE = 32, FF = 512;
constexpr int IN_COLS = 3 * FW + NH + 3 * CW + 2 * DM;
constexpr int C_Q = 0, C_K = 1024, C_V = 2048, C_F = 3072, C_U = 3080, C_BG = 4104, C_CG = 5128, C_GA = 6152;
constexpr float EPS = 1e-6f;
constexpr int NSEG = 64;

constexpr size_t MiB = 1u << 20;
constexpr size_t WS_CTL = 0;
constexpr size_t WS_RSTD1 = 1 * MiB;
constexpr size_t WS_LOGF = 2 * MiB;
constexpr size_t WS_CUM = 3 * MiB;
constexpr size_t WS_NQ = 6 * MiB;
constexpr size_t WS_RSTD2 = 4 * MiB, WS_RSTD3 = 5 * MiB;
constexpr size_t WS_EID = 7 * MiB;
constexpr size_t WS_WTS = 7 * MiB + 512 * 1024;
constexpr size_t WS_POS = 8 * MiB;
constexpr size_t WS_SEGB = 8 * MiB + 512 * 1024;
constexpr size_t WS_TOKL = 9 * MiB;
constexpr size_t WS_WRH = 17 * MiB, WS_WRL = 17 * MiB + 256 * 1024;
constexpr size_t WS_WT_IN = 20 * MiB, WS_WT_A = 60 * MiB, WS_WT_B = 64 * MiB, WS_WT_OUT = 68 * MiB, WS_WT_PG = 76 * MiB, WS_WT_PE = 84 * MiB;
constexpr size_t WS_PB = 86 * MiB;
constexpr size_t WS_WT_GU = 104 * MiB, WS_WT_DN = 232 * MiB;
constexpr size_t WS_WT_IN8 = WS_WT_IN + (size_t)6144 * 2048 * 2;
constexpr size_t WS_SC = 264 * MiB;
constexpr size_t WS_XB8 = 168 * MiB;
constexpr size_t WS_XB = 296 * MiB;
constexpr size_t WS_Q = 424 * MiB, WS_K = 488 * MiB, WS_V = 552 * MiB;
constexpr size_t WS_Z = 616 * MiB, WS_BG = 680 * MiB;
constexpr size_t WS_GAB = 744 * MiB;
constexpr size_t WS_MERGED = 552 * MiB;
constexpr size_t WS_X1B = 424 * MiB;
constexpr size_t WS_HACT = 552 * MiB;
constexpr size_t WS_X2B = 744 * MiB;
constexpr size_t WS_PP = 872 * MiB;
constexpr size_t WS_X2F8 = 632 * MiB;
constexpr size_t WS_X1F8 = 680 * MiB;
constexpr size_t WS_END = 1000 * MiB;
constexpr int CW_CNT = 16384, CNT_STRIDE = 64;
constexpr int CW_N2 = 2048;
constexpr int CW_ATT = 3072;
constexpr int CW_CONV = 3072 + 64;

typedef unsigned short bf16;
typedef float f32x4 __attribute__((ext_vector_type(4)));
typedef unsigned u32x4 __attribute__((ext_vector_type(4)));
typedef unsigned u32x2 __attribute__((ext_vector_type(2)));

struct Params {
    const float *x, *p, *g_mix, *w_in, *b_f, *conv_w, *w_a, *w_b, *w_out, *g_ffn, *w_rg, *b_rg, *w_re, *b_re, *w_gu, *w_dn, *g_ple, *w_pg, *w_pe, *g_final;
    float* out; unsigned char* ws;
};

__device__ __forceinline__ unsigned f2bf(float f) { unsigned u = __builtin_bit_cast(unsigned, f); return (u + 0x7fffu + ((u >> 16) & 1u)) >> 16; }
__device__ __forceinline__ unsigned pk2(float lo, float hi) { return f2bf(lo) | (f2bf(hi) << 16); }
__device__ __forceinline__ float bf2f(unsigned short b) { return __builtin_bit_cast(float, (unsigned)b << 16); }
__device__ __forceinline__ float bflo(unsigned w) { return __builtin_bit_cast(float, w << 16); }
__device__ __forceinline__ float bfhi(unsigned w) { return __builtin_bit_cast(float, w & 0xffff0000u); }
__device__ __forceinline__ float wave_sum(float v) {
#pragma unroll
    for (int o = 1; o < 64; o <<= 1) v += __shfl_xor(v, o);
    return v;
}
__device__ __forceinline__ float wave_max(float v) {
#pragma unroll
    for (int o = 1; o < 64; o <<= 1) v = fmaxf(v, __shfl_xor(v, o));
    return v;
}
__device__ __forceinline__ float sigmoidf_(float v) { return 1.0f / (1.0f + __expf(-v)); }

__device__ __forceinline__ void thin_cumsum(const Params& P, int gw, int ngw, int lane) {
    const float* logf = (const float*)(P.ws + WS_LOGF); float* cum = (float*)(P.ws + WS_CUM);
    for (int bh = gw; bh < BATCH * NH; bh += ngw) {
        const int b = bh / NH, h = bh % NH;
        const float* src = logf + ((size_t)b * SEQ + lane * 64) * 8 + h;
        double s = 0.0;
        for (int i = 0; i < 64; ++i) s += (double)src[(size_t)i * 8];
        double incl = s;
#pragma unroll
        for (int o = 1; o < 64; o <<= 1) { const double up = __shfl_up(incl, o); if (lane >= o) incl += up; }
        double run = incl - s;
        float* dst = cum + (size_t)bh * SEQ + lane * 64;
        for (int i = 0; i < 64; ++i) { run += (double)src[(size_t)i * 8]; dst[i] = (float)run; }
    }
}
__device__ __forceinline__ void thin_conv_chunk(const Params& P, int k, int tid) {
    const bf16* Z = (const bf16*)(P.ws + WS_Z); bf16* BG = (bf16*)(P.ws + WS_BG);
#pragma unroll 1
    for (int j0 = 0; j0 < 8; j0 += 2) {
        int tt[2], cc[2]; u32x4 z2[2], z1[2], z0[2], bb[2];
#pragma unroll
        for (int r = 0; r < 2; ++r) { const int i = k * 4096 + (j0 + r) * 512 + tid; const int t = i / (CW / 8), c = (i % (CW / 8)) * 8, s = t % SEQ; tt[r] = t; cc[r] = c;
            z2[r] = *(const u32x4*)(Z + (size_t)t * CW + c); z1[r] = (u32x4){0u, 0u, 0u, 0u}; z0[r] = (u32x4){0u, 0u, 0u, 0u};
            if (s >= 1) z1[r] = *(const u32x4*)(Z + (size_t)(t - 1) * CW + c);
            if (s >= 2) z0[r] = *(const u32x4*)(Z + (size_t)(t - 2) * CW + c);
            bb[r] = *(const u32x4*)(BG + (size_t)t * CW + c); }
#pragma unroll
        for (int r = 0; r < 2; ++r) { const int c = cc[r]; u32x4 o;
#pragma unroll
            for (int q = 0; q < 4; ++q) {
                const int c0 = c + 2 * q;
                const float lo = bflo(bb[r][q]) * (P.conv_w[c0] * bflo(z0[r][q]) + P.conv_w[CW + c0] * bflo(z1[r][q]) + P.conv_w[2 * CW + c0] * bflo(z2[r][q]));
                const float hi = bfhi(bb[r][q]) * (P.conv_w[c0 + 1] * bfhi(z0[r][q]) + P.conv_w[CW + c0 + 1] * bfhi(z1[r][q]) + P.conv_w[2 * CW + c0 + 1] * bfhi(z2[r][q]));
                o[q] = pk2(lo, hi);
            }
            *(u32x4*)(BG + (size_t)tt[r] * CW + c) = o; }
    }
}
__device__ __forceinline__ void thin_conv(const Params& P, long gt, long ngt) {
    const bf16* Z = (const bf16*)(P.ws + WS_Z); bf16* BG = (bf16*)(P.ws + WS_BG);
    for (long i0 = gt; i0 < (long)T * (CW / 8); i0 += 2 * ngt) {
        int tt[2], cc[2]; u32x4 z2[2], z1[2], z0[2], bb[2];
#pragma unroll
        for (int r = 0; r < 2; ++r) { const long i = i0 + r * ngt; const int t = (int)(i / (CW / 8)), c = (int)(i % (CW / 8)) * 8, s = t % SEQ; tt[r] = t; cc[r] = c;
            z2[r] = *(const u32x4*)(Z + (size_t)t * CW + c); z1[r] = (u32x4){0u, 0u, 0u, 0u}; z0[r] = (u32x4){0u, 0u, 0u, 0u};
            if (s >= 1) z1[r] = *(const u32x4*)(Z + (size_t)(t - 1) * CW + c);
            if (s >= 2) z0[r] = *(const u32x4*)(Z + (size_t)(t - 2) * CW + c);
            bb[r] = *(const u32x4*)(BG + (size_t)t * CW + c); }
#pragma unroll
        for (int r = 0; r < 2; ++r) { const int c = cc[r]; u32x4 o;
#pragma unroll
            for (int q = 0; q < 4; ++q) {
                const int c0 = c + 2 * q;
                const float lo = bflo(bb[r][q]) * (P.conv_w[c0] * bflo(z0[r][q]) + P.conv_w[CW + c0] * bflo(z1[r][q]) + P.conv_w[2 * CW + c0] * bflo(z2[r][q]));
                const float hi = bfhi(bb[r][q]) * (P.conv_w[c0 + 1] * bfhi(z0[r][q]) + P.conv_w[CW + c0 + 1] * bfhi(z1[r][q]) + P.conv_w[2 * CW + c0 + 1] * bfhi(z2[r][q]));
                o[q] = pk2(lo, hi);
            }
            *(u32x4*)(BG + (size_t)tt[r] * CW + c) = o; }
    }
}
#define LAS __attribute__((address_space(3)))
#define GAS __attribute__((address_space(1)))
typedef short bf16x8 __attribute__((ext_vector_type(8)));
typedef float f32x2 __attribute__((ext_vector_type(2)));
constexpr int NWAVES = 8;
constexpr int RING_OFF = 0, RING_BYTES = 131072;
constexpr int LDSCTL_OFF = RING_BYTES, MISC_OFF = LDSCTL_OFF + 320;
constexpr int SEGT_OFF = LDSCTL_OFF + 1024;
constexpr int LDS_BYTES = 147456;
constexpr int CW_BAR = 4096;
typedef __bf16 bf16x2_t __attribute__((ext_vector_type(2)));
__device__ __forceinline__ unsigned cvt_pk_bf16(float lo, float hi) { f32x2 v = {lo, hi}; bf16x2_t b = __builtin_convertvector(v, bf16x2_t); return __builtin_bit_cast(unsigned, b); }
typedef int i32x8 __attribute__((ext_vector_type(8)));
typedef unsigned u32x8 __attribute__((ext_vector_type(8)));
__device__ __forceinline__ u32x2 pack8_fp8(f32x4 a, f32x4 b) { u32x2 w; int t = __builtin_amdgcn_cvt_pk_fp8_f32(a.x, a.y, 0, false); t = __builtin_amdgcn_cvt_pk_fp8_f32(a.z, a.w, t, true); w.x = (unsigned)t;
    t = __builtin_amdgcn_cvt_pk_fp8_f32(b.x, b.y, 0, false); t = __builtin_amdgcn_cvt_pk_fp8_f32(b.z, b.w, t, true); w.y = (unsigned)t; return w; }
__device__ __forceinline__ float fast_sigmoid(float v) { return __builtin_amdgcn_rcpf(1.0f + __builtin_amdgcn_exp2f(v * -1.4426950408889634f)); }

#define XB_TMO      128
#define XB_XCNT(j)  (256  + 64 * (j))
#define XB_XSUB(j)  (1280 + 64 * (j))
#define XB_XGEN(j)  (2304 + 64 * (j))
#define XB_TOP      3328
#define XB_TOPGEN   3392
#define XCD_BAR_WORDS 3456
#define XB_SPIN_CAP (1u << 18)
__device__ __forceinline__ unsigned xb_ld(unsigned* p)              { return __hip_atomic_load(p, __ATOMIC_RELAXED, __HIP_MEMORY_SCOPE_AGENT); }
__device__ __forceinline__ unsigned xb_add(unsigned* p, unsigned v) { return __hip_atomic_fetch_add(p, v, __ATOMIC_RELAXED, __HIP_MEMORY_SCOPE_AGENT); }
__device__ __forceinline__ unsigned xb_xcc_id() { return (unsigned)__builtin_amdgcn_s_getreg((3 << 11) | 20) & 0xFu; }
#define XB_SPIN(cond, bar) do { unsigned _sp = 0; while (cond) { __builtin_amdgcn_s_sleep(1); \
    if ((++_sp & 255u) == 0u) { if (xb_ld(&(bar)[XB_TMO])) break; if (_sp > XB_SPIN_CAP) { atomicAdd(&(bar)[XB_TMO], 1u); break; } } } } while (0)
struct XcdBarrier { unsigned* bar; unsigned x; volatile LAS unsigned* st; };
__device__ __forceinline__ XcdBarrier xcd_barrier_post(unsigned* bar, volatile LAS unsigned* st) {
    XcdBarrier b; b.bar = bar; b.x = xb_xcc_id(); b.st = st;
    if (threadIdx.x == 0) (void)xb_add(&bar[XB_XCNT(b.x)], 1u);
    return b;
}
__device__ __forceinline__ void xcd_barrier_complete(unsigned* bar, unsigned x, unsigned& nloc, unsigned& nx) {
    const unsigned G = gridDim.x * gridDim.y * gridDim.z;
    unsigned sum, cnt, mine, sp = 0u;
    for (;;) {
        sum = 0u; cnt = 0u; mine = 0u;
#pragma unroll
        for (unsigned j = 0; j < 16; ++j) { const unsigned c = xb_ld(&bar[XB_XCNT(j)]); sum += c; cnt += (c > 0u) ? 1u : 0u; mine = (j == x) ? c : mine; }
        if (sum == G) break;
        __builtin_amdgcn_s_sleep(1);
        if ((++sp & 255u) == 0u) { if (xb_ld(&bar[XB_TMO])) break; if (sp > XB_SPIN_CAP) { atomicAdd(&bar[XB_TMO], 1u); break; } }
    }
    nloc = mine > 0u ? mine : 1u; nx = cnt > 0u ? cnt : 1u;
}
__device__ __forceinline__ void xcd_barrier(const XcdBarrier& b) {
    asm volatile("s_waitcnt vmcnt(0)" ::: "memory");
    __syncthreads();
    if (threadIdx.x == 0) {
        unsigned* bar = b.bar;
        __builtin_amdgcn_s_waitcnt(0);
        unsigned nloc = b.st[0], nx = b.st[1];
        if (nloc == 0u) { xcd_barrier_complete(bar, b.x, nloc, nx); b.st[0] = nloc; b.st[1] = nx; }
        const unsigned old = xb_add(&bar[XB_XSUB(b.x)], 1u);
        const unsigned gen = old / nloc;
        if (old + 1u == (gen + 1u) * nloc) {
            __builtin_amdgcn_fence(__ATOMIC_RELEASE, "agent");
            asm volatile("s_waitcnt vmcnt(0)" ::: "memory");
            const unsigned og = xb_add(&bar[XB_TOP], 1u);
            const unsigned tg = og / nx;
            if (og + 1u == (tg + 1u) * nx) xb_add(&bar[XB_TOPGEN], 1u);
            else XB_SPIN(xb_ld(&bar[XB_TOPGEN]) == tg, bar);
            __builtin_amdgcn_fence(__ATOMIC_ACQUIRE, "agent");
            xb_add(&bar[XB_XGEN(b.x)], 1u);
            asm volatile("s_waitcnt vmcnt(0)" ::: "memory");
        } else {
            XB_SPIN(xb_ld(&bar[XB_XGEN(b.x)]) == gen, bar);
            __builtin_amdgcn_fence(__ATOMIC_ACQUIRE, "agent");
            asm volatile("s_waitcnt vmcnt(0)" ::: "memory");
        }
    }
    __syncthreads();
}

struct Params;
struct XItem { const float* src; const float* gain; unsigned char* dst; int ldw, K, fp8; };
struct SidePair { XItem a, b; f32x4 va[8], vb[8]; int n; };
__device__ __forceinline__ void side_load(const Params& P, int gw, int NGW, int k, int lane, SidePair& sp);
__device__ __forceinline__ void side_store(int lane, const SidePair& sp);
namespace pg8 {
constexpr int BM = 256, BK = 64, HALF = 128, HTB = HALF * BK * 2, STAGE_BYTES = 8 * HTB, NXCD = 8, WGM = 8;
__host__ __device__ __forceinline__ int lds_byte(int r, int c) { const int st = (r >> 4) * 2 + (c >> 5), rr = r & 15, cc = c & 31, ob = rr * 64 + cc * 2; return st * 1024 + (ob ^ (((ob >> 9) & 1) << 5)); }
__host__ __device__ __forceinline__ void stage_rc(int b, int& R, int& C) { const int st = b / 1024, sb = b % 1024, swz = sb ^ (((sb >> 9) & 1) << 5); R = (st >> 1) * 16 + swz / 64; C = (st & 1) * 32 + (swz % 64) / 2; }
__host__ __device__ __forceinline__ int perm32(int rho) { const int n = rho >> 4, i = rho & 15; return 8 * (i >> 2) + 4 * n + (i & 3); }

struct Unit { int pm, pn, seg, mt, nrow, slot0, ui; const char* a; const char* b; };

struct StaticOrder {
    int nM, nN, nwg, G, c, K; const char* A; const char* Bt;
    __device__ void init(const void* A_, const void* Bt_, int M, int N, int K_, int G_, int c_) { A = (const char*)A_; Bt = (const char*)Bt_; nM = M / BM; nN = N / BM; nwg = nM * nN; G = G_; c = c_; K = K_; }
    __device__ bool next(int i, Unit& u) const {
        const long L = (long)i * G + c; if (L >= nwg) return false;
        int wgid = (int)L; { const int q = nwg / NXCD, r = nwg % NXCD, xcd = wgid % NXCD, off = wgid / NXCD; wgid = (xcd < r ? xcd * (q + 1) : r * (q + 1) + (xcd - r) * q) + off; }
        const int nig = WGM * nN, gid = wgid / nig, fm = gid * WGM, gsz = (nM - fm) < WGM ? (nM - fm) : WGM;
        u.pm = fm + ((wgid % nig) % gsz); u.pn = (wgid % nig) / gsz;
#if defined(REV_PN)
        u.pn = nN - 1 - u.pn;
#endif
        u.seg = 0; u.mt = 0; u.nrow = BM; u.slot0 = 0;
        u.a = A + (size_t)u.pm * BM * K * 2; u.b = Bt + (size_t)u.pn * BM * K * 2; return true;
    }
    __device__ __forceinline__ unsigned arow(const Unit&, int r) const { return (unsigned)r; }
};

template <class Epi, class Sched, bool GATHER, bool FP8 = false, int SCW = 121, int SCA = 127>
__device__ __forceinline__ void gemm_phase(LAS unsigned char* lds, const int K, const Sched& S, const Epi& E) {
    const int tid = threadIdx.x, wid = __builtin_amdgcn_readfirstlane(tid >> 6), lane = tid & 63, wr = wid >> 2, wc = wid & 3, fr = lane & 15, fq = lane >> 4;
    const int nt = K / BK;
    int Rr[2], Cc[2]; unsigned voffB[2];
#pragma unroll
    for (int i = 0; i < 2; ++i) { int R, C; stage_rc(tid * 16 + i * 8192, R, C); const int Rb = Epi::PERM ? ((R & ~31) + perm32(R & 31)) : R; Rr[i] = R; Cc[i] = C; voffB[i] = (unsigned)(Rb * K + C) * 2u; }
    const size_t kstep = (size_t)(BK * 2);
    const size_t hstep = (size_t)HALF * K * 2;
    const unsigned ldsw = (unsigned)wid * 1024u;
    const int aoff = lds_byte(wr * 64 + fr, fq * 8), boff = lds_byte(wc * 32 + fr, fq * 8);
#define PG8_SA(b, h) (((b) * 2 + (h)) * HTB)
#define PG8_SB(b, h) ((4 + (b) * 2 + (h)) * HTB)
#define PG8_LD1(bufoff, gptr, i_) __builtin_amdgcn_global_load_lds((const unsigned*)(gptr), (LAS unsigned*)(lds + (bufoff) + ldsw + (i_) * 8192), 16, 0, 0)
#define PG8_STAGE_B(bufoff, gbase) do { PG8_LD1(bufoff, (const char*)(gbase) + voffB[0], 0); PG8_LD1(bufoff, (const char*)(gbase) + voffB[1], 1); } while (0)
#define PG8_STAGE_A(bufoff, gbase, v0, v1) do { PG8_LD1(bufoff, (const char*)(gbase) + (v0), 0); PG8_LD1(bufoff, (const char*)(gbase) + (v1), 1); } while (0)
#define PG8_LDA(dst, b, h) do { if constexpr (FP8) { _Pragma("unroll") for (int m = 0; m < 4; ++m) dst##8[m] = __builtin_shufflevector(*(const LAS u32x4*)(lds + PG8_SA(b, h) + aoff + m * 2048), *(const LAS u32x4*)(lds + PG8_SA(b, h) + aoff + m * 2048 + 1024), 0, 1, 2, 3, 4, 5, 6, 7); } \
        else { _Pragma("unroll") for (int m = 0; m < 4; ++m) _Pragma("unroll") for (int k = 0; k < 2; ++k) dst[m][k] = *(const LAS bf16x8*)(lds + PG8_SA(b, h) + aoff + m * 2048 + k * 1024); } } while (0)
#define PG8_LDB(dst, b, h) do { if constexpr (FP8) { _Pragma("unroll") for (int n = 0; n < 2; ++n) dst##8[n] = __builtin_shufflevector(*(const LAS u32x4*)(lds + PG8_SB(b, h) + boff + n * 2048), *(const LAS u32x4*)(lds + PG8_SB(b, h) + boff + n * 2048 + 1024), 0, 1, 2, 3, 4, 5, 6, 7); } \
        else { _Pragma("unroll") for (int n = 0; n < 2; ++n) _Pragma("unroll") for (int k = 0; k < 2; ++k) dst[n][k] = *(const LAS bf16x8*)(lds + PG8_SB(b, h) + boff + n * 2048 + k * 1024); } } while (0)
#define PG8_MMA(ai, bj, At, Bt) do { __builtin_amdgcn_s_setprio(1); if constexpr (FP8) { _Pragma("unroll") for (int m = 0; m < 4; ++m) _Pragma("unroll") for (int n = 0; n < 2; ++n) \
        asm volatile("v_mfma_scale_f32_16x16x128_f8f6f4 %0, %1, %2, %0, %3, %4 op_sel_hi:[0,0,0]" : "+v"(acc[ai][bj][m][n]) : "v"(Bt##8[n]), "v"(At##8[m]), "v"(scw), "v"(sca)); } \
        else { _Pragma("unroll") for (int m = 0; m < 4; ++m) _Pragma("unroll") for (int n = 0; n < 2; ++n) _Pragma("unroll") for (int k = 0; k < 2; ++k) \
        acc[ai][bj][m][n] = __builtin_amdgcn_mfma_f32_16x16x32_bf16(Bt[n][k], At[m][k], acc[ai][bj][m][n], 0, 0, 0); } __builtin_amdgcn_s_setprio(0); } while (0)
#define PG8_WAIT_V(n) asm volatile("s_waitcnt vmcnt(" #n ")" ::: "memory")
#define PG8_WAIT_L(n) asm volatile("s_waitcnt lgkmcnt(" #n ")" ::: "memory")
#define PG8_BAR __builtin_amdgcn_s_barrier()
#define PG8_SCHED __builtin_amdgcn_sched_barrier(0)
#define PG8_VOFFA(dst, u) do { _Pragma("unroll") for (int h_ = 0; h_ < 2; ++h_) _Pragma("unroll") for (int i_ = 0; i_ < 2; ++i_) \
        dst[h_][i_] = S.arow(u, h_ * HALF + Rr[i_]) * (unsigned)(K * 2) + (unsigned)(Cc[i_] * 2); } while (0)
    Unit cur, nxt; int ui = 0;
    cur.seg = 0;
    if (!S.next(0, cur)) return;
    cur.ui = 0;
    f32x4 acc[2][2][4][2];
#pragma unroll
    for (int a = 0; a < 2; ++a)
#pragma unroll
        for (int b = 0; b < 2; ++b)
#pragma unroll
            for (int m = 0; m < 4; ++m)
#pragma unroll
                for (int n = 0; n < 2; ++n) acc[a][b][m][n] = (f32x4){0.f, 0.f, 0.f, 0.f};
    bf16x8 At[4][2], B0[2][2], B1[2][2];
    u32x8 At8[4], B08[2], B18[2];
    const int scw = SCW, sca = SCA;
    unsigned voffA[2][2];
    PG8_VOFFA(voffA, cur);
    const char* cA = cur.a; const char* cB = cur.b;
    PG8_STAGE_B(PG8_SB(0, 0), cB); PG8_STAGE_B(PG8_SB(0, 1), cB + hstep); PG8_STAGE_A(PG8_SA(0, 0), cA, voffA[0][0], voffA[0][1]); PG8_STAGE_A(PG8_SA(0, 1), cA, voffA[1][0], voffA[1][1]);
    if (wr == 1) PG8_BAR;
    PG8_WAIT_V(2); PG8_BAR;
    PG8_STAGE_B(PG8_SB(1, 0), cB + kstep); PG8_STAGE_A(PG8_SA(1, 0), cA + kstep, voffA[0][0], voffA[0][1]); PG8_STAGE_B(PG8_SB(1, 1), cB + hstep + kstep);
    PG8_WAIT_V(6); PG8_BAR;
    for (;;) {
        nxt.seg = cur.seg;
        const bool has_next = S.next(ui + 1, nxt);
        const char* nA = has_next ? nxt.a : cA; const char* nB = has_next ? nxt.b : cB;
#pragma unroll 1
        for (int t = 0; t < nt; t += 2) {
            const bool last = (t == nt - 2);
            const char* a1 = cA + (size_t)(t + 1) * kstep;
            const char* a2 = last ? nA : cA + (size_t)(t + 2) * kstep; const char* b2 = last ? nB : cB + (size_t)(t + 2) * kstep;
            const char* a3 = a2 + kstep; const char* b3 = b2 + kstep;
            PG8_LDB(B0, 0, 0); PG8_LDB(B1, 0, 1); PG8_SCHED; PG8_LDA(At, 0, 0); PG8_STAGE_A(PG8_SA(1, 1), a1, voffA[1][0], voffA[1][1]);
            if constexpr (GATHER) { if (last && has_next) { PG8_VOFFA(voffA, nxt); } }
            PG8_WAIT_V(8); PG8_WAIT_L(0); PG8_BAR; PG8_MMA(0, 0, At, B0); PG8_MMA(0, 1, At, B1); PG8_BAR; PG8_SCHED;
            PG8_LDA(At, 0, 1); PG8_STAGE_B(PG8_SB(0, 0), b2); PG8_STAGE_B(PG8_SB(0, 1), b2 + hstep); PG8_STAGE_A(PG8_SA(0, 0), a2, voffA[0][0], voffA[0][1]);
            PG8_WAIT_V(8); PG8_WAIT_L(0); PG8_BAR; PG8_MMA(1, 0, At, B0); PG8_MMA(1, 1, At, B1); PG8_BAR; PG8_SCHED;
            PG8_LDB(B0, 1, 0); PG8_LDB(B1, 1, 1); PG8_SCHED; PG8_LDA(At, 1, 0); PG8_STAGE_A(PG8_SA(0, 1), a2, voffA[1][0], voffA[1][1]);
            PG8_WAIT_V(8); PG8_WAIT_L(0); PG8_BAR; PG8_MMA(0, 0, At, B0); PG8_MMA(0, 1, At, B1); PG8_BAR; PG8_SCHED;
            PG8_LDA(At, 1, 1); PG8_STAGE_B(PG8_SB(1, 0), b3); PG8_STAGE_B(PG8_SB(1, 1), b3 + hstep); PG8_STAGE_A(PG8_SA(1, 0), a3, voffA[0][0], voffA[0][1]);
            PG8_WAIT_V(8); PG8_WAIT_L(0); PG8_BAR; PG8_MMA(1, 0, At, B0); PG8_MMA(1, 1, At, B1); PG8_BAR; PG8_SCHED;
        }
        if (wr == 0) PG8_BAR;
        if constexpr (FP8) asm volatile("s_nop 15\n\ts_nop 15" ::: "memory");
        E(acc, cur, wr, wc, fr, fq);
        if (!has_next) break;
#pragma unroll
        for (int a = 0; a < 2; ++a)
#pragma unroll
            for (int b = 0; b < 2; ++b)
#pragma unroll
                for (int m = 0; m < 4; ++m)
#pragma unroll
                    for (int n = 0; n < 2; ++n) acc[a][b][m][n] = (f32x4){0.f, 0.f, 0.f, 0.f};
        cur = nxt; cA = nA; cB = nB; ++ui; cur.ui = ui;
        if (wr == 1) PG8_BAR;
    }
    PG8_WAIT_V(0);
    PG8_BAR;
#undef PG8_SA
#undef PG8_SB
#undef PG8_LD1
#undef PG8_STAGE_A
#undef PG8_STAGE_B
#undef PG8_LDA
#undef PG8_LDB
#undef PG8_MMA
#undef PG8_WAIT_V
#undef PG8_WAIT_L
#undef PG8_BAR
#undef PG8_SCHED
#undef PG8_VOFFA
}

typedef const f32x4 (&AccRef)[2][2][4][2];
__device__ __forceinline__ u32x4 pack8(f32x4 v0, f32x4 v1) { u32x4 w; w.x = cvt_pk_bf16(v0[0], v0[1]); w.y = cvt_pk_bf16(v0[2], v0[3]); w.z = cvt_pk_bf16(v1[0], v1[1]); w.w = cvt_pk_bf16(v1[2], v1[3]); return w; }
__device__ __forceinline__ f32x4 sig4(f32x4 v) { return (f32x4){fast_sigmoid(v[0]), fast_sigmoid(v[1]), fast_sigmoid(v[2]), fast_sigmoid(v[3])}; }
__device__ __forceinline__ f32x4 bflo4(u32x4 w) { return (f32x4){bflo(w.x), bfhi(w.x), bflo(w.y), bfhi(w.y)}; }
__device__ __forceinline__ f32x4 bfhi4(u32x4 w) { return (f32x4){bflo(w.z), bfhi(w.z), bflo(w.w), bfhi(w.w)}; }
__device__ __forceinline__ unsigned q8x4(f32x4 v) { const unsigned a = (unsigned)(v.x * 255.0f + 0.5f), b = (unsigned)(v.y * 255.0f + 0.5f), c = (unsigned)(v.z * 255.0f + 0.5f), d = (unsigned)(v.w * 255.0f + 0.5f); return a | (b << 8) | (c << 16) | (d << 24); }
__device__ __forceinline__ f32x4 dq8x4(unsigned w) { return (f32x4){(float)(w & 0xffu), (float)((w >> 8) & 0xffu), (float)((w >> 16) & 0xffu), (float)(w >> 24)} * (1.0f / 255.0f); }

struct EpiIn {
    static constexpr bool PERM = true;
    unsigned char* ws; const Params* P; int gw, NGW;
    __device__ __forceinline__ void operator()(AccRef acc, const Unit& u, int wr, int wc, int fr, int fq) const {
        asm volatile("" : "+v"(fr), "+v"(fq));
        const int row0 = u.pm * BM + wr * 64 + fr, cw = wc * 32 + 8 * fq;
        const int pn = u.pn < 8 ? u.pn : u.pn + 4;
        if (pn < 8) {
            float* NQ = (float*)(ws + WS_NQ) + (size_t)(pn >> 2) * (512 * NH * 4);
#pragma unroll
            for (int bj = 0; bj < 2; ++bj)
#pragma unroll
                for (int ai = 0; ai < 2; ++ai) { float mx = 0.f;
#pragma unroll
                    for (int m = 0; m < 4; ++m) { const f32x4 a = acc[ai][bj][m][0], b = acc[ai][bj][m][1];
                        float s = (a.x * a.x + a.y * a.y) + (a.z * a.z + a.w * a.w) + (b.x * b.x + b.y * b.y) + (b.z * b.z + b.w * b.w);
                        s += __shfl_xor(s, 16); s += __shfl_xor(s, 32); mx = fmaxf(mx, s); }
#pragma unroll
                    for (int o = 1; o < 16; o <<= 1) mx = fmaxf(mx, __shfl_xor(mx, o));
                    if (fr == 0 && fq == 0) NQ[((size_t)(u.pm * 4 + ai * 2 + wr) * NH + 2 * (pn & 3) + bj) * 4 + wc] = mx * 1.03f; }
        }
        if (pn < 12 || (pn >= 20 && pn < 24)) {
            bf16* base; if (pn < 12) base = (bf16*)(ws + WS_Q) + (size_t)(pn >> 2) * ((size_t)T * FW) + (pn & 3) * BM; else base = (bf16*)(ws + WS_BG) + (pn - 20) * BM;
#pragma unroll
            for (int ai = 0; ai < 2; ++ai)
#pragma unroll
                for (int m = 0; m < 4; ++m) { bf16* rowp = base + (size_t)(row0 + ai * HALF + m * 16) * FW + cw;
#pragma unroll
                    for (int bj = 0; bj < 2; ++bj) *(u32x4*)(rowp + bj * HALF) = pack8(acc[ai][bj][m][0], acc[ai][bj][m][1]); }
        } else if (pn < 20) {
            bf16* base = (bf16*)(ws + WS_Z) + (pn - 12) * HALF;
#pragma unroll
            for (int ai = 0; ai < 2; ++ai)
#pragma unroll
                for (int m = 0; m < 4; ++m) { bf16* rowp = base + (size_t)(row0 + ai * HALF + m * 16) * CW + cw;
                    *(u32x4*)rowp = pack8(acc[ai][0][m][0] * acc[ai][1][m][0], acc[ai][0][m][1] * acc[ai][1][m][1]); }
        }
        { SidePair sp; side_load(*P, gw, NGW, u.ui, (fq << 4) | fr, sp); side_store((fq << 4) | fr, sp); }
    }
};

struct EpiGate {
    static constexpr bool PERM = true;
    static constexpr int UI0 = 10;
    unsigned char* ws; const Params* P; int gw, NGW;
    __device__ __forceinline__ void operator()(AccRef acc, const Unit& u, int wr, int wc, int fr, int fq) const {
        asm volatile("" : "+v"(fr), "+v"(fq));
        const int row0 = u.pm * BM + wr * 64 + fr, cw = wc * 32 + 8 * fq;
        if (u.pn < 4) {
            bf16* vb = (bf16*)(ws + WS_V) + u.pn * BM;
#pragma unroll
            for (int ai = 0; ai < 2; ++ai)
#pragma unroll
                for (int m = 0; m < 4; ++m) { bf16* rowp = vb + (size_t)(row0 + ai * HALF + m * 16) * FW + cw;
#pragma unroll
                    for (int bj = 0; bj < 2; ++bj) *(u32x4*)(rowp + bj * HALF) = pack8(acc[ai][bj][m][0], acc[ai][bj][m][1]); }
        } else {
        unsigned char* base = ws + WS_GAB + (u.pn - 4) * BM;
#pragma unroll
        for (int ai = 0; ai < 2; ++ai)
#pragma unroll
            for (int m = 0; m < 4; ++m) { unsigned char* rowp = base + (size_t)(row0 + ai * HALF + m * 16) * 4096 + cw;
#pragma unroll
                for (int bj = 0; bj < 2; ++bj) { u32x2 w; w.x = q8x4(sig4(acc[ai][bj][m][0])); w.y = q8x4(sig4(acc[ai][bj][m][1])); *(u32x2*)(rowp + bj * HALF) = w; } }
        }
        { SidePair sp; side_load(*P, gw, NGW, UI0 + u.ui, (fq << 4) | fr, sp); side_store((fq << 4) | fr, sp); }
    }
};

template <int PASS> struct EpiMerge {
    static constexpr bool PERM = true;
    unsigned char* ws;
    __device__ __forceinline__ void operator()(AccRef acc, const Unit& u, int wr, int wc, int fr, int fq) const {
        asm volatile("" : "+v"(fr), "+v"(fq));
        const int row0 = u.pm * BM + wr * 64 + fr, c0 = u.pn * BM + wc * 32 + 8 * fq;
        const unsigned char* G = ws + WS_GAB + PASS * DM; bf16* MG = (bf16*)(ws + WS_MERGED);
#pragma unroll
        for (int ai = 0; ai < 2; ++ai)
#pragma unroll
            for (int m = 0; m < 4; ++m) { const size_t row = (size_t)(row0 + ai * HALF + m * 16);
#pragma unroll
                for (int bj = 0; bj < 2; ++bj) { const u32x2 gv = *(const u32x2*)(G + row * 4096 + c0 + bj * HALF);
                    f32x4 v0 = acc[ai][bj][m][0] * dq8x4(gv.x), v1 = acc[ai][bj][m][1] * dq8x4(gv.y);
                    if (PASS == 1) { const u32x4 tv = *(const u32x4*)(MG + row * DM + c0 + bj * HALF); v0 += bflo4(tv); v1 += bfhi4(tv); }
                    *(u32x4*)(MG + row * DM + c0 + bj * HALF) = pack8(v0, v1); } }
    }
};
struct EpiX1 {
    static constexpr bool PERM = true;
    const bf16* XB; const float* RS; bf16* XRB; unsigned char* X8;
    __device__ __forceinline__ void operator()(AccRef acc, const Unit& u, int wr, int wc, int fr, int fq) const {
        asm volatile("" : "+v"(fr), "+v"(fq));
        const int row0 = u.pm * BM + wr * 64 + fr, c0 = u.pn * BM + wc * 32 + 8 * fq;
#pragma unroll
        for (int ai = 0; ai < 2; ++ai)
#pragma unroll
            for (int m = 0; m < 4; ++m) { const int row = row0 + ai * HALF + m * 16; const size_t off = (size_t)row * DM + c0; const float ri = 1.0f / RS[row];
#pragma unroll
                for (int bj = 0; bj < 2; ++bj) { const u32x4 xv = *(const u32x4*)(XB + off + bj * HALF);
                    const f32x4 v0 = bflo4(xv) * ri + acc[ai][bj][m][0], v1 = bfhi4(xv) * ri + acc[ai][bj][m][1];
                    *(u32x4*)(XRB + off + bj * HALF) = pack8(v0, v1); *(u32x2*)(X8 + off + bj * HALF) = pack8_fp8(v0, v1); }
                if (m == 3) asm volatile("" ::: "memory"); }
    }
};
struct EpiPlain {
    static constexpr bool PERM = true;
    bf16* O; int ldc;
    __device__ __forceinline__ void operator()(AccRef acc, const Unit& u, int wr, int wc, int fr, int fq) const {
        asm volatile("" : "+v"(fr), "+v"(fq));
        const int row0 = u.pm * BM + wr * 64 + fr, c0 = u.pn * BM + wc * 32 + 8 * fq;
#pragma unroll
        for (int ai = 0; ai < 2; ++ai)
#pragma unroll
            for (int m = 0; m < 4; ++m) { bf16* rowp = O + (size_t)(row0 + ai * HALF + m * 16) * ldc + c0;
#pragma unroll
                for (int bj = 0; bj < 2; ++bj) *(u32x4*)(rowp + bj * HALF) = pack8(acc[ai][bj][m][0], acc[ai][bj][m][1]); }
    }
};
struct EpiPle {
    static constexpr bool PERM = true;
    const bf16* XRB; bf16* X3B; const bf16* PP; const float* RS;
    __device__ __forceinline__ void operator()(AccRef acc, const Unit& u, int wr, int wc, int fr, int fq) const {
        asm volatile("" : "+v"(fr), "+v"(fq));
        const int row0 = u.pm * BM + wr * 64 + fr, c0 = u.pn * BM + wc * 32 + 8 * fq;
#pragma unroll
        for (int ai = 0; ai < 2; ++ai)
#pragma unroll
            for (int m = 0; m < 4; ++m) { const int row = row0 + ai * HALF + m * 16; const size_t off = (size_t)row * DM + c0; const float r = RS[row];
#pragma unroll
                for (int bj = 0; bj < 2; ++bj) { const u32x4 pv = *(const u32x4*)(PP + off + bj * HALF), xv = *(const u32x4*)(XRB + off + bj * HALF);
                    *(u32x4*)(X3B + off + bj * HALF) = pack8(bflo4(xv) + sig4(acc[ai][bj][m][0] * r) * bflo4(pv), bfhi4(xv) + sig4(acc[ai][bj][m][1] * r) * bfhi4(pv)); }
                if (m == 3) asm volatile("" ::: "memory"); }
    }
};

struct SegOrder {
    const LAS int* tab;
    int nN, G, c, seg_lo, seg_hi, K, down; const char* A; const char* Bt; const int* TOKL;
    int L0 = 0, Lmax = 0x7fffffff;
    __device__ __forceinline__ int rd(int i) const { return __builtin_amdgcn_readfirstlane(tab[i]); }
    __device__ bool next(int i, Unit& u) const {
        const int m_lo = rd(64 + seg_lo), m_hi = rd(64 + seg_hi);
        const long L = (long)L0 + (long)i * G + c; if (c < 0 || L >= Lmax || L >= (long)(m_hi - m_lo) * nN) return false;
        const int mtile = m_lo + (int)(L / nN); u.pn = (int)(L % nN);
        int s = u.seg > seg_lo ? u.seg : seg_lo; while (s + 1 < seg_hi && rd(64 + s + 1) <= mtile) ++s;
        u.seg = s; u.mt = mtile - rd(64 + s); u.pm = 0; const int left = rd(s) - u.mt * BM; u.nrow = left < BM ? left : BM; u.slot0 = rd(129 + s) + u.mt * BM;
        const int e = s & 31;
        if (down) { u.a = A + (size_t)u.slot0 * K * 2; u.b = Bt + ((size_t)e * DM + (size_t)u.pn * BM) * K * 2; }
        else { u.a = A; u.b = Bt + ((size_t)e * 2 * FF + (size_t)u.pn * BM) * K * 2; }
        return true;
    }
    __device__ __forceinline__ unsigned arow(const Unit& u, int r) const {
        if (down) return (unsigned)r;
        const int rr = r < u.nrow ? r : u.nrow - 1;
        return (unsigned)TOKL[(size_t)u.seg * T + u.mt * BM + rr];
    }
};
struct EpiGU {
    static constexpr bool PERM = true;
    unsigned char* ws;
    __device__ __forceinline__ void operator()(AccRef acc, const Unit& u, int wr, int wc, int fr, int fq) const {
        asm volatile("" : "+v"(fr), "+v"(fq));
        const float2* SC = (const float2*)(ws + WS_SC) + (size_t)u.seg * T + u.mt * BM;
        unsigned char* H = ws + WS_HACT + (size_t)u.slot0 * FF + u.pn * HALF + wc * 32 + 8 * fq;
        float2 sc[2][4];
#pragma unroll
        for (int ai = 0; ai < 2; ++ai)
#pragma unroll
            for (int m = 0; m < 4; ++m) { const int r = ai * HALF + wr * 64 + m * 16 + fr; sc[ai][m] = SC[r < u.nrow ? r : 0]; }
#pragma unroll
        for (int ai = 0; ai < 2; ++ai)
#pragma unroll
            for (int m = 0; m < 4; ++m) { const int r = ai * HALF + wr * 64 + m * 16 + fr; const bool live = r < u.nrow; const float s1 = sc[ai][m].x, s2 = sc[ai][m].y;
                f32x4 g0 = acc[ai][0][m][0] * s1, g1 = acc[ai][0][m][1] * s1; const f32x4 u0 = acc[ai][1][m][0] * s2, u1 = acc[ai][1][m][1] * s2;
                g0 = g0 * sig4(g0) * u0; g1 = g1 * sig4(g1) * u1;
                { const f32x4 lo4 = (f32x4){-448.f, -448.f, -448.f, -448.f}, hi4 = (f32x4){448.f, 448.f, 448.f, 448.f}; g0 = __builtin_elementwise_min(__builtin_elementwise_max(g0, lo4), hi4); g1 = __builtin_elementwise_min(__builtin_elementwise_max(g1, lo4), hi4); }
                if (live) *(u32x2*)(H + (size_t)r * FF) = pack8_fp8(g0, g1); }
    }
};
template <bool LAST> struct EpiDN {
    static constexpr bool PERM = true;
    unsigned char* ws;
    __device__ __forceinline__ void operator()(AccRef acc, const Unit& u, int wr, int wc, int fr, int fq) const {
        asm volatile("" : "+v"(fr), "+v"(fq));
        const int* TOKL = (const int*)(ws + WS_TOKL) + (size_t)u.seg * T + u.mt * BM; bf16* XRB = (bf16*)(ws + WS_X1B); unsigned char* X8 = ws + WS_X2F8;
        const int c0 = u.pn * BM + wc * 32 + 8 * fq;
        int tok[2][4]; u32x4 xv[2][4][2];
#pragma unroll
        for (int ai = 0; ai < 2; ++ai)
#pragma unroll
            for (int m = 0; m < 4; ++m) { const int r = ai * HALF + wr * 64 + m * 16 + fr; tok[ai][m] = TOKL[r < u.nrow ? r : 0]; }
#pragma unroll
        for (int ai = 0; ai < 2; ++ai)
#pragma unroll
            for (int m = 0; m < 4; ++m)
#pragma unroll
                for (int bj = 0; bj < 2; ++bj) xv[ai][m][bj] = *(const u32x4*)(XRB + (size_t)tok[ai][m] * DM + c0 + bj * HALF);
#pragma unroll
        for (int ai = 0; ai < 2; ++ai)
#pragma unroll
            for (int m = 0; m < 4; ++m) { const int r = ai * HALF + wr * 64 + m * 16 + fr; const bool live = r < u.nrow; const size_t off = (size_t)tok[ai][m] * DM + c0;
#pragma unroll
                for (int bj = 0; bj < 2; ++bj) { const f32x4 v0 = bflo4(xv[ai][m][bj]) + acc[ai][bj][m][0], v1 = bfhi4(xv[ai][m][bj]) + acc[ai][bj][m][1];
                    if (live) { *(u32x4*)(XRB + off + bj * HALF) = pack8(v0, v1); if (LAST) *(u32x2*)(X8 + off + bj * HALF) = pack8_fp8(v0, v1); } } }
    }
};
}
using pg8::bflo4; using pg8::bfhi4;

namespace fox {
typedef short s16x4 __attribute__((ext_vector_type(4)));
typedef float f32x16 __attribute__((ext_vector_type(16)));
constexpr int D = 128, LDQ = 1024, NW = 8, QBLK = 32, KVBLK = 64, QB = NW * QBLK;
constexpr float SCALE = 0.08838834764831845f, INVS = 11.313708498984761f, THR = 8.f;
constexpr int SHM_V = KVBLK * D * 2, SHM_K = KVBLK * D * 2;
constexpr int OFF_WS = 2 * SHM_V + 2 * SHM_K, OFF_B = OFF_WS + NW * 64 * 4, LDS_ATT = OFF_B + SEQ * 4;
#define KSWZ(row, colB) ((row) * 256 + ((colB) ^ (((row) & 7) << 4)))
#define SBAR() __builtin_amdgcn_sched_barrier(0)
__device__ __forceinline__ int v_st(int k, int c) { const int kk = (k & ~0xC) | ((k & 4) << 1) | ((k & 8) >> 1); return ((kk >> 3) * 4 + (c >> 5)) * 512 + ((kk & 7) * 32 + (c & 31)) * 2; }
__device__ __forceinline__ int v_rd_base(int lane) { return ((lane & 3) << 3) | (((lane >> 2) & 3) << 6) | (((lane >> 4) & 1) << 5) | (((lane >> 5) & 1) << 8); }
constexpr int v_rd_off(int d0, int ks, int half) { return d0 * 512 + ks * 4096 + half * 2048; }
__device__ __forceinline__ int crow(int r, int hi) { return (r & 3) + 8 * (r >> 2) + 4 * hi; }
__device__ __forceinline__ unsigned cvtpk(float lo, float hi) { return cvt_pk_bf16(lo, hi); }
__device__ __forceinline__ void mask_tile(f32x16& p0, f32x16& p1, int dq) {
    const float NEG = -__builtin_inff();
#pragma unroll
    for (int r = 0; r < 16; ++r) { const int c = (r & 3) + 8 * (r >> 2);
        if (dq - c < 0) p0[r] = NEG;
        if (dq - c - 32 < 0) p1[r] = NEG; }
}
__device__ __forceinline__ void partialSM(f32x16& p0, f32x16& p1, float& m_reg, float& mn, float& alpha) {
    float pmax = p0[0];
#pragma unroll
    for (int r = 1; r < 16; ++r) pmax = fmaxf(pmax, p0[r]);
#pragma unroll
    for (int r = 0; r < 16; ++r) pmax = fmaxf(pmax, p1[r]);
    { auto rr = __builtin_amdgcn_permlane32_swap(__float_as_uint(pmax), __float_as_uint(pmax), false, false);
      pmax = fmaxf(__uint_as_float(rr[0]), __uint_as_float(rr[1])); }
    constexpr float C2 = 1.4426950408889634f * SCALE;
    if (__builtin_expect(__all((pmax - m_reg) * SCALE <= THR), 1)) { mn = m_reg; alpha = 1.f; }
    else { mn = fmaxf(m_reg, pmax); alpha = __builtin_amdgcn_exp2f((m_reg - mn) * C2); m_reg = mn; }
    const float mnL = -mn * C2;
#pragma unroll
    for (int r = 0; r < 16; ++r) p0[r] = fmaf(p0[r], C2, mnL);
#pragma unroll
    for (int r = 0; r < 16; ++r) p1[r] = fmaf(p1[r], C2, mnL);
#pragma unroll
    for (int r = 0; r < 16; ++r) p0[r] = __builtin_amdgcn_exp2f(p0[r]);
}
__device__ __forceinline__ void finishSM(f32x16& p0, f32x16& p1, float alpha, float& l_reg, bf16x8& pa0, bf16x8& pa1, bf16x8& pa2, bf16x8& pa3) {
#pragma unroll
    for (int r = 0; r < 16; ++r) p1[r] = __builtin_amdgcn_exp2f(p1[r]);
    float ps = 0;
#pragma unroll
    for (int r = 0; r < 16; ++r) ps += p0[r];
#pragma unroll
    for (int r = 0; r < 16; ++r) ps += p1[r];
    { auto rr = __builtin_amdgcn_permlane32_swap(__float_as_uint(ps), __float_as_uint(ps), false, false);
      ps = __uint_as_float(rr[0]) + __uint_as_float(rr[1]); }
    l_reg = l_reg * alpha + ps;
#define PK4(P, B_, OUT) do { unsigned a0 = cvtpk(P[B_+0], P[B_+1]), a1 = cvtpk(P[B_+2], P[B_+3]);                          \
        unsigned b0 = cvtpk(P[B_+4], P[B_+5]), b1 = cvtpk(P[B_+6], P[B_+7]);                                             \
        auto r0 = __builtin_amdgcn_permlane32_swap(a0, b0, false, false); auto r1 = __builtin_amdgcn_permlane32_swap(a1, b1, false, false); \
        u32x4 w = {r0[0], r1[0], r0[1], r1[1]}; OUT = __builtin_bit_cast(bf16x8, w); } while (0)
    PK4(p0, 0, pa0); PK4(p0, 8, pa1); PK4(p1, 0, pa2); PK4(p1, 8, pa3);
#undef PK4
}
template <int KB>
__device__ __forceinline__ void qkt(f32x16& p0, f32x16& p1, const char* K_lds, const char* bias_t, int r32, int hi, const bf16x8* qr) {
    const f32x4* bl = (const f32x4*)(bias_t + hi * 16);
#pragma unroll
    for (int q = 0; q < 4; ++q) { const f32x4 b0 = bl[2 * q], b1 = bl[8 + 2 * q];
        p0[4 * q] = b0.x; p0[4 * q + 1] = b0.y; p0[4 * q + 2] = b0.z; p0[4 * q + 3] = b0.w;
        p1[4 * q] = b1.x; p1[4 * q + 1] = b1.y; p1[4 * q + 2] = b1.z; p1[4 * q + 3] = b1.w; }
    const char* kb[4];
#pragma unroll
    for (int dd = 0; dd < 4; ++dd) kb[dd] = K_lds + KB * SHM_K + KSWZ(r32, (dd * 16 + hi * 8) * 2);
#pragma unroll
    for (int d0 = 0; d0 < 8; ++d0) { const char* a = kb[d0 & 3] + (d0 >> 2) * 128;
        bf16x8 b0 = *reinterpret_cast<const bf16x8*>(a);
        bf16x8 b1 = *reinterpret_cast<const bf16x8*>(a + 32 * 256);
        p0 = __builtin_amdgcn_mfma_f32_32x32x16_bf16(b0, qr[d0], p0, 0, 0, 0);
        p1 = __builtin_amdgcn_mfma_f32_32x32x16_bf16(b1, qr[d0], p1, 0, 0, 0); }
}
template <int VB>
__device__ __forceinline__ void pv_tile(f32x16* o, int vb0, bf16x8 pa0, bf16x8 pa1, bf16x8 pa2, bf16x8 pa3) {
#define TRRD(dst, off) asm volatile("ds_read_b64_tr_b16 %0, %1 offset:%2" : "=&v"(dst) : "v"(vb0), "i"(off) : "memory")
#define PV_D0(d0) do { s16x4 l0, l1, l2, l3, h0, h1, h2, h3; constexpr int b_ = VB * SHM_V + v_rd_off(d0, 0, 0);   \
        TRRD(l0, b_); TRRD(h0, b_ + 2048); TRRD(l1, b_ + 4096); TRRD(h1, b_ + 6144); TRRD(l2, b_ + 8192); TRRD(h2, b_ + 10240); TRRD(l3, b_ + 12288); TRRD(h3, b_ + 14336); \
        asm volatile("s_waitcnt lgkmcnt(0)" ::: "memory"); SBAR();   \
        o[d0] = __builtin_amdgcn_mfma_f32_32x32x16_bf16(pa0, (bf16x8){l0[0], l0[1], l0[2], l0[3], h0[0], h0[1], h0[2], h0[3]}, o[d0], 0, 0, 0);   \
        o[d0] = __builtin_amdgcn_mfma_f32_32x32x16_bf16(pa1, (bf16x8){l1[0], l1[1], l1[2], l1[3], h1[0], h1[1], h1[2], h1[3]}, o[d0], 0, 0, 0);   \
        o[d0] = __builtin_amdgcn_mfma_f32_32x32x16_bf16(pa2, (bf16x8){l2[0], l2[1], l2[2], l2[3], h2[0], h2[1], h2[2], h2[3]}, o[d0], 0, 0, 0);   \
        o[d0] = __builtin_amdgcn_mfma_f32_32x32x16_bf16(pa3, (bf16x8){l3[0], l3[1], l3[2], l3[3], h3[0], h3[1], h3[2], h3[3]}, o[d0], 0, 0, 0); } while (0)
    PV_D0(0); PV_D0(1); PV_D0(2); PV_D0(3);
#undef PV_D0
#undef TRRD
}
struct BlockRef { const bf16* K; const float* C; int P0, jlo; float cref;
    __device__ __forceinline__ const bf16* Kp() const { return K; }
    __device__ __forceinline__ const bf16* Vp() const { return K + (WS_V - WS_K) / 2; }
    __device__ __forceinline__ const bf16* Qp() const { return K - (WS_K - WS_Q) / 2 + (size_t)P0 * LDQ; }
    __device__ __forceinline__ bf16* Op() const { return const_cast<bf16*>(Qp()); } };
struct Seam { bf16x8 qr[8]; bf16x8 st_v0, st_v1, st_k0, st_k1; };
__device__ __forceinline__ bf16x8 load8(const bf16* p) { return *reinterpret_cast<const bf16x8*>(p); }
#define ROW(p, k0, rr) ((p) + (size_t)((k0) + (rr)) * LDQ + sc)
#define VMW() asm volatile("s_waitcnt vmcnt(0)" ::: "memory")
#define VMWN(n) asm volatile("s_waitcnt vmcnt(%0)" :: "i"(n) : "memory")
#define SLOAD_H(Kp, Vp, k0) do { S.st_v0 = load8(ROW(Vp, k0, sr)); S.st_v1 = load8(ROW(Vp, k0, 32 + sr));              \
                         S.st_k0 = load8(ROW(Kp, k0, sr)); S.st_k1 = load8(ROW(Kp, k0, 32 + sr)); } while (0)
#define SWRITE_HK(bf) do { *(bf16x8*)(K_lds + (bf) * SHM_K + kws) = S.st_k0; *(bf16x8*)(K_lds + (bf) * SHM_K + kws + 32 * 256) = S.st_k1; } while (0)
#define SWRITE_HV(bf) do { *(bf16x8*)(V_lds + (bf) * SHM_V + vst0) = S.st_v0; *(bf16x8*)(V_lds + (bf) * SHM_V + vst1) = S.st_v1; } while (0)
#define SWRITE_H(bf) do { SWRITE_HV(bf); SWRITE_HK(bf); } while (0)
#define BIAS_FILL(ref_) do { int k_ = (int)threadIdx.x * 4; asm volatile("" : "+v"(k_)); const int kb_ = (ref_).jlo * KVBLK; for (; kb_ + k_ < (ref_).P0 + QB; k_ += NW * 64 * 4) *(f32x4*)(B_lds + k_ * 4) = ((ref_).cref - *(const f32x4*)((ref_).C + kb_ + k_)) * INVS; } while (0)
__device__ __forceinline__ void prime(const BlockRef& cur, char* lds, Seam& S) {
    const int tid = threadIdx.x, wid = __builtin_amdgcn_readfirstlane(tid >> 6), lane = tid & 63, r32 = lane & 31, hi = lane >> 5;
    const int sr = tid >> 4, sc = (tid & 15) * 8, kws = KSWZ(sr, sc * 2); char* K_lds = lds + 2 * SHM_V; char* B_lds = lds + OFF_B;
#pragma unroll
    for (int d0 = 0; d0 < 8; ++d0) S.qr[d0] = load8(cur.Qp() + (size_t)(wid * QBLK + r32) * LDQ + d0 * 16 + hi * 8);
    SLOAD_H(cur.Kp(), cur.Vp(), cur.jlo * KVBLK); BIAS_FILL(cur); VMW(); SWRITE_HK(0);
    __syncthreads();
}
__device__ __forceinline__ BlockRef ref(int k, unsigned char* ws, const char* lds);
__device__ __forceinline__ void block(const BlockRef& cur, BlockRef& nxt, bool& has_nxt, char* lds, Seam& S, unsigned* ctr, volatile int* slot, unsigned char* gws) {
    const int tid = threadIdx.x, wid = __builtin_amdgcn_readfirstlane(tid >> 6), lane = tid & 63, r32 = lane & 31, hi = lane >> 5;
    const int j_lo = cur.jlo, NT = (cur.P0 + QB) / KVBLK - j_lo;
    const int qlo = cur.P0 + wid * QBLK, qm = qlo + r32 - 4 * hi;
    char* V_lds = lds; char* K_lds = lds + 2 * SHM_V; char* B_lds = lds + OFF_B;
    float* ws = (float*)(lds + OFF_WS) + wid * 64; float* li_l = ws, * al_l = ws + 32;
    float m_reg = -1e30f, l_reg = 0; f32x16 o[4] = {};
    const int sr = tid >> 4, sc = (tid & 15) * 8, vst0 = v_st(sr, sc), vst1 = v_st(32 + sr, sc), kws = KSWZ(sr, sc * 2);
    const int vb0 = (int)(uintptr_t)V_lds + v_rd_base(lane);
    const bf16* Kh = cur.Kp(); const bf16* Vh = cur.Vp();
#define RESC(a) do { if (__any((a) < 1.f)) { if (hi == 0) al_l[r32] = (a); asm volatile("s_waitcnt lgkmcnt(0)" ::: "memory");              \
                     for (int d_ = 0; d_ < 4; ++d_) for (int r = 0; r < 16; ++r) o[d_][r] *= al_l[crow(r, hi)]; } } while (0)
#define KBASE(t) ((j_lo + (t)) * KVBLK)
#define MASKT(P0_, P1_, t) do { const int kb_ = KBASE(t); if (kb_ + KVBLK - 1 > qlo) mask_tile(P0_, P1_, qm - kb_); } while (0)
    constexpr int NQL = 8;
#define SEAM_K0() do { VMWN(NQL); SWRITE_HK(0); SBAR(); } while (0)
    f32x16 pA0, pA1, pB0, pB1; float mnA, mnB, alA, alB; bf16x8 pa0, pa1, pa2, pa3;
    SWRITE_HV(0); SBAR();
    SLOAD_H(Kh, Vh, KBASE(1));
    SBAR(); qkt<0>(pA0, pA1, K_lds, B_lds, r32, hi, S.qr);
    MASKT(pA0, pA1, 0); partialSM(pA0, pA1, m_reg, mnA, alA);
    VMW(); SWRITE_H(1);
    __syncthreads();
#define HALF_STEP(PX0, PX1, mnX, alX, PY0, PY1, alY, t, KB, VB, SB) do {                                                      \
        SBAR(); qkt<KB>(PX0, PX1, K_lds, B_lds + (t) * 256, r32, hi, S.qr);                                             \
        finishSM(PY0, PY1, alY, l_reg, pa0, pa1, pa2, pa3); SBAR();                                                           \
        if ((t) + 1 < NT) { SLOAD_H(Kh, Vh, KBASE((t) + 1)); SBAR(); }                                               \
        pv_tile<VB>(o, vb0, pa0, pa1, pa2, pa3); MASKT(PX0, PX1, (t)); partialSM(PX0, PX1, m_reg, mnX, alX);                                        \
        __syncthreads();                                                                                                      \
        if ((t) + 1 < NT) { VMW(); SWRITE_H(SB); }                                                                          \
        RESC(alX); __syncthreads(); } while (0)
    for (int t = 1; t + 1 < NT; t += 2) {
        unsigned tk = 0u; const bool claim = (t + 3 >= NT) && tid == 0;
        if (claim) tk = atomicAdd(ctr, 1u);
        HALF_STEP(pB0, pB1, mnB, alB, pA0, pA1, alA, t, 1, 0, 0);
        if (claim) slot[0] = (int)tk;
        HALF_STEP(pA0, pA1, mnA, alA, pB0, pB1, alB, t + 1, 0, 1, 1);
    }
    { const int kn = __builtin_amdgcn_readfirstlane(slot[0]); has_nxt = kn < BATCH * NH * 16; nxt = has_nxt ? ref(kn, gws, lds) : cur; }
    SBAR(); qkt<1>(pB0, pB1, K_lds, B_lds + (NT - 1) * 256, r32, hi, S.qr); SBAR();
    SLOAD_H(nxt.Kp(), nxt.Vp(), nxt.jlo * KVBLK); SBAR();
#pragma unroll
    for (int d0 = 0; d0 < 8; ++d0) S.qr[d0] = load8(nxt.Qp() + (size_t)(wid * QBLK + r32) * LDQ + d0 * 16 + hi * 8);
    SBAR();
    finishSM(pA0, pA1, alA, l_reg, pa0, pa1, pa2, pa3); SBAR();
    pv_tile<0>(o, vb0, pa0, pa1, pa2, pa3);
    MASKT(pB0, pB1, NT - 1); partialSM(pB0, pB1, m_reg, mnB, alB); __syncthreads(); RESC(alB);
    finishSM(pB0, pB1, alB, l_reg, pa0, pa1, pa2, pa3); SBAR(); pv_tile<1>(o, vb0, pa0, pa1, pa2, pa3);
    SBAR(); SEAM_K0();
    if (hi == 0) li_l[r32] = l_reg; asm volatile("s_waitcnt lgkmcnt(0)" ::: "memory");
    float rli[16];
#pragma unroll
    for (int r = 0; r < 16; ++r) rli[r] = __builtin_amdgcn_rcpf(li_l[crow(r, hi)]);
    bf16* Ow = cur.Op() + (size_t)(wid * QBLK) * LDQ;
#pragma unroll
    for (int r = 0; r < 16; ++r) { const int orow = crow(r, hi);
#pragma unroll
        for (int d0 = 0; d0 < 4; ++d0) { const float v = o[d0][r] * rli[r];
            const float vn = __shfl_xor(v, 1);
            if ((r32 & 1) == 0) *(unsigned*)(Ow + (size_t)orow * LDQ + d0 * 32 + r32) = cvtpk(v, vn); } }
    BIAS_FILL(nxt);
    __syncthreads();
#undef RESC
#undef KBASE
#undef MASKT
#undef SEAM_K0
#undef HALF_STEP
}
#undef ROW
#undef VMW
#undef VMWN
#undef SLOAD_H
#undef SWRITE_HK
#undef SWRITE_HV
#undef SWRITE_H
#undef BIAS_FILL
#undef KSWZ
#undef SBAR
constexpr int ORD_OFF = 86016, CJ_OFF = 88064, CNTS_OFF = 104448, TOT_OFF = 106496, SK_OFF = 108544;
__device__ __forceinline__ void build_order(char* lds, unsigned char* ws) {
    const int tid = threadIdx.x, lane = tid & 63, wid = tid >> 6;
    float* cj = (float*)(lds + CJ_OFF); int* cnt = (int*)(lds + CNTS_OFF); int* tot = (int*)(lds + TOT_OFF); unsigned short* ord = (unsigned short*)(lds + ORD_OFF);
    const float* CUM = (const float*)(ws + WS_CUM); float* sk = (float*)(lds + SK_OFF);
    const float* NQq = (const float*)(ws + WS_NQ); const float* NQk = NQq + 512 * NH * 4;
#pragma unroll
    for (int k = 0; k < 8; ++k) { const int idx = tid + 512 * k, bh_ = idx >> 6, j_ = idx & 63; cj[idx] = CUM[(size_t)bh_ * SEQ + 64 * j_ + 63];
        const f32x4 kp = *(const f32x4*)(NQk + ((size_t)((bh_ / NH) * 64 + j_) * NH + (bh_ % NH)) * 4); sk[idx] = sqrtf((kp.x + kp.y) + (kp.z + kp.w)); }
    cnt[tid] = 0;
    __syncthreads();
    int cls[2], rnk[2], jl[2];
#pragma unroll
    for (int p = 0; p < 2; ++p) {
        const int i = p * 512 + tid, bh = i >> 4, qb = i & 15;
        float q2 = 0.f, kd = 0.f;
#pragma unroll
        for (int g = 0; g < 4; ++g) { const f32x4 qp = *(const f32x4*)(NQq + ((size_t)((bh / NH) * 64 + 4 * qb + g) * NH + (bh % NH)) * 4); q2 = fmaxf(q2, (qp.x + qp.y) + (qp.z + qp.w)); kd = fmaxf(kd, sk[bh * 64 + 4 * qb + g]); }
        const float sq = sqrtf(q2) * SCALE;
        const float lim = CUM[(size_t)bh * SEQ + qb * QB] + sq * kd + 8.4f + 17.0f;
        int lo = 0;
        while (lo < 4 * qb && cj[bh * 64 + lo] >= lim + sq * sk[bh * 64 + lo]) ++lo;
        lo &= ~1;
        const int cl = ((4 * (qb + 1) - lo) >> 1) - 1;
        cls[p] = cl; rnk[p] = 0; jl[p] = lo >> 1;
        unsigned long long rem = __ballot(1);
        while (rem) {
            const int c0 = __builtin_amdgcn_readlane(cl, (int)__builtin_ctzll(rem));
            const unsigned long long m = __ballot(cl == c0);
            if (cl == c0) { rnk[p] = __builtin_popcountll(m & ((1ull << lane) - 1ull)); if ((m & ((1ull << lane) - 1ull)) == 0ull) cnt[(p * 8 + wid) * 32 + c0] = __builtin_popcountll(m); }
            rem &= ~m;
        }
    }
    __syncthreads();
    if (tid < 32) { int t = 0; for (int c = 0; c < 16; ++c) t += cnt[c * 32 + tid]; tot[tid] = t; }
    __syncthreads();
#pragma unroll
    for (int p = 0; p < 2; ++p) {
        const int ch = p * 8 + wid; int base = rnk[p];
        for (int c = cls[p] + 1; c < 32; ++c) base += tot[c];
        for (int c = 0; c < ch; ++c) base += cnt[c * 32 + cls[p]];
        ord[base] = (unsigned short)((p * 512 + tid) | (jl[p] << 10));
    }
    __syncthreads();
}
__device__ __forceinline__ BlockRef ref(int k, unsigned char* ws, const char* lds) {
    const int e = __builtin_amdgcn_readfirstlane((int)((const unsigned short*)(lds + ORD_OFF))[k]);
    const int i = e & 1023, bh = i >> 4, qb = i & 15, b = bh / NH, h = bh % NH;
    BlockRef r; r.K = (const bf16*)(ws + WS_K) + (size_t)b * SEQ * LDQ + h * D; r.C = (const float*)(ws + WS_CUM) + (size_t)bh * SEQ; r.P0 = qb * QB; r.cref = r.C[r.P0];
    r.jlo = (e >> 10) * 2;
    return r;
}
__device__ __forceinline__ void attn_phase(char* lds, unsigned char* ws, volatile int* slot) {
    constexpr int TOTAL = BATCH * NH * 16;
    unsigned* ctr = (unsigned*)(ws + WS_CTL) + CW_ATT;
    build_order(lds, ws);
    if (threadIdx.x == 0) slot[0] = (int)atomicAdd(ctr, 1u);
    __syncthreads();
    const int i0 = __builtin_amdgcn_readfirstlane(slot[0]);
    __syncthreads();
    if (i0 >= TOTAL) return;
    BlockRef cur = ref(i0, ws, lds), nxt = cur; bool has_nxt = false;
    Seam S;
    prime(cur, lds, S);
    for (;;) {
        block(cur, nxt, has_nxt, lds, S, ctr, slot, ws);
        if (!has_nxt) break;
        cur = nxt;
    }
}
}
__device__ __forceinline__ int tid_now() { int t = (int)threadIdx.x; asm volatile("" : "+v"(t)); return t; }
struct Frame {
    LAS unsigned char* lds; volatile LAS unsigned* MISC; unsigned* ctl;
    int tid, lane, wave, vcu, G;
};

__device__ __forceinline__ void xitem_load(const XItem& it, int lane, f32x4 (&v)[8]) {
    const int nq = lane & 7, ko = lane >> 3; const float* s = it.src + (size_t)(8 * ko) * it.ldw + 4 * nq;
#pragma unroll
    for (int j = 0; j < 8; ++j) v[j] = *(const f32x4*)(s + (size_t)j * it.ldw);
}
__device__ __forceinline__ void xitem_store(const XItem& it, int lane, const f32x4 (&v)[8]) {
    const int nq = lane & 7, ko = lane >> 3;
    f32x4 g0 = (f32x4){1.f, 1.f, 1.f, 1.f}, g1 = g0;
    if (it.gain) { g0 = *(const f32x4*)(it.gain + 8 * ko); g1 = *(const f32x4*)(it.gain + 8 * ko + 4); }
    if (it.fp8) { g0 *= 64.0f; g1 *= 64.0f; }
    if (it.fp8) { unsigned char* d = it.dst + (size_t)(4 * nq) * it.K + 8 * ko;
#pragma unroll
        for (int e = 0; e < 4; ++e) *(u32x2*)(d + (size_t)e * it.K) = pack8_fp8((f32x4){v[0][e] * g0.x, v[1][e] * g0.y, v[2][e] * g0.z, v[3][e] * g0.w}, (f32x4){v[4][e] * g1.x, v[5][e] * g1.y, v[6][e] * g1.z, v[7][e] * g1.w});
    } else { bf16* d = (bf16*)it.dst + (size_t)(4 * nq) * it.K + 8 * ko;
#pragma unroll
        for (int e = 0; e < 4; ++e) { u32x4 o; o.x = pk2(v[0][e] * g0.x, v[1][e] * g0.y); o.y = pk2(v[2][e] * g0.z, v[3][e] * g0.w); o.z = pk2(v[4][e] * g1.x, v[5][e] * g1.y); o.w = pk2(v[6][e] * g1.z, v[7][e] * g1.w);
            *(u32x4*)(d + (size_t)e * it.K) = o; } }
}
__device__ __forceinline__ int win_src_col(int n0) {
    if (n0 < 3072) return C_Q + n0;
    if (n0 < 5120) { const int j = (n0 - 3072) >> 8, w = (n0 - 3072) & 255; return w < 128 ? C_U + 128 * j + w : C_CG + 128 * j + (w - 128); }
    if (n0 < 6144) return C_BG + (n0 - 5120);
    return C_GA + (n0 - 6144);
}
constexpr int XI_IN = 32 * 320, XI_SIDE = 16 * 64 + 16 * 64 + 32 * 64 + 32 * 64 + 4 * 64 + 32 * 32 * 32 + 32 * 8 * 64;
__device__ __forceinline__ XItem xitem_of(const Params& P, int r) {
    unsigned char* ws = P.ws;
    constexpr int I_A = 16 * 64, I_B = 16 * 64, I_OUT = 32 * 64, I_PG = 32 * 64, I_PE = 4 * 64, I_GU = 32 * 32 * 32;
    XItem it; it.fp8 = 0; it.gain = nullptr;
    if (r < XI_IN) { const int kb = r / 320, g = r % 320; it.src = P.w_in + (size_t)(64 * kb) * IN_COLS + win_src_col(32 * g); it.ldw = IN_COLS; it.gain = P.g_mix + 64 * kb; it.K = DM; const int n0 = 32 * g;
        if (n0 >= 2048 && n0 < 3072) { it.fp8 = 1; it.dst = ws + WS_WT_IN8 + (size_t)(n0 - 2048) * DM + 64 * kb; }
        else if (n0 >= 6144) { it.fp8 = 1; it.dst = ws + WS_WT_IN8 + (size_t)(1024 + n0 - 6144) * DM + 64 * kb; }
        else it.dst = ws + WS_WT_IN + ((size_t)(n0 < 2048 ? n0 : n0 - 1024) * DM + 64 * kb) * 2;
        return it; } r -= XI_IN;
    if (r < I_A) { const int kb = r / 64, g = r % 64; it.src = P.w_a + (size_t)(64 * kb) * DM + 32 * g; it.ldw = DM; it.K = FW; it.dst = ws + WS_WT_A + ((size_t)(32 * g) * FW + 64 * kb) * 2; return it; } r -= I_A;
    if (r < I_B) { const int kb = r / 64, g = r % 64; it.src = P.w_b + (size_t)(64 * kb) * DM + 32 * g; it.ldw = DM; it.K = CW; it.dst = ws + WS_WT_B + ((size_t)(32 * g) * CW + 64 * kb) * 2; return it; } r -= I_B;
    if (r < I_OUT) { const int kb = r / 64, g = r % 64; it.src = P.w_out + (size_t)(64 * kb) * DM + 32 * g; it.ldw = DM; it.K = DM; it.dst = ws + WS_WT_OUT + ((size_t)(32 * g) * DM + 64 * kb) * 2; return it; } r -= I_OUT;
    if (r < I_PG) { const int kb = r / 64, g = r % 64; it.src = P.w_pg + (size_t)(64 * kb) * DM + 32 * g; it.ldw = DM; it.gain = P.g_ple + 64 * kb; it.K = DM; it.fp8 = 1; it.dst = ws + WS_WT_PG + (size_t)(32 * g) * DM + 64 * kb; return it; } r -= I_PG;
    if (r < I_PE) { const int kb = r / 64, g = r % 64; it.src = P.w_pe + (size_t)(64 * kb) * DM + 32 * g; it.ldw = DM; it.K = PLE; it.dst = ws + WS_WT_PE + ((size_t)(32 * g) * PLE + 64 * kb) * 2; return it; } r -= I_PE;
    if (r < I_GU) { const int e = r / 1024, kb = (r % 1024) / 32, g = r % 32, n0 = 32 * g, j = n0 >> 8, w = n0 & 255; const int sc = w < 128 ? 128 * j + w : FF + 128 * j + (w - 128);
        it.src = P.w_gu + (size_t)e * DM * 2 * FF + (size_t)(64 * kb) * (2 * FF) + sc; it.ldw = 2 * FF; it.gain = P.g_ffn + 64 * kb; it.K = DM; it.fp8 = 1; it.dst = ws + WS_WT_GU + (size_t)e * 2 * FF * DM + (size_t)n0 * DM + 64 * kb; return it; } r -= I_GU;
    { const int e = r / 512, kb = (r % 512) / 64, g = r % 64; it.src = P.w_dn + (size_t)e * FF * DM + (size_t)(64 * kb) * DM + 32 * g; it.ldw = DM; it.K = FF; it.fp8 = 1; it.dst = ws + WS_WT_DN + (size_t)e * DM * FF + (size_t)(32 * g) * FF + 64 * kb; return it; }
}
__device__ __forceinline__ void xitem_pair(const Params& P, int r0, int r1, int lane) {
    const XItem a = xitem_of(P, r0); const XItem b = xitem_of(P, r1 >= 0 ? r1 : r0);
    f32x4 va[8], vb[8];
    xitem_load(a, lane, va); xitem_load(b, lane, vb);
    xitem_store(a, lane, va); if (r1 >= 0) xitem_store(b, lane, vb);
}
__device__ __forceinline__ void p0_weights(const Params& P, const Frame& F) {
    const int lane = tid_now() & 63;
    const int gw = F.vcu * NWAVES + F.wave, NGW = F.G * NWAVES;
    for (int r = gw; r < XI_IN; r += 2 * NGW) xitem_pair(P, r, r + NGW < XI_IN ? r + NGW : -1, lane);
}
__device__ __forceinline__ void side_load(const Params& P, int gw, int NGW, int k, int lane, SidePair& sp) {
    const int r0 = gw + 2 * k * NGW, r1 = r0 + NGW; sp.n = r0 < XI_SIDE ? (r1 < XI_SIDE ? 2 : 1) : 0;
    if (sp.n > 0) { sp.a = xitem_of(P, XI_IN + r0); sp.b = xitem_of(P, XI_IN + (sp.n > 1 ? r1 : r0)); xitem_load(sp.a, lane, sp.va); xitem_load(sp.b, lane, sp.vb); }
}
__device__ __forceinline__ void side_store(int lane, const SidePair& sp) {
    if (sp.n > 0) xitem_store(sp.a, lane, sp.va);
    if (sp.n > 1) xitem_store(sp.b, lane, sp.vb);
}
__device__ __forceinline__ void p0_rowstats(const Params& P, const Frame& F) {
    unsigned char* ws = P.ws; float* rstd1 = (float*)(ws + WS_RSTD1); float* logf = (float*)(ws + WS_LOGF); bf16* XB = (bf16*)(ws + WS_XB);
    const int tid = tid_now(), lane = tid & 63;
    LAS f32x4* wfA = (LAS f32x4*)(F.lds + RING_OFF); LAS f32x4* wfB = wfA + DM;
    for (int k = tid; k < DM; k += NWAVES * 64) { const f32x4* w = (const f32x4*)(P.w_in + (size_t)k * IN_COLS + C_F); const float g = P.g_mix[k];
        const int s = (((k >> 8) * 4 + (k & 3)) << 6) + ((k >> 2) & 63); wfA[s] = w[0] * g; wfB[s] = w[1] * g; }
    __syncthreads();
    const int gw = F.vcu * NWAVES + F.wave, ngw = F.G * NWAVES;
    f32x4 nv[8];
    if (gw < T) { const f32x4* xr = (const f32x4*)(P.x + (size_t)gw * DM) + lane;
#pragma unroll
        for (int j = 0; j < 8; ++j) nv[j] = xr[64 * j]; }
    for (int t = gw; t < T; t += ngw) {
        f32x4 v[8]; float ss = 0.f;
#pragma unroll
        for (int j = 0; j < 8; ++j) v[j] = nv[j];
        if (t + ngw < T) { const f32x4* xr = (const f32x4*)(P.x + (size_t)(t + ngw) * DM) + lane;
#pragma unroll
            for (int j = 0; j < 8; ++j) nv[j] = xr[64 * j]; }
#pragma unroll
        for (int j = 0; j < 8; ++j) ss += (v[j].x * v[j].x + v[j].y * v[j].y) + (v[j].z * v[j].z + v[j].w * v[j].w);
        ss = wave_sum(ss);
        const float rstd = 1.0f / sqrtf(ss * (1.0f / DM) + EPS);
        u32x2* xo = (u32x2*)(XB + (size_t)t * DM) + lane;
#pragma unroll
        for (int j = 0; j < 8; ++j) { u32x2 w; w.x = pk2(v[j].x * rstd, v[j].y * rstd); w.y = pk2(v[j].z * rstd, v[j].w * rstd); xo[64 * j] = w; }
        { unsigned* x8 = (unsigned*)(ws + WS_XB8 + (size_t)t * DM) + lane; const float r8 = rstd * 8.0f;
#pragma unroll
          for (int j = 0; j < 8; ++j) { int q = __builtin_amdgcn_cvt_pk_fp8_f32(v[j].x * r8, v[j].y * r8, 0, false); q = __builtin_amdgcn_cvt_pk_fp8_f32(v[j].z * r8, v[j].w * r8, q, true); x8[64 * j] = (unsigned)q; } }
        f32x4 fa = (f32x4){0.f, 0.f, 0.f, 0.f}, fb = fa;
        int lo = lane; asm volatile("" : "+v"(lo));
#pragma unroll
        for (int j = 0; j < 8; ++j)
#pragma unroll
            for (int e = 0; e < 4; ++e) { const int s = ((j * 4 + e) << 6) + lo; fa += wfA[s] * v[j][e]; fb += wfB[s] * v[j][e]; }
        float r;
        { const bool b0 = lane & 1, b1 = lane & 2, b2 = lane & 4;
          const f32x4 keep = b0 ? fb : fa, send = b0 ? fa : fb;
          const float g0 = keep.x + __shfl_xor(send.x, 1), g1 = keep.y + __shfl_xor(send.y, 1), g2 = keep.z + __shfl_xor(send.z, 1), g3 = keep.w + __shfl_xor(send.w, 1);
          const float h0 = (b1 ? g2 : g0) + __shfl_xor(b1 ? g0 : g2, 2), h1 = (b1 ? g3 : g1) + __shfl_xor(b1 ? g1 : g3, 2);
          r = (b2 ? h1 : h0) + __shfl_xor(b2 ? h0 : h1, 4);
          r += __shfl_xor(r, 8); r += __shfl_xor(r, 16); r += __shfl_xor(r, 32); }
        if (lane < 8) { const int o = ((lane & 1) << 2) | (lane & 2) | ((lane >> 2) & 1);
            const float a = r * rstd + P.b_f[o]; logf[(size_t)t * 8 + o] = fminf(a, 0.f) - log1pf(__expf(-fabsf(a)));
            if (lane == 0) rstd1[t] = rstd; }
    }
    __syncthreads();
}
__device__ __forceinline__ void p0_pcast(const Params& P, const Frame& F) {
    const long gt = (long)F.vcu * (NWAVES * 64) + tid_now(), ngt = (long)F.G * NWAVES * 64;
    bf16* PB = (bf16*)(P.ws + WS_PB);
    for (long i = gt; i < (long)T * PLE / 8; i += ngt) { const f32x4 a = *(const f32x4*)(P.p + i * 8), b = *(const f32x4*)(P.p + i * 8 + 4);
        u32x4 o; o.x = pk2(a.x, a.y); o.y = pk2(a.z, a.w); o.z = pk2(b.x, b.y); o.w = pk2(b.z, b.w); *(u32x4*)(PB + i * 8) = o; }
}


__device__ __forceinline__ void p0_router_weights(const Params& P, const Frame& F) {
    const int gt = F.vcu * (NWAVES * 64) + tid_now(), ngt = F.G * NWAVES * 64;
    bf16* WRH = (bf16*)(P.ws + WS_WRH); bf16* WRL = (bf16*)(P.ws + WS_WRL);
    for (int i = gt; i < 48 * DM; i += ngt) { const int n = i / DM, k = i % DM;
        float v = 0.f; if (n < NE) v = P.w_re[(size_t)k * NE + n]; else if (n < NE + NGRP) v = P.w_rg[(size_t)k * NGRP + (n - NE)];
        v *= P.g_ffn[k]; const unsigned h = f2bf(v); const float lo = v - bf2f((unsigned short)h);
        WRH[i] = (bf16)h; WRL[i] = (bf16)f2bf(lo); }
}
__device__ __forceinline__ void router_mfma(const Params& P, const Frame& F) {
    unsigned char* ws = P.ws; const int tid = tid_now(), lane = tid & 63, r16 = lane & 15, kq = lane >> 4;
    const int gw = F.vcu * NWAVES + F.wave, NGW = F.G * NWAVES;
    const bf16* WRH = (const bf16*)(ws + WS_WRH); const bf16* WRL = (const bf16*)(ws + WS_WRL);
    int* EID = (int*)(ws + WS_EID); float* WTS = (float*)(ws + WS_WTS); int* POS = (int*)(ws + WS_POS); int* TOKL = (int*)(ws + WS_TOKL); float* RSTD2 = (float*)(ws + WS_RSTD2);
    unsigned* CNT = F.ctl + CW_CNT;
    LAS float* L = (LAS float*)(F.lds + RING_OFF + F.wave * 8192);
    LAS int* lcnt = (LAS int*)(F.lds + RING_OFF + 65536); LAS int* gbase = lcnt + 64;
    (void)gw; (void)NGW;
    for (int task0 = F.vcu * 4; task0 < T / 32; task0 += F.G * 4) {
        const int task = task0 + F.wave; const bool active = F.wave < 4;
        if (tid < 64) lcnt[tid] = 0;
        __syncthreads();
        int t = 0, s0 = 0, s1 = 0, lp0 = 0, lp1 = 0; float rstd = 0.f, wa = 0.f, wb = 0.f;
        if (active) {
        const bf16* xr = (const bf16*)(ws + WS_X1B) + (size_t)(task * 32 + r16) * DM + 8 * kq;
        const bf16* wh = WRH + (size_t)r16 * DM + 8 * kq; const bf16* wl = WRL + (size_t)r16 * DM + 8 * kq;
        f32x4 acc[2][3]; float ss0 = 0.f, ss1 = 0.f;
#pragma unroll
        for (int g = 0; g < 2; ++g)
#pragma unroll
            for (int nb = 0; nb < 3; ++nb) acc[g][nb] = (f32x4){0.f, 0.f, 0.f, 0.f};
#pragma unroll 1
        for (int ks0 = 0; ks0 < DM / 32; ks0 += 4) {
            u32x4 xa[4][2]; bf16x8 bh[4][3], bl[4][3];
#pragma unroll
            for (int j = 0; j < 4; ++j) { xa[j][0] = *(const u32x4*)(xr + (ks0 + j) * 32); xa[j][1] = *(const u32x4*)(xr + (size_t)16 * DM + (ks0 + j) * 32);
#pragma unroll
                for (int nb = 0; nb < 3; ++nb) { bh[j][nb] = *(const bf16x8*)(wh + (size_t)nb * 16 * DM + (ks0 + j) * 32); bl[j][nb] = *(const bf16x8*)(wl + (size_t)nb * 16 * DM + (ks0 + j) * 32); } }
#pragma unroll
            for (int j = 0; j < 4; ++j) {
                { const f32x4 a0 = bflo4(xa[j][0]), a1 = bfhi4(xa[j][0]); ss0 += (a0.x * a0.x + a0.y * a0.y) + (a0.z * a0.z + a0.w * a0.w) + (a1.x * a1.x + a1.y * a1.y) + (a1.z * a1.z + a1.w * a1.w); }
                { const f32x4 a0 = bflo4(xa[j][1]), a1 = bfhi4(xa[j][1]); ss1 += (a0.x * a0.x + a0.y * a0.y) + (a0.z * a0.z + a0.w * a0.w) + (a1.x * a1.x + a1.y * a1.y) + (a1.z * a1.z + a1.w * a1.w); }
#pragma unroll
                for (int g = 0; g < 2; ++g) { const bf16x8 ah = __builtin_bit_cast(bf16x8, xa[j][g]);
#pragma unroll
                    for (int nb = 0; nb < 3; ++nb) { acc[g][nb] = __builtin_amdgcn_mfma_f32_16x16x32_bf16(ah, bh[j][nb], acc[g][nb], 0, 0, 0); acc[g][nb] = __builtin_amdgcn_mfma_f32_16x16x32_bf16(ah, bl[j][nb], acc[g][nb], 0, 0, 0); } }
            }
        }
        ss0 += __shfl_xor(ss0, 16); ss0 += __shfl_xor(ss0, 32); ss1 += __shfl_xor(ss1, 16); ss1 += __shfl_xor(ss1, 32);
#pragma unroll
        for (int g = 0; g < 2; ++g)
#pragma unroll
            for (int nb = 0; nb < 3; ++nb)
#pragma unroll
                for (int j = 0; j < 4; ++j) L[(16 * g + 4 * kq + j) * 48 + nb * 16 + r16] = acc[g][nb][j];
        asm volatile("s_waitcnt lgkmcnt(0)" ::: "memory");
        const float ss = (lane & 16) ? ss1 : ss0;
        if (lane < 32) {
            t = task * 32 + lane; const LAS float* lg = L + lane * 48;
            rstd = 1.0f / sqrtf(ss * (1.0f / DM) + EPS);
            float gl[4];
#pragma unroll
            for (int i = 0; i < 4; ++i) gl[i] = lg[32 + i] * rstd + P.b_rg[i];
            int grp = 0; float gm = gl[0];
#pragma unroll
            for (int i = 1; i < 4; ++i) if (gl[i] > gm) { gm = gl[i]; grp = i; }
            float gsum = 0.f;
#pragma unroll
            for (int i = 0; i < 4; ++i) gsum += __expf(gl[i] - gm);
            const float p_grp = 1.0f / gsum;
            float es[8];
#pragma unroll
            for (int i = 0; i < 8; ++i) es[i] = lg[grp * 8 + i] * rstd + P.b_re[grp * 8 + i];
            int i1 = 0; float l1 = es[0];
#pragma unroll
            for (int i = 1; i < 8; ++i) if (es[i] > l1) { l1 = es[i]; i1 = i; }
            int i2 = -1; float l2 = -3.0e38f;
#pragma unroll
            for (int i = 0; i < 8; ++i) if (i != i1 && es[i] > l2) { l2 = es[i]; i2 = i; }
            const float w1 = 1.0f / (1.0f + __expf(l2 - l1)), w2 = 1.0f - w1;
            s0 = grp * EPG + i1; s1 = NE + grp * EPG + i2; wa = p_grp * w1; wb = p_grp * w2;
            lp0 = __hip_atomic_fetch_add(lcnt + s0, 1, __ATOMIC_RELAXED, __HIP_MEMORY_SCOPE_WORKGROUP); lp1 = __hip_atomic_fetch_add(lcnt + s1, 1, __ATOMIC_RELAXED, __HIP_MEMORY_SCOPE_WORKGROUP);
        }
        }
        __syncthreads();
        if (tid < 64) { const int c = lcnt[tid]; gbase[tid] = c > 0 ? (int)atomicAdd(&CNT[tid * CNT_STRIDE], (unsigned)c) : 0; }
        __syncthreads();
        if (active && lane < 32) {
            const int p0 = gbase[s0] + lp0, p1 = gbase[s1] + lp1;
            RSTD2[t] = rstd; EID[2 * t] = s0; EID[2 * t + 1] = s1 - NE; WTS[2 * t] = wa; WTS[2 * t + 1] = wb; POS[2 * t] = p0; POS[2 * t + 1] = p1;
            TOKL[(size_t)s0 * T + p0] = t; TOKL[(size_t)s1 * T + p1] = t;
            float2* SC = (float2*)(ws + WS_SC); SC[(size_t)s0 * T + p0] = make_float2(rstd, rstd * wa * 8.0f); SC[(size_t)s1 * T + p1] = make_float2(rstd, rstd * wb * 8.0f);
        }
        __syncthreads();
    }
}

__device__ __forceinline__ void thin_rstd_bf16(const bf16* X, float* RSTD, int gw, int ngw, int lane) {
    for (int t = gw; t < T; t += ngw) { const u32x4* xr = (const u32x4*)(X + (size_t)t * DM) + lane; float ss = 0.f;
#pragma unroll
        for (int j = 0; j < 4; ++j) { const u32x4 w = xr[64 * j]; const f32x4 a = bflo4(w), b = bfhi4(w); ss += (a.x * a.x + a.y * a.y) + (a.z * a.z + a.w * a.w) + (b.x * b.x + b.y * b.y) + (b.z * b.z + b.w * b.w); }
        ss = wave_sum(ss);
        if (lane == 0) RSTD[t] = 1.0f / sqrtf(ss * (1.0f / DM) + EPS); }
}
__device__ __forceinline__ void thin_rstd_fp8(const unsigned char* X, float* RSTD, int gw, int ngw, int lane) {
    for (int t = gw; t < T; t += 4 * ngw) {
        u32x4 w[4][2];
#pragma unroll
        for (int r = 0; r < 4; ++r) { const u32x4* xr = (const u32x4*)(X + (size_t)(t + r * ngw) * DM) + lane; w[r][0] = xr[0]; w[r][1] = xr[64]; }
#pragma unroll
        for (int r = 0; r < 4; ++r) { float ss = 0.f;
#pragma unroll
            for (int j = 0; j < 2; ++j)
#pragma unroll
                for (int q = 0; q < 4; ++q) { const auto a = __builtin_amdgcn_cvt_pk_f32_fp8((int)w[r][j][q], false), b = __builtin_amdgcn_cvt_pk_f32_fp8((int)w[r][j][q], true); ss += (a[0] * a[0] + a[1] * a[1]) + (b[0] * b[0] + b[1] * b[1]); }
            ss = wave_sum(ss);
            if (lane == 0) RSTD[t + r * ngw] = 1.0f / sqrtf(ss * (1.0f / DM) + EPS); } }
}
__device__ __forceinline__ void thin_final_bf16(const Params& P, const bf16* X, int gw, int ngw, int lane) {
    u32x4 nw[2][4];
#pragma unroll
    for (int r = 0; r < 2; ++r) { const u32x4* xr = (const u32x4*)(X + (size_t)(gw + r * ngw) * DM) + lane;
#pragma unroll
        for (int j = 0; j < 4; ++j) nw[r][j] = xr[64 * j]; }
    for (int t = gw; t < T; t += 2 * ngw) { u32x4 w[2][4];
#pragma unroll
        for (int r = 0; r < 2; ++r)
#pragma unroll
            for (int j = 0; j < 4; ++j) w[r][j] = nw[r][j];
        if (t + 2 * ngw < T) {
#pragma unroll
            for (int r = 0; r < 2; ++r) { const u32x4* xr = (const u32x4*)(X + (size_t)(t + (2 + r) * ngw) * DM) + lane;
#pragma unroll
                for (int j = 0; j < 4; ++j) nw[r][j] = xr[64 * j]; } }
#pragma unroll
        for (int r = 0; r < 2; ++r) { float ss = 0.f;
#pragma unroll
            for (int j = 0; j < 4; ++j) { const f32x4 a = bflo4(w[r][j]), b = bfhi4(w[r][j]); ss += (a.x * a.x + a.y * a.y) + (a.z * a.z + a.w * a.w) + (b.x * b.x + b.y * b.y) + (b.z * b.z + b.w * b.w); }
            ss = wave_sum(ss);
            const float rstd = 1.0f / sqrtf(ss * (1.0f / DM) + EPS);
            f32x4* o = (f32x4*)(P.out + (size_t)(t + r * ngw) * DM); const f32x4* g = (const f32x4*)P.g_final;
#pragma unroll
            for (int j = 0; j < 4; ++j) { const int c = 2 * (lane + 64 * j); o[c] = bflo4(w[r][j]) * rstd * g[c]; o[c + 1] = bfhi4(w[r][j]) * rstd * g[c + 1]; } } }
}

struct MegaArgs { Params P; int ph_lo, ph_hi; };
constexpr int NPHASE = 12;
__global__ void __launch_bounds__(NWAVES * 64, 2) mega_fwd(MegaArgs args) {
    extern __shared__ __attribute__((aligned(16))) unsigned char lds_raw[];
    const Params& P = args.P;
    Frame F;
    F.lds = (LAS unsigned char*)lds_raw;
    F.MISC = (volatile LAS unsigned*)(F.lds + MISC_OFF);
    F.tid = threadIdx.x; F.lane = F.tid & 63; F.wave = __builtin_amdgcn_readfirstlane(F.tid >> 6);
    F.G = gridDim.x; { const int bx = blockIdx.x; F.vcu = (F.G % 8 == 0) ? (bx % 8) * (F.G / 8) + bx / 8 : bx; }
    F.ctl = (unsigned*)(P.ws + WS_CTL);
    for (int u = F.tid; u < (LDS_BYTES - LDSCTL_OFF) / 4; u += NWAVES * 64) ((LAS unsigned*)(F.lds + LDSCTL_OFF))[u] = 0u;
    __syncthreads();
    const int lo = args.ph_lo, hi = args.ph_hi;
    XcdBarrier bar; bar.bar = F.ctl + CW_BAR; bar.x = 0; bar.st = nullptr;
    if (hi - lo > 1) bar = xcd_barrier_post(F.ctl + CW_BAR, F.MISC + 8);
#define IN(k) (lo <= (k) && (k) < hi)
#if defined(PROBE_SET)
#define STAMP(k) do { if (blockIdx.x == 0 && threadIdx.x == 0) ((unsigned long long*)(P.ws + WS_CTL + 512 * 1024))[k] = __builtin_amdgcn_s_memrealtime(); } while (0)
#else
#define STAMP(k) do { } while (0)
#endif
#define SEAM(k) do { STAMP(16 + (k)); if (IN(k) && IN((k) + 1)) xcd_barrier(bar); STAMP((k) + 1); } while (0)
    STAMP(0);
    const int gw = F.vcu * NWAVES + F.wave, NGW = F.G * NWAVES;
    unsigned char* ws = P.ws;

    if (IN(0)) { p0_rowstats(P, F); p0_weights(P, F); p0_pcast(P, F); p0_router_weights(P, F); }
    SEAM(0);
    if (IN(1)) {
        thin_cumsum(P, gw, NGW, tid_now() & 63);
#if defined(LDS_NAN_CHECK)
        for (int u = F.tid; u < RING_BYTES / 4; u += NWAVES * 64) ((LAS unsigned*)(F.lds + RING_OFF))[u] = 0x7FC07FC0u;
        __syncthreads();
#endif
        { pg8::StaticOrder S; S.init(ws + WS_XB, ws + WS_WT_IN, T, 5120, DM, F.G, (int)blockIdx.x);
          pg8::EpiIn E{ws, &P, gw, NGW};
          pg8::gemm_phase<pg8::EpiIn, pg8::StaticOrder, false>(F.lds + RING_OFF, DM, S, E); }
        { pg8::StaticOrder S; S.init(ws + WS_XB8, ws + WS_WT_IN8, T, 5120, DM / 2, F.G, (int)blockIdx.x);
          pg8::EpiGate E{ws, &P, gw, NGW};
          pg8::gemm_phase<pg8::EpiGate, pg8::StaticOrder, false, true, 121, 124>(F.lds + RING_OFF, DM / 2, S, E); }
    }
    SEAM(1);
    if (IN(2)) {
        fox::attn_phase((char*)lds_raw, ws, (volatile int*)((char*)lds_raw + MISC_OFF + 64));
        { volatile int* cslot = (volatile int*)((char*)lds_raw + MISC_OFF + 96); unsigned* cctr = F.ctl + CW_CONV; const int tid2 = tid_now();
          for (;;) { __syncthreads(); if (tid2 == 0) cslot[0] = (int)atomicAdd(cctr, 1u); __syncthreads();
              const int k = __builtin_amdgcn_readfirstlane(cslot[0]); if (k >= T / 32) break;
              thin_conv_chunk(P, k, tid2); } }
    }
    SEAM(2);
    if (IN(3)) {
        { pg8::StaticOrder S; S.init(ws + WS_Q, ws + WS_WT_A, T, DM, FW, F.G, (int)blockIdx.x); pg8::EpiMerge<0> E{ws};
          pg8::gemm_phase<pg8::EpiMerge<0>, pg8::StaticOrder, false>(F.lds + RING_OFF, FW, S, E); }
        asm volatile("s_waitcnt vmcnt(0)" ::: "memory"); __syncthreads();
        { pg8::StaticOrder S; S.init(ws + WS_BG, ws + WS_WT_B, T, DM, CW, F.G, (int)blockIdx.x); pg8::EpiMerge<1> E{ws};
          pg8::gemm_phase<pg8::EpiMerge<1>, pg8::StaticOrder, false>(F.lds + RING_OFF, CW, S, E); }
    }
    SEAM(3);
    if (IN(4)) {
        { pg8::StaticOrder S; S.init(ws + WS_MERGED, ws + WS_WT_OUT, T, DM, DM, F.G, (int)blockIdx.x); pg8::EpiX1 E{(const bf16*)(ws + WS_XB), (const float*)(ws + WS_RSTD1), (bf16*)(ws + WS_X1B), ws + WS_X1F8};
          pg8::gemm_phase<pg8::EpiX1, pg8::StaticOrder, false>(F.lds + RING_OFF, DM, S, E); }
        { pg8::StaticOrder S; S.init(ws + WS_PB, ws + WS_WT_PE, T, DM, PLE, F.G, (int)blockIdx.x); pg8::EpiPlain E{(bf16*)(ws + WS_PP), DM};
          pg8::gemm_phase<pg8::EpiPlain, pg8::StaticOrder, false>(F.lds + RING_OFF, PLE, S, E); }
    }
    SEAM(4);
    if (IN(5)) { router_mfma(P, F); }
    SEAM(5);
    LAS int* segt = (LAS int*)(F.lds + SEGT_OFF);
    if (IN(6) || IN(7) || IN(8)) {
        if (tid_now() == 0) { const unsigned* CNT = F.ctl + CW_CNT; int mt = 0, sb = 0;
            for (int s = 0; s < NSEG; ++s) { const int c = (int)__hip_atomic_load(CNT + s * CNT_STRIDE, __ATOMIC_RELAXED, __HIP_MEMORY_SCOPE_AGENT); segt[s] = c; segt[64 + s] = mt; segt[129 + s] = sb; const int n = (c + 255) >> 8; mt += n; sb += n << 8; }
            segt[64 + NSEG] = mt; segt[129 + NSEG] = sb; }
        __syncthreads();
    }
    if (IN(6)) {
        pg8::SegOrder S; S.tab = segt; S.nN = 2 * FF / 256; S.G = F.G; S.c = F.vcu; S.seg_lo = 0; S.seg_hi = NSEG; S.K = DM / 2; S.down = 0; S.A = (const char*)(ws + WS_X1F8); S.Bt = (const char*)(ws + WS_WT_GU); S.TOKL = (const int*)(ws + WS_TOKL);
        S.Lmax = 4 * F.G;
        pg8::EpiGU E{ws};
        pg8::gemm_phase<pg8::EpiGU, pg8::SegOrder, true, true>(F.lds + RING_OFF, DM / 2, S, E);
    }
    SEAM(6);
    if (IN(7)) {
        { pg8::SegOrder S; S.tab = segt; S.nN = 2 * FF / 256; S.G = F.G; S.c = F.G - 1 - F.vcu; S.seg_lo = 0; S.seg_hi = NSEG; S.K = DM / 2; S.down = 0; S.A = (const char*)(ws + WS_X1F8); S.Bt = (const char*)(ws + WS_WT_GU); S.TOKL = (const int*)(ws + WS_TOKL);
          S.L0 = 4 * F.G;
          pg8::EpiGU E{ws};
          pg8::gemm_phase<pg8::EpiGU, pg8::SegOrder, true, true>(F.lds + RING_OFF, DM / 2, S, E); }
        asm volatile("s_waitcnt vmcnt(0)" ::: "memory"); __syncthreads();
        pg8::SegOrder S; S.tab = segt; S.nN = DM / 256; S.G = F.G; S.c = F.vcu; S.seg_lo = 0; S.seg_hi = NE; S.K = FF / 2; S.down = 1; S.A = (const char*)(ws + WS_HACT); S.Bt = (const char*)(ws + WS_WT_DN); S.TOKL = (const int*)(ws + WS_TOKL);
        pg8::EpiDN<false> E{ws};
        pg8::gemm_phase<pg8::EpiDN<false>, pg8::SegOrder, false, true, 121, 124>(F.lds + RING_OFF, FF / 2, S, E);
    }
    SEAM(7);
    if (IN(8)) {
        pg8::SegOrder S; S.tab = segt; S.nN = DM / 256; S.G = F.G; S.c = F.vcu; S.seg_lo = NE; S.seg_hi = NSEG; S.K = FF / 2; S.down = 1; S.A = (const char*)(ws + WS_HACT); S.Bt = (const char*)(ws + WS_WT_DN); S.TOKL = (const int*)(ws + WS_TOKL);
        pg8::EpiDN<true> E{ws};
        pg8::gemm_phase<pg8::EpiDN<true>, pg8::SegOrder, false, true, 121, 124>(F.lds + RING_OFF, FF / 2, S, E);
    }
    SEAM(8);
    if (IN(9)) { thin_rstd_fp8(ws + WS_X2F8, (float*)(ws + WS_RSTD3), gw, NGW, tid_now() & 63); }
    SEAM(9);
    if (IN(10)) {
        pg8::EpiPle E{(const bf16*)(ws + WS_X1B), (bf16*)(ws + WS_X2B), (const bf16*)(ws + WS_PP), (const float*)(ws + WS_RSTD3)};
        pg8::StaticOrder S; S.init(ws + WS_X2F8, ws + WS_WT_PG, T, DM, DM / 2, F.G, (int)blockIdx.x);
        pg8::gemm_phase<pg8::EpiPle, pg8::StaticOrder, false, true>(F.lds + RING_OFF, DM / 2, S, E);
    }
    SEAM(10);
    if (IN(11)) { thin_final_bf16(P, (const bf16*)(ws + WS_X2B), gw, NGW, tid_now() & 63); }
    STAMP(12);
#undef IN
#undef SEAM
}
#if defined(PROBE_SET)
#ifndef PROBE_SCALE
#define PROBE_SCALE 0.1f
#endif
#ifndef PROBE_OFF
#define PROBE_OFF 0.f
#endif
__global__ void k_probe(Params P, int set) {
    const unsigned long long* st = (const unsigned long long*)(P.ws + WS_CTL + 512 * 1024);
    float us = 0.f;
    for (int k = 0; k < 12; ++k) if ((set >> k) & 1) us += (float)(st[k + 1] - st[k]) * 0.01f;
    for (int k = 0; k < 11; ++k) if ((set >> (16 + k)) & 1) us += (float)(st[k + 1] - st[16 + k]) * 0.01f;
    if (threadIdx.x == 0 && blockIdx.x == 0) P.out[0] += (us - PROBE_OFF) * PROBE_SCALE;
}
#endif
static void launch_mega(const Params& P, int lo, int hi, hipStream_t stream) {
    static bool attr_done = false;
    if (!attr_done) { attr_done = true;
        if (hipFuncSetAttribute((const void*)mega_fwd, hipFuncAttributeMaxDynamicSharedMemorySize, LDS_BYTES) != hipSuccess) fprintf(stderr, "kernel_launch: hipFuncSetAttribute failed\n");
        (void)hipGetLastError(); }
    if (lo >= hi) return;
    MegaArgs a; memset(&a, 0, sizeof(a)); a.P = P; a.ph_lo = lo; a.ph_hi = hi;
    hipLaunchKernelGGL(mega_fwd, dim3(256), dim3(NWAVES * 64), LDS_BYTES, stream, a);
    const hipError_t le = hipPeekAtLastError();
    if (le != hipSuccess) fprintf(stderr, "kernel_launch: mega launch [%d,%d) failed: %s\n", lo, hi, hipGetErrorName(le));
}
extern "C" void kernel_launch(void* const* d_in, const int* in_sizes, int n_in, void* d_out, int out_size, void* d_ws, size_t ws_size, hipStream_t stream) {
    if (n_in != 20 || in_sizes[0] != T * DM || out_size != T * DM || ws_size < WS_END) {
        fprintf(stderr, "kernel_launch: unexpected shapes (n_in %d, in0 %d, out %d, ws %zu; need ws >= %zu); nothing launched\n", n_in, n_in > 0 ? in_sizes[0] : -1, out_size, ws_size, (size_t)WS_END); return; }
    Params P; memset(&P, 0, sizeof(P));
    const float** pp = (const float**)&P;
    for (int i = 0; i < 20; ++i) pp[i] = (const float*)d_in[i];
    P.out = (float*)d_out; P.ws = (unsigned char*)d_ws;
    unsigned char* ws = P.ws;
    (void)hipMemsetAsync(ws + WS_CTL, 0, 1 * MiB, stream);
    launch_mega(P, 0, NPHASE, stream);
#if defined(PROBE_SET)
    k_probe<<<1, 64, 0, stream>>>(P, PROBE_SET);
#endif
}
```
